# Optimizing an MI355X kernel written in HIP

```python
import jax
import jax.numpy as jnp
from jax import lax
import numpy as np

D_MODEL = 2048
BATCH = 1
SEQ = 8192
DEPTH = 2

CTX_LEN = 256
GRID_W = 64

GDN_HEADS = D_MODEL // 256
GDN_HEAD_DIM = 128
GDN_WIDTH = GDN_HEADS * GDN_HEAD_DIM
GDN_CONV = 3
GDN_CHUNK = 64
RWKV_HEAD_DIM = 64
RWKV_HEADS = D_MODEL // 128
RWKV_WIDTH = RWKV_HEADS * RWKV_HEAD_DIM
RWKV_DECAY_RANK = 64
RWKV_A_RANK = 64
RWKV_GATE_RANK = 160

D_MIX = GDN_WIDTH + RWKV_WIDTH
D_FF = 4 * D_MODEL
N_MOD = 6
NORM_EPS = 1e-6
RWKV_LN_EPS = 64e-5

GDN_SIZES = (3 * GDN_WIDTH, GDN_WIDTH, GDN_HEADS, GDN_HEADS, GDN_HEADS, GDN_HEADS)
RWKV_SIZES = (RWKV_WIDTH, RWKV_WIDTH, RWKV_WIDTH,
              RWKV_DECAY_RANK, RWKV_DECAY_RANK, RWKV_A_RANK, RWKV_A_RANK, RWKV_GATE_RANK)
P_GDN = sum(GDN_SIZES)
P_RWKV = sum(RWKV_SIZES)
P_IN = P_GDN + P_RWKV

kernel_name = "hybrid_gdn_rwkv7_prefix_dit_block"


def split_cols(t, sizes):
    return jnp.split(t, [int(s) for s in np.cumsum(sizes)[:-1]], axis=-1)


def rmsnorm(x, g):
    xf = x.astype(jnp.float32)
    y = xf * lax.rsqrt(jnp.mean(xf * xf, axis=-1, keepdims=True) + NORM_EPS)
    return (y * g.astype(jnp.float32)).astype(x.dtype)


def l2norm(t):
    tf = t.astype(jnp.float32)
    return tf * lax.rsqrt(jnp.sum(tf * tf, axis=-1, keepdims=True) + 1e-6)


def neighbour_mean(t, axis):
    n = t.shape[axis]
    pad = [(0, 0)] * t.ndim
    pad[axis] = (1, 1)
    tp = jnp.pad(t, pad)
    prev = lax.slice_in_dim(tp, 0, n, axis=axis)
    nxt = lax.slice_in_dim(tp, 2, n + 2, axis=axis)
    return 0.5 * (prev + nxt)


def centred_dwconv(t, w):
    k = w.shape[0]
    p = k // 2
    n = t.shape[1]
    tp = jnp.pad(t, ((0, 0), (p, p), (0, 0)))
    out = tp[:, 0:n] * w[0]
    for j in range(1, k):
        out = out + tp[:, j:j + n] * w[j]
    return out


def to_col_major(t, rows):
    b, n, c = t.shape
    return t.reshape(b, rows, GRID_W, c).transpose(0, 2, 1, 3).reshape(b, n, c)


def to_row_major(t, rows):
    b, n, c = t.shape
    return t.reshape(b, GRID_W, rows, c).transpose(0, 2, 1, 3).reshape(b, n, c)


def maybe_flip(t, d, axis):
    return jnp.flip(t, axis=axis) if d == 1 else t


def gdn_chunked(q, k, v, log_decay, beta, s0):
    b, h, t, _ = q.shape
    dv = v.shape[-1]
    c = GDN_CHUNK
    n = t // c
    q, k, v = (a.reshape(b, h, n, c, a.shape[-1]) for a in (q, k, v))
    beta = beta.reshape(b, h, n, c)
    g = jnp.cumsum(log_decay.reshape(b, h, n, c), axis=-1)
    incl = jnp.tril(jnp.ones((c, c), dtype=bool))
    strict = jnp.tril(jnp.ones((c, c), dtype=bool), -1)
    decay = jnp.where(incl, jnp.exp(jnp.where(incl, g[..., :, None] - g[..., None, :], 0.0)), 0.0)
    k_beta = k * beta[..., None]
    l_mat = jnp.where(strict, jnp.einsum('bhnik,bhnjk->bhnij', k_beta, k) * decay, 0.0)
    eye = jnp.eye(c, dtype=q.dtype)
    t_inv = lax.linalg.triangular_solve(l_mat + eye, jnp.broadcast_to(eye, l_mat.shape),
                                        left_side=True, lower=True, unit_diagonal=True)
    u = jnp.einsum('bhnij,bhnjv->bhniv', t_inv, v * beta[..., None])
    w = jnp.einsum('bhnij,bhnjk->bhnik', t_inv, k_beta * jnp.exp(g)[..., None])
    a_intra = jnp.where(incl, jnp.einsum('bhnik,bhnjk->bhnij', q, k) * decay, 0.0)
    g_last = g[..., -1]
    q_e = q * jnp.exp(g)[..., None]
    k_e = k * jnp.exp(g_last[..., None] - g)[..., None]

    def step(s, inp):
        q_i, k_i, u_i, w_i, a_i, dl_i = inp
        v_new = u_i - jnp.einsum('bhik,bhkv->bhiv', w_i, s)
        o = jnp.einsum('bhik,bhkv->bhiv', q_i, s) + jnp.einsum('bhij,bhjv->bhiv', a_i, v_new)
        s = s * dl_i[..., None, None] + jnp.einsum('bhik,bhiv->bhkv', k_i, v_new)
        return s, o

    xs = tuple(jnp.moveaxis(a, 2, 0) for a in (q_e, k_e, u, w, a_intra, jnp.exp(g_last)))
    s, o = lax.scan(step, s0, xs)
    return s, jnp.moveaxis(o, 0, 2).reshape(b, h, t, dv)


def gdn_prepare(p, conv_w, a_log, dt_bias):
    b, t, _ = p.shape
    qkv, z, b_f, b_b, al_f, al_b = split_cols(p, GDN_SIZES)
    qkv = jax.nn.silu(centred_dwconv(qkv, conv_w))
    q, k, v = jnp.split(qkv, 3, axis=-1)

    def heads(a):
        return a.reshape(b, t, GDN_HEADS, GDN_HEAD_DIM).transpose(0, 2, 1, 3).astype(jnp.float32)

    q = l2norm(heads(q)) * (GDN_HEAD_DIM ** -0.5)
    k = l2norm(heads(k))
    v = heads(v)
    betas = jax.nn.sigmoid(jnp.stack([b_f, b_b]).astype(jnp.float32)).transpose(0, 1, 3, 2)
    alphas = jnp.stack([al_f, al_b]).astype(jnp.float32)
    log_decay = -jnp.exp(a_log.astype(jnp.float32))[:, None, None, :] * jax.nn.softplus(
        alphas + dt_bias.astype(jnp.float32)[:, None, None, :])
    return q, k, v, z, betas, log_decay.transpose(0, 1, 3, 2)


def gdn_output(o, z, norm_g):
    b, h, t, _ = o.shape
    o = rmsnorm(o, norm_g).transpose(0, 2, 1, 3).reshape(b, t, GDN_WIDTH)
    return o * jax.nn.silu(z.astype(jnp.float32))


def gdn_group(p_l, p_c, conv_w, a_log, dt_bias, norm_g):
    q_l, k_l, v_l, z_l, b_l, g_l = gdn_prepare(p_l, conv_w, a_log, dt_bias)
    q_c, k_c, v_c, z_c, b_c, g_c = gdn_prepare(p_c, conv_w, a_log, dt_bias)
    s0 = jnp.zeros((p_l.shape[0], GDN_HEADS, GDN_HEAD_DIM, GDN_HEAD_DIM), jnp.float32)
    outs_l, outs_c = [], []
    for d in range(2):
        s_c, oc = gdn_chunked(maybe_flip(q_c, d, 2), maybe_flip(k_c, d, 2), maybe_flip(v_c, d, 2),
                              maybe_flip(g_c[d], d, 2), maybe_flip(b_c[d], d, 2), s0)
        _, ol = gdn_chunked(maybe_flip(q_l, d, 2), maybe_flip(k_l, d, 2), maybe_flip(v_l, d, 2),
                            maybe_flip(g_l[d], d, 2), maybe_flip(b_l[d], d, 2), s_c)
        outs_c.append(maybe_flip(oc, d, 2))
        outs_l.append(maybe_flip(ol, d, 2))
    return (gdn_output(outs_l[0] + outs_l[1], z_l, norm_g),
            gdn_output(outs_c[0] + outs_c[1], z_c, norm_g))


def rwkv7_scan(r, decay, k, v, kk, a, s0):
    def step(s, inp):
        r_t, w_t, k_t, v_t, kk_t, a_t = inp
        sa = jnp.einsum('bhvk,bhk->bhv', s, -kk_t)
        s = (s * w_t[:, :, None, :] + sa[..., None] * (kk_t * a_t)[:, :, None, :]
             + v_t[..., None] * k_t[:, :, None, :])
        return s, jnp.einsum('bhvk,bhk->bhv', s, r_t)

    xs = tuple(jnp.moveaxis(t, 1, 0) for t in (r, decay, k, v, kk, a))
    s, out = lax.scan(step, s0, xs)
    return s, jnp.moveaxis(out, 0, 1)


def rwkv_prepare(p, w0, w2, a0, a2, g2, k_k, k_a):
    b, t, _ = p.shape
    r, k, v, w1f, w1b, a1f, a1b, g1 = split_cols(p.astype(jnp.float32), RWKV_SIZES)

    def heads(a):
        return a.reshape(b, t, RWKV_HEADS, RWKV_HEAD_DIM)

    gate = jax.nn.sigmoid(g1) @ g2
    kk = l2norm(heads(k * k_k))
    dirs = []
    for d, (w1, a1) in enumerate(((w1f, a1f), (w1b, a1b))):
        w = -jax.nn.softplus(-(w0[d] + jnp.tanh(w1) @ w2[d])) - 0.5
        decay = jnp.exp(-jnp.exp(w))
        a = jax.nn.sigmoid(a0[d] + a1 @ a2[d])
        k_d = k * (1.0 + (a - 1.0) * k_a)
        dirs.append((heads(decay), heads(k_d), heads(a)))
    return heads(r), heads(v), kk, gate, dirs


def rwkv_output(o, r, v, ks, gate, r_k, ln_g, ln_b):
    b, t, h, n = o.shape
    mean = jnp.mean(o, axis=-1, keepdims=True)
    var = jnp.var(o, axis=-1, keepdims=True)
    o = ((o - mean) * lax.rsqrt(var + RWKV_LN_EPS)).reshape(b, t, RWKV_WIDTH) * ln_g + ln_b
    rk = r_k.reshape(h, n)
    bonus = (jnp.sum(r * ks[0] * rk, axis=-1, keepdims=True)
             + jnp.sum(r * ks[1] * rk, axis=-1, keepdims=True)) * v
    return (o + bonus.reshape(b, t, RWKV_WIDTH)) * gate


def rwkv_group(p_l, p_c, rows, mu, w0, w2, a0, a2, g2, k_k, k_a, r_k, ln_g, ln_b):
    b, n, c = p_l.shape
    p_l = p_l + mu * (neighbour_mean(p_l.reshape(b, rows, GRID_W, c), 1).reshape(b, n, c) - p_l)
    p_l = to_col_major(p_l, rows)
    p_c = p_c + mu * (neighbour_mean(p_c, 1) - p_c)
    r_l, v_l, kk_l, gate_l, dirs_l = rwkv_prepare(p_l, w0, w2, a0, a2, g2, k_k, k_a)
    r_c, v_c, kk_c, gate_c, dirs_c = rwkv_prepare(p_c, w0, w2, a0, a2, g2, k_k, k_a)
    s0 = jnp.zeros((b, RWKV_HEADS, RWKV_HEAD_DIM, RWKV_HEAD_DIM), jnp.float32)
    outs_l, outs_c = [], []
    for d in range(2):
        dec_c, kd_c, a_c = dirs_c[d]
        dec_l, kd_l, a_l = dirs_l[d]
        s_c, oc = rwkv7_scan(maybe_flip(r_c, d, 1), maybe_flip(dec_c, d, 1), maybe_flip(kd_c, d, 1),
                             maybe_flip(v_c, d, 1), maybe_flip(kk_c, d, 1), maybe_flip(a_c, d, 1), s0)
        _, ol = rwkv7_scan(maybe_flip(r_l, d, 1), maybe_flip(dec_l, d, 1), maybe_flip(kd_l, d, 1),
                           maybe_flip(v_l, d, 1), maybe_flip(kk_l, d, 1), maybe_flip(a_l, d, 1), s_c)
        outs_c.append(maybe_flip(oc, d, 1))
        outs_l.append(maybe_flip(ol, d, 1))
    out_l = rwkv_output(outs_l[0] + outs_l[1], r_l, v_l, (dirs_l[0][1], dirs_l[1][1]), gate_l, r_k, ln_g, ln_b)
    out_c = rwkv_output(outs_c[0] + outs_c[1], r_c, v_c, (dirs_c[0][1], dirs_c[1][1]), gate_c, r_k, ln_g, ln_b)
    return to_row_major(out_l, rows), out_c


def hybrid_mixer(h_l, h_c, rows, need_ctx, w_in, conv_w, a_log, dt_bias, gdn_norm_g, mu, w0, w2, a0, a2,
                 g2, k_k, k_a, r_k, ln_g, ln_b, w_out):
    p_l = h_l @ w_in
    p_c = h_c @ w_in
    og_l, og_c = gdn_group(p_l[..., :P_GDN], p_c[..., :P_GDN], conv_w, a_log, dt_bias, gdn_norm_g)
    or_l, or_c = rwkv_group(p_l[..., P_GDN:], p_c[..., P_GDN:], rows, mu, w0, w2, a0, a2, g2,
                            k_k, k_a, r_k, ln_g, ln_b)
    out_l = jnp.concatenate([og_l, or_l], axis=-1).astype(h_l.dtype) @ w_out
    out_c = jnp.concatenate([og_c, or_c], axis=-1).astype(h_c.dtype) @ w_out if need_ctx else None
    return out_l, out_c


def squared_relu_mlp(h, w1, w2):
    return jnp.square(jax.nn.relu(h @ w1)) @ w2


def setup_inputs(seed: int = 0) -> dict:
    key = jax.random.key(seed)
    ks = jax.random.split(key, 28)
    f32 = jnp.float32
    D = D_MODEL

    def nrm(k, shape, scale):
        return jax.random.normal(k, shape, f32) * scale

    dt = jnp.exp(jax.random.uniform(ks[11], (DEPTH, 2, GDN_HEADS), f32, float(np.log(1e-3)), float(np.log(1e-1))))
    dt_bias = dt + jnp.log(-jnp.expm1(-dt))
    return {
        "x": nrm(ks[0], (BATCH, SEQ, D), 1.0),
        "c": nrm(ks[1], (BATCH, D), 1.0),
        "ctx": nrm(ks[2], (BATCH, CTX_LEN, D), 1.0),
        "c_ctx": nrm(ks[3], (D,), 1.0),
        "ada_w": nrm(ks[4], (DEPTH, D, N_MOD * D), 0.5 * D ** -0.5),
        "ada_b": nrm(ks[5], (DEPTH, N_MOD * D), 0.02),
        "norm1_g": 1.0 + nrm(ks[6], (DEPTH, D), 0.05),
        "norm2_g": 1.0 + nrm(ks[7], (DEPTH, D), 0.05),
        "w_in": nrm(ks[8], (DEPTH, D, P_IN), D ** -0.5),
        "gdn_conv_w": nrm(ks[9], (DEPTH, GDN_CONV, 3 * GDN_WIDTH), GDN_CONV ** -0.5),
        "gdn_a_log": jnp.log(jax.random.uniform(ks[10], (DEPTH, 2, GDN_HEADS), f32, 1.0, 16.0)),
        "gdn_dt_bias": dt_bias,
        "gdn_norm_g": 1.0 + nrm(ks[12], (DEPTH, GDN_HEAD_DIM), 0.05),
        "rwkv_mu": jax.random.uniform(ks[13], (DEPTH, P_RWKV), f32, 0.0, 1.0),
        "rwkv_w0": jax.random.uniform(ks[14], (DEPTH, 2, RWKV_WIDTH), f32, -6.0, -1.0),
        "rwkv_w2": nrm(ks[15], (DEPTH, 2, RWKV_DECAY_RANK, RWKV_WIDTH), 0.1),
        "rwkv_a0": nrm(ks[16], (DEPTH, 2, RWKV_WIDTH), 0.1),
        "rwkv_a2": nrm(ks[17], (DEPTH, 2, RWKV_A_RANK, RWKV_WIDTH), RWKV_A_RANK ** -0.5),
        "rwkv_g2": nrm(ks[18], (DEPTH, RWKV_GATE_RANK, RWKV_WIDTH), RWKV_GATE_RANK ** -0.5),
        "rwkv_k_k": 0.85 + nrm(ks[19], (DEPTH, RWKV_WIDTH), 0.05),
        "rwkv_k_a": 1.0 + nrm(ks[20], (DEPTH, RWKV_WIDTH), 0.05),
        "rwkv_r_k": nrm(ks[21], (DEPTH, RWKV_WIDTH), 0.1),
        "rwkv_ln_g": 1.0 + nrm(ks[22], (DEPTH, RWKV_WIDTH), 0.05),
        "rwkv_ln_b": nrm(ks[23], (DEPTH, RWKV_WIDTH), 0.02),
        "w_out": nrm(ks[24], (DEPTH, D_MIX, D), D_MIX ** -0.5),
        "mlp_w1": nrm(ks[25], (DEPTH, D, D_FF), D ** -0.5),
        "mlp_w2": nrm(ks[26], (DEPTH, D_FF, D), D_FF ** -0.5),
        "final_g": 1.0 + nrm(ks[27], (D,), 0.05),
    }


def reference(x, c, ctx, c_ctx, ada_w, ada_b, norm1_g, norm2_g, w_in, gdn_conv_w, gdn_a_log, gdn_dt_bias,
              gdn_norm_g, rwkv_mu, rwkv_w0, rwkv_w2, rwkv_a0, rwkv_a2, rwkv_g2, rwkv_k_k, rwkv_k_a, rwkv_r_k,
              rwkv_ln_g, rwkv_ln_b, w_out, mlp_w1, mlp_w2, final_g):
    rows = x.shape[1] // GRID_W
    lat, cx = x, ctx
    for l in range(DEPTH):
        need_ctx = l < DEPTH - 1
        mod_l = jax.nn.silu(c) @ ada_w[l] + ada_b[l]
        mod_c = jax.nn.silu(c_ctx) @ ada_w[l] + ada_b[l]
        sh1_l, sc1_l, gt1_l, sh2_l, sc2_l, gt2_l = [m[:, None, :] for m in jnp.split(mod_l, N_MOD, axis=-1)]
        sh1_c, sc1_c, gt1_c, sh2_c, sc2_c, gt2_c = jnp.split(mod_c, N_MOD, axis=-1)
        h_l = rmsnorm(lat, norm1_g[l]) * (1 + sc1_l) + sh1_l
        h_c = rmsnorm(cx, norm1_g[l]) * (1 + sc1_c) + sh1_c
        mix_l, mix_c = hybrid_mixer(h_l, h_c, rows, need_ctx, w_in[l], gdn_conv_w[l], gdn_a_log[l],
                                    gdn_dt_bias[l], gdn_norm_g[l], rwkv_mu[l], rwkv_w0[l], rwkv_w2[l],
                                    rwkv_a0[l], rwkv_a2[l], rwkv_g2[l], rwkv_k_k[l], rwkv_k_a[l],
                                    rwkv_r_k[l], rwkv_ln_g[l], rwkv_ln_b[l], w_out[l])
        lat = lat + gt1_l * mix_l
        h2_l = rmsnorm(lat, norm2_g[l]) * (1 + sc2_l) + sh2_l
        lat = lat + gt2_l * squared_relu_mlp(h2_l, mlp_w1[l], mlp_w2[l])
        if need_ctx:
            cx = cx + gt1_c * mix_c
            h2_c = rmsnorm(cx, norm2_g[l]) * (1 + sc2_c) + sh2_c
            cx = cx + gt2_c * squared_relu_mlp(h2_c, mlp_w1[l], mlp_w2[l])
    return rmsnorm(lat, final_g)
```

```cpp
#include <hip/hip_runtime.h>
#include <hip/hip_cooperative_groups.h>
#include <cstdio>
#include <cstdint>
namespace cg = cooperative_groups;
__device__ __forceinline__ int otid() { int t = threadIdx.x; asm volatile("" : "+v"(t)); return t; }
namespace pg8 {
#define PG8_LAS __attribute__((address_space(3)))
typedef unsigned short bf16_t;
typedef short bf16x8 __attribute__((ext_vector_type(8)));
typedef float f32x4 __attribute__((ext_vector_type(4)));
typedef unsigned u32x4 __attribute__((ext_vector_type(4)));
constexpr int BM = 256, BK = 64, HALF = 128, HTB = HALF * BK * 2  , STAGE_BYTES = 8 * HTB, NXCD = 8, WGM = 8;

__host__ __device__ __forceinline__ int lds_byte(int r, int c) { const int st = (r >> 4) * 2 + (c >> 5), rr = r & 15, cc = c & 31, ob = rr * 64 + cc * 2; return st * 1024 + (ob ^ (((ob >> 9) & 1) << 5)); }
__host__ __device__ __forceinline__ void stage_rc(int b, int& R, int& C) { const int st = b / 1024, sb = b % 1024, swz = sb ^ (((sb >> 9) & 1) << 5); R = (st >> 1) * 16 + swz / 64; C = (st & 1) * 32 + (swz % 64) / 2; }
__host__ __device__ __forceinline__ int perm32(int rho) { const int n = rho >> 4, i = rho & 15; return 8 * (i >> 2) + 4 * n + (i & 3); }

struct Unit { int pm, pn; };
struct Gemm { const bf16_t* A; const bf16_t* Bt; int M, N, K; };

struct StaticOrder {
    int nM, nN, nwg, G, c;
    __host__ __device__ void init(int M, int N, int G_, int c_) { nM = M / BM; nN = N / BM; nwg = nM * nN; G = G_; c = c_; }
    __host__ __device__ bool next(int i, Unit& u) const {
        const long L = (long)i * G + c; if (L >= nwg) return false;
        int wgid = (int)L; { const int q = nwg / NXCD, r = nwg % NXCD, xcd = wgid % NXCD, off = wgid / NXCD; wgid = (xcd < r ? xcd * (q + 1) : r * (q + 1) + (xcd - r) * q) + off; }
        const int nig = WGM * nN, gid = wgid / nig, fm = gid * WGM, gsz = (nM - fm) < WGM ? (nM - fm) : WGM;
        u.pm = fm + ((wgid % nig) % gsz); u.pn = (wgid % nig) / gsz; return true;
    }
    __device__ __forceinline__ void a_ready(const Unit&) const {}
    __device__ __forceinline__ void done(const Unit&) const {}
};

__device__ __forceinline__ unsigned cvt_pk_bf16(float lo, float hi) { unsigned r; asm volatile("v_cvt_pk_bf16_f32 %0, %1, %2" : "=v"(r) : "v"(lo), "v"(hi)); return r; }
struct EpiF32 {
    static constexpr bool PERM = false, AFTER_DRAIN = false;
    float* O; int ldc;
    __device__ __forceinline__ void operator()(const f32x4 (&acc)[2][2][4][2], const Unit& u, int wr, int wc, int fr, int fq) const {
        const int row0 = u.pm * BM + wr * 64 + fr, col0 = u.pn * BM + wc * 32 + 4 * fq;
#pragma unroll
        for (int ai = 0; ai < 2; ++ai)
#pragma unroll
            for (int m = 0; m < 4; ++m) { float* rowp = O + (size_t)(row0 + ai * HALF + m * 16) * ldc + col0;
#pragma unroll
                for (int bj = 0; bj < 2; ++bj)
#pragma unroll
                    for (int n = 0; n < 2; ++n) *(f32x4*)(rowp + bj * HALF + n * 16) = acc[ai][bj][m][n]; }
    }
    __device__ __forceinline__ void fused(f32x4 (&)[2][2][4][2], const Unit&, int, int, int, int, PG8_LAS unsigned char*, int, int) const {}
};
struct EpiRes {
    static constexpr bool PERM = false, AFTER_DRAIN = false;
    const float* res_l; const float* res_c; float* out_l; float* out_c; const float* gate_l; const float* gate_c;
    __device__ __forceinline__ void operator()(const f32x4 (&acc)[2][2][4][2], const Unit& u, int wr, int wc, int fr, int fq) const {
        const bool isc = u.pm >= 32;
        const float* res = isc ? res_c : res_l; float* out = isc ? out_c : out_l; const float* gate = isc ? gate_c : gate_l;
        const int row0 = (isc ? u.pm - 32 : u.pm) * BM + wr * 64 + fr, col0 = u.pn * BM + wc * 32 + 4 * fq;
        f32x4 gv[2][2];
#pragma unroll
        for (int bj = 0; bj < 2; ++bj)
#pragma unroll
            for (int n = 0; n < 2; ++n) gv[bj][n] = *(const f32x4*)(gate + col0 + bj * HALF + n * 16);
#pragma unroll
        for (int ai = 0; ai < 2; ++ai)
#pragma unroll
            for (int m = 0; m < 4; ++m) { const size_t off = (size_t)(row0 + ai * HALF + m * 16) * 2048 + col0;
#pragma unroll
                for (int bj = 0; bj < 2; ++bj)
#pragma unroll
                    for (int n = 0; n < 2; ++n) { const f32x4 r = *(const f32x4*)(res + off + bj * HALF + n * 16);
                        *(f32x4*)(out + off + bj * HALF + n * 16) = r + gv[bj][n] * acc[ai][bj][m][n]; } }
    }
    __device__ __forceinline__ void fused(f32x4 (&)[2][2][4][2], const Unit&, int, int, int, int, PG8_LAS unsigned char*, int, int) const {}
};
struct EpiRelu2 {
    static constexpr bool PERM = true, AFTER_DRAIN = false;
    bf16_t* O; int ldc;
    __device__ __forceinline__ void operator()(const f32x4 (&acc)[2][2][4][2], const Unit& u, int wr, int wc, int fr, int fq) const {
        const int row0 = u.pm * BM + wr * 64 + fr, col0 = u.pn * BM + wc * 32 + 8 * fq;
#pragma unroll
        for (int ai = 0; ai < 2; ++ai)
#pragma unroll
            for (int m = 0; m < 4; ++m) { bf16_t* rowp = O + (size_t)(row0 + ai * HALF + m * 16) * ldc + col0;
#pragma unroll
                for (int bj = 0; bj < 2; ++bj) { f32x4 v0 = acc[ai][bj][m][0], v1 = acc[ai][bj][m][1];
#pragma unroll
                    for (int e = 0; e < 4; ++e) { const float a = fmaxf(v0[e], 0.f), b = fmaxf(v1[e], 0.f); v0[e] = a * a; v1[e] = b * b; }
                    u32x4 w; w.x = cvt_pk_bf16(v0[0], v0[1]); w.y = cvt_pk_bf16(v0[2], v0[3]); w.z = cvt_pk_bf16(v1[0], v1[1]); w.w = cvt_pk_bf16(v1[2], v1[3]);
                    *(u32x4*)(rowp + bj * HALF) = w; } }
    }
    __device__ __forceinline__ void fused(f32x4 (&)[2][2][4][2], const Unit&, int, int, int, int, PG8_LAS unsigned char*, int, int) const {}
};
template <class Epi, class Sched, bool ALIGN_EPI = false, bool SP2 = false>
__device__ __forceinline__ void gemm_phase(PG8_LAS unsigned char* lds, const Gemm g, const Sched& S, const Epi& E) {
    const int tid = otid(), wid = __builtin_amdgcn_readfirstlane(tid >> 6), lane = tid & 63, wr = wid >> 2, wc = wid & 3, fr = lane & 15, fq = lane >> 4;
    const int K = g.K, nt = K / BK;
    unsigned voffA[2], voffB[2];
#pragma unroll
    for (int i = 0; i < 2; ++i) { int R, C; stage_rc(tid * 16 + i * 8192, R, C); const int Rb = Epi::PERM ? ((R & ~31) + perm32(R & 31)) : R;
        voffA[i] = (unsigned)(R * K + C) * 2u; voffB[i] = (unsigned)(Rb * K + C) * 2u; }
    const size_t kstep = (size_t)(BK * 2);
    const size_t hstep = (size_t)HALF * K * 2;
    const size_t tstep = 2 * hstep;
    const unsigned ldsw = (unsigned)wid * 1024u;
    const int aoff = lds_byte(wr * 64 + fr, fq * 8), boff = lds_byte(wc * 32 + fr, fq * 8);
#define PG8_SA(b, h) (((b) * 2 + (h)) * HTB)
#define PG8_SB(b, h) ((4 + (b) * 2 + (h)) * HTB)
#define PG8_STAGE(bufoff, gbase, voff) do { _Pragma("unroll") for (int _i = 0; _i < 2; ++_i) \
        __builtin_amdgcn_global_load_lds((const unsigned*)((const char*)(gbase) + (voff)[_i]), (PG8_LAS unsigned*)(lds + (bufoff) + ldsw + _i * 8192), 16, 0, 0); } while (0)
#define PG8_LDA(dst, b, h) do { _Pragma("unroll") for (int m = 0; m < 4; ++m) _Pragma("unroll") for (int k = 0; k < 2; ++k) dst[m][k] = *(const PG8_LAS bf16x8*)(lds + PG8_SA(b, h) + aoff + m * 2048 + k * 1024); } while (0)
#define PG8_LDB(dst, b, h) do { _Pragma("unroll") for (int n = 0; n < 2; ++n) _Pragma("unroll") for (int k = 0; k < 2; ++k) dst[n][k] = *(const PG8_LAS bf16x8*)(lds + PG8_SB(b, h) + boff + n * 2048 + k * 1024); } while (0)
#define PG8_MMA(ai, bj, At, Bt) do { __builtin_amdgcn_s_setprio(1); _Pragma("unroll") for (int m = 0; m < 4; ++m) _Pragma("unroll") for (int n = 0; n < 2; ++n) _Pragma("unroll") for (int k = 0; k < 2; ++k) \
        acc[ai][bj][m][n] = __builtin_amdgcn_mfma_f32_16x16x32_bf16(Bt[n][k], At[m][k], acc[ai][bj][m][n], 0, 0, 0); __builtin_amdgcn_s_setprio(0); } while (0)
#define PG8_WAIT_V(n) asm volatile("s_waitcnt vmcnt(" #n ")" ::: "memory")
#define PG8_WAIT_L(n) asm volatile("s_waitcnt lgkmcnt(" #n ")" ::: "memory")
#define PG8_BAR __builtin_amdgcn_s_barrier()
#define PG8_SCHED __builtin_amdgcn_sched_barrier(0)
    Unit cur, nxt; int ui = 0;
    if (!S.next(0, cur)) return;
    f32x4 acc[2][2][4][2];
#pragma unroll
    for (int a = 0; a < 2; ++a)
#pragma unroll
        for (int b = 0; b < 2; ++b)
#pragma unroll
            for (int m = 0; m < 4; ++m)
#pragma unroll
                for (int n = 0; n < 2; ++n) acc[a][b][m][n] = (f32x4){0.f, 0.f, 0.f, 0.f};
    bf16x8 At[4][2], B0[2][2], B1[2][2];
    const char* cA = (const char*)g.A + (size_t)cur.pm * tstep; const char* cB = (const char*)g.Bt + (size_t)cur.pn * tstep;
    S.a_ready(cur);
    if constexpr (SP2) {
        PG8_STAGE(PG8_SB(0, 0), cB, voffB); PG8_STAGE(PG8_SB(0, 1), cB + hstep, voffB); PG8_STAGE(PG8_SA(0, 0), cA, voffA); PG8_STAGE(PG8_SA(0, 1), cA + hstep, voffA);
        if (wr == 1) PG8_BAR;
        PG8_WAIT_V(2); PG8_BAR;
        PG8_STAGE(PG8_SB(1, 0), cB + kstep, voffB); PG8_STAGE(PG8_SA(1, 0), cA + kstep, voffA); PG8_STAGE(PG8_SB(1, 1), cB + hstep + kstep, voffB);
        PG8_WAIT_V(6); PG8_BAR;
    } else {
        PG8_STAGE(PG8_SB(0, 0), cB, voffB); PG8_STAGE(PG8_SA(0, 0), cA, voffA); PG8_STAGE(PG8_SB(0, 1), cB + hstep, voffB); PG8_STAGE(PG8_SA(0, 1), cA + hstep, voffA);
        if (wr == 1) PG8_BAR;
        PG8_WAIT_V(4); PG8_BAR;
        PG8_STAGE(PG8_SB(1, 0), cB + kstep, voffB); PG8_STAGE(PG8_SA(1, 0), cA + kstep, voffA); PG8_STAGE(PG8_SB(1, 1), cB + hstep + kstep, voffB);
        PG8_WAIT_V(6); PG8_BAR;
    }
    for (;;) {
        const bool has_next = S.next(ui + 1, nxt);
        const char* nA = has_next ? (const char*)g.A + (size_t)nxt.pm * tstep : cA; const char* nB = has_next ? (const char*)g.Bt + (size_t)nxt.pn * tstep : cB;
        for (int t = 0; t < nt; t += 2) {
            const bool last = (t == nt - 2);
            const char* a1 = cA + (size_t)(t + 1) * kstep;
            const char* a2 = last ? nA : cA + (size_t)(t + 2) * kstep; const char* b2 = last ? nB : cB + (size_t)(t + 2) * kstep;
            const char* a3 = a2 + kstep; const char* b3 = b2 + kstep;
            if (last && has_next) S.a_ready(nxt);
            if constexpr (SP2) {
            PG8_LDB(B0, 0, 0); PG8_LDB(B1, 0, 1); PG8_SCHED; PG8_LDA(At, 0, 0); PG8_STAGE(PG8_SA(1, 1), a1 + hstep, voffA);
            PG8_WAIT_V(8); PG8_WAIT_L(0); PG8_BAR; PG8_MMA(0, 0, At, B0); PG8_MMA(0, 1, At, B1); PG8_BAR; PG8_SCHED;
            PG8_LDA(At, 0, 1); PG8_STAGE(PG8_SB(0, 0), b2, voffB); PG8_STAGE(PG8_SB(0, 1), b2 + hstep, voffB); PG8_STAGE(PG8_SA(0, 0), a2, voffA);
            PG8_WAIT_V(8); PG8_WAIT_L(0); PG8_BAR; PG8_MMA(1, 0, At, B0); PG8_MMA(1, 1, At, B1); PG8_BAR; PG8_SCHED;
            PG8_LDB(B0, 1, 0); PG8_LDB(B1, 1, 1); PG8_SCHED; PG8_LDA(At, 1, 0); PG8_STAGE(PG8_SA(0, 1), a2 + hstep, voffA);
            PG8_WAIT_V(8); PG8_WAIT_L(0); PG8_BAR; PG8_MMA(0, 0, At, B0); PG8_MMA(0, 1, At, B1); PG8_BAR; PG8_SCHED;
            PG8_LDA(At, 1, 1); PG8_STAGE(PG8_SB(1, 0), b3, voffB); PG8_STAGE(PG8_SB(1, 1), b3 + hstep, voffB); PG8_STAGE(PG8_SA(1, 0), a3, voffA);
            PG8_WAIT_V(8); PG8_WAIT_L(0); PG8_BAR; PG8_MMA(1, 0, At, B0); PG8_MMA(1, 1, At, B1); PG8_BAR; PG8_SCHED;
            } else {
            PG8_LDB(B0, 0, 0); PG8_SCHED; PG8_LDA(At, 0, 0); PG8_STAGE(PG8_SA(1, 1), a1 + hstep, voffA);
            PG8_WAIT_L(8); PG8_BAR; PG8_WAIT_L(0); PG8_MMA(0, 0, At, B0); PG8_BAR; PG8_SCHED;
            PG8_LDB(B1, 0, 1); PG8_STAGE(PG8_SB(0, 0), b2, voffB);
            PG8_BAR; PG8_WAIT_L(0); PG8_MMA(0, 1, At, B1); PG8_BAR;
            PG8_LDA(At, 0, 1); PG8_STAGE(PG8_SA(0, 0), a2, voffA);
            PG8_BAR; PG8_WAIT_L(0); PG8_MMA(1, 0, At, B0); PG8_BAR; PG8_SCHED;
            PG8_STAGE(PG8_SB(0, 1), b2 + hstep, voffB);
            PG8_WAIT_V(6); PG8_BAR; PG8_MMA(1, 1, At, B1); PG8_BAR;
            PG8_LDB(B0, 1, 0); PG8_SCHED; PG8_LDA(At, 1, 0); PG8_STAGE(PG8_SA(0, 1), a2 + hstep, voffA);
            PG8_WAIT_L(8); PG8_BAR; PG8_WAIT_L(0); PG8_MMA(0, 0, At, B0); PG8_BAR; PG8_SCHED;
            PG8_LDB(B1, 1, 1); PG8_STAGE(PG8_SB(1, 0), b3, voffB);
            PG8_BAR; PG8_WAIT_L(0); PG8_MMA(0, 1, At, B1); PG8_BAR;
            PG8_LDA(At, 1, 1); PG8_STAGE(PG8_SA(1, 0), a3, voffA);
            PG8_BAR; PG8_WAIT_L(0); PG8_MMA(1, 0, At, B0); PG8_BAR; PG8_SCHED;
            PG8_STAGE(PG8_SB(1, 1), b3 + hstep, voffB);
            PG8_WAIT_V(6); PG8_BAR; PG8_MMA(1, 1, At, B1); PG8_BAR;
            }
        }
        if constexpr (ALIGN_EPI) { if (wr == 0) PG8_BAR; }
        if constexpr (!Epi::AFTER_DRAIN) { E(acc, cur, wr, wc, fr, fq); S.done(cur); }
        if (!has_next) break;
#pragma unroll
        for (int a = 0; a < 2; ++a)
#pragma unroll
            for (int b = 0; b < 2; ++b)
#pragma unroll
                for (int m = 0; m < 4; ++m)
#pragma unroll
                    for (int n = 0; n < 2; ++n) acc[a][b][m][n] = (f32x4){0.f, 0.f, 0.f, 0.f};
        cur = nxt; cA = nA; cB = nB; ++ui;
        if constexpr (ALIGN_EPI) { if (wr == 1) PG8_BAR; }
    }
    PG8_WAIT_V(0);
    if constexpr (!ALIGN_EPI) { if (wr == 0) PG8_BAR; }
    PG8_BAR;
    if constexpr (Epi::AFTER_DRAIN) { E.fused(acc, cur, wr, wc, fr, fq, lds, wid, lane); S.done(cur); }
#undef PG8_SA
#undef PG8_SB
#undef PG8_STAGE
#undef PG8_LDA
#undef PG8_LDB
#undef PG8_MMA
#undef PG8_WAIT_V
#undef PG8_WAIT_L
#undef PG8_BAR
#undef PG8_SCHED
}
}
#define LAS __attribute__((address_space(3)))
typedef unsigned short bf16;
typedef float f32x4 __attribute__((ext_vector_type(4)));
typedef float f32x2 __attribute__((ext_vector_type(2)));
typedef short bf16x8 __attribute__((ext_vector_type(8)));
typedef unsigned v4u __attribute__((ext_vector_type(4)));
typedef unsigned v2u __attribute__((ext_vector_type(2)));

constexpr int NTHR = 512;
constexpr int LDS_BYTES = 155648;
constexpr int DM = 2048, TLAT = 8192, TCTX = 256, TTOK = 8448, PINP = 7680, DFF = 8192;
constexpr size_t MiB = 1u << 20;
constexpr size_t WS_MOD = 0;
constexpr size_t WS_DL = 256 * 1024;
constexpr size_t WS_BONUS = 512 * 1024;
constexpr size_t WS_LATC = 2 * MiB;
constexpr size_t WS_WT_IN = 4 * MiB, WS_WT_OUT = 34 * MiB, WS_WT_1 = 42 * MiB, WS_WT_2 = 74 * MiB;
constexpr size_t WS_H = 106 * MiB;
constexpr size_t WS_SZ = 139 * MiB;
constexpr size_t WS_GATE = WS_SZ + (size_t)TTOK * 1024 * 2;
constexpr size_t WS_P = 172 * MiB;
constexpr size_t WS_GDN = 420 * MiB;
constexpr size_t WS_RWD = 569 * MiB;
constexpr size_t WS_RWS = WS_RWD + (size_t)2 * 16 * TTOK * 512;
constexpr size_t WS_END = WS_RWS + (size_t)16 * TTOK * 384;
static_assert(WS_GATE + (size_t)TTOK * 1024 * 2 <= WS_P && WS_P + (size_t)TTOK * PINP * 4 <= WS_GDN && WS_GDN + (size_t)2 * 8 * 132 * 36864 * 2 <= WS_RWD, "ws map");
static_assert(WS_END <= 768 * MiB, "ws size");

struct Params { const float* in[28]; float* out; unsigned char* ws; int ph_lo, ph_hi; };

__device__ __forceinline__ unsigned f2bf(float f) { unsigned u = __builtin_bit_cast(unsigned, f); return (u + 0x7fffu + ((u >> 16) & 1u)) >> 16; }
__device__ __forceinline__ unsigned pk2(float lo, float hi) { return f2bf(lo) | (f2bf(hi) << 16); }
__device__ __forceinline__ float bf2f(unsigned b) { return __builtin_bit_cast(float, b << 16); }
__device__ __forceinline__ float bflo(unsigned w) { return __builtin_bit_cast(float, w << 16); }
__device__ __forceinline__ float bfhi(unsigned w) { return __builtin_bit_cast(float, w & 0xffff0000u); }
__device__ __forceinline__ float wave_sum(float v) {
#pragma unroll
    for (int o = 1; o < 64; o <<= 1) v += __shfl_xor(v, o);
    return v;
}
__device__ __forceinline__ float sigmoidf_(float x) { return 1.f / (1.f + expf(-x)); }
__device__ __forceinline__ float siluf_(float x) { return x / (1.f + expf(-x)); }
__device__ __forceinline__ float softplusf_(float x) { return x > 20.f ? x : log1pf(expf(x)); }
#define LDS_WAIT() asm volatile("s_waitcnt lgkmcnt(0)" ::: "memory")

__device__ __forceinline__ void transpose_item(const float* W, int K, int N, bf16* WT, float* scr, int item, int lane) {
    const int nblk = N / 32, kb = item / nblk, nb = item % nblk, k0 = 64 * kb, n0 = 32 * nb;
#pragma unroll 8
    for (int i = 0; i < 32; ++i) { const int kk = 2 * i + (lane >> 5); scr[kk * 33 + (lane & 31)] = W[(size_t)(k0 + kk) * N + n0 + (lane & 31)]; }
    LDS_WAIT();
    const int c = lane & 7;
#pragma unroll
    for (int j = 0; j < 4; ++j) { const int n = (lane >> 3) + 8 * j; const float* s = scr + (8 * c) * 33 + n;
        v4u o; o.x = pk2(s[0 * 33], s[1 * 33]); o.y = pk2(s[2 * 33], s[3 * 33]); o.z = pk2(s[4 * 33], s[5 * 33]); o.w = pk2(s[6 * 33], s[7 * 33]);
        *(v4u*)(WT + (size_t)(n0 + n) * K + k0 + 8 * c) = o; }
    LDS_WAIT();
}
__device__ __forceinline__ void convert_weights(const Params& p, int l, int gw, int ngw, float* scr, int lane) {
    const float* w_in = p.in[8] + (size_t)l * 2048 * 7616; const float* w_out = p.in[24] + (size_t)l * 2048 * 2048;
    const float* w1 = p.in[25] + (size_t)l * 2048 * 8192; const float* w2 = p.in[26] + (size_t)l * 8192 * 2048;
    bf16* t_in = (bf16*)(p.ws + WS_WT_IN); bf16* t_out = (bf16*)(p.ws + WS_WT_OUT); bf16* t_1 = (bf16*)(p.ws + WS_WT_1); bf16* t_2 = (bf16*)(p.ws + WS_WT_2);
    for (int it = gw; it < 26048; it += ngw) {
        int r = it;
        if (r < 7616) { transpose_item(w_in, 2048, 7616, t_in, scr, r, lane); continue; } r -= 7616;
        if (r < 2048) { transpose_item(w_out, 2048, 2048, t_out, scr, r, lane); continue; } r -= 2048;
        if (r < 8192) { transpose_item(w1, 2048, 8192, t_1, scr, r, lane); continue; } r -= 8192;
        transpose_item(w2, 8192, 2048, t_2, scr, r, lane);
    }
}
__device__ __forceinline__ void phase0(const Params& p, float* L) {
    const int tid = otid(), lane = tid & 63, wave = tid >> 6, G = gridDim.x, b = blockIdx.x;
    { v4u z = {0u, 0u, 0u, 0u}; v4u* dst = (v4u*)((bf16*)(p.ws + WS_WT_IN) + (size_t)7616 * 2048);
      for (int i = b * NTHR + tid; i < 64 * 2048 / 8; i += G * NTHR) dst[i] = z; }
    convert_weights(p, 0, b * 8 + wave, G * 8, L + wave * 2112, lane);
    __syncthreads();
    float* sl = L; float* sc = L + 2048; float* red = L + 4096;
    for (int k = tid; k < 2048; k += NTHR) { sl[k] = siluf_(p.in[1][k]); sc[k] = siluf_(p.in[3][k]); }
    __syncthreads();
    for (int it = b; it < 768; it += G) {
        const int l = it / 384, cb = it % 384, col = cb * 32 + (tid & 31), kp = tid >> 5;
        const float* W = p.in[4] + (size_t)l * 2048 * 12288 + col;
        float a0 = 0.f, a1 = 0.f;
#pragma unroll 8
        for (int k = kp * 128; k < kp * 128 + 128; ++k) { const float w = W[(size_t)k * 12288]; a0 += sl[k] * w; a1 += sc[k] * w; }
        red[(kp * 32 + (tid & 31)) * 2] = a0; red[(kp * 32 + (tid & 31)) * 2 + 1] = a1;
        __syncthreads();
        if (tid < 64) { const int cls = tid >> 5, c = tid & 31; float s = p.in[5][l * 12288 + cb * 32 + c];
            for (int q = 0; q < 16; ++q) s += red[(q * 32 + c) * 2 + cls];
            ((float*)(p.ws + WS_MOD))[(l * 2 + cls) * 12288 + cb * 32 + c] = s; }
        __syncthreads();
    }
}

__device__ __forceinline__ void norm_phase(const Params& p, int l, const float* xl, const float* xc, const float* g, int sh_idx, int sc_idx, int nrows) {
    const int tid = otid(), lane = tid & 63, gw = blockIdx.x * 8 + (tid >> 6), ngw = gridDim.x * 8;
    bf16* H = (bf16*)(p.ws + WS_H);
    const float* mod = (const float*)(p.ws + WS_MOD) + (size_t)l * 2 * 12288;
    for (int row = gw; row < nrows; row += ngw) {
        const bool isc = row >= TLAT;
        const float* xr = isc ? xc + (size_t)(row - TLAT) * DM : xl + (size_t)row * DM;
        const float* md = mod + (isc ? 12288 : 0);
        f32x4 v[8]; float ss = 0.f;
#pragma unroll
        for (int j = 0; j < 8; ++j) { v[j] = ((const f32x4*)xr)[lane + 64 * j]; ss += v[j].x * v[j].x + v[j].y * v[j].y + v[j].z * v[j].z + v[j].w * v[j].w; }
        const float rstd = rsqrtf(wave_sum(ss) * (1.f / DM) + 1e-6f);
#pragma unroll
        for (int j = 0; j < 8; ++j) { const int col = 4 * (lane + 64 * j);
            const f32x4 gg = *(const f32x4*)(g + col), s1 = *(const f32x4*)(md + sc_idx * DM + col), s0 = *(const f32x4*)(md + sh_idx * DM + col);
            const f32x4 y = v[j] * rstd * gg * (1.f + s1) + s0;
            v2u o; o.x = pk2(y.x, y.y); o.y = pk2(y.z, y.w);
            *(v2u*)(H + (size_t)row * DM + col) = o; }
    }
}
__device__ __forceinline__ void final_norm(const Params& p) {
    const int tid = otid(), lane = tid & 63, gw = blockIdx.x * 8 + (tid >> 6), ngw = gridDim.x * 8;
    const float* g = p.in[27];
    for (int row = gw; row < TLAT; row += ngw) {
        float* xr = p.out + (size_t)row * DM;
        f32x4 v[8]; float ss = 0.f;
#pragma unroll
        for (int j = 0; j < 8; ++j) { v[j] = ((const f32x4*)xr)[lane + 64 * j]; ss += v[j].x * v[j].x + v[j].y * v[j].y + v[j].z * v[j].z + v[j].w * v[j].w; }
        const float rstd = rsqrtf(wave_sum(ss) * (1.f / DM) + 1e-6f);
#pragma unroll
        for (int j = 0; j < 8; ++j) { const f32x4 gg = ((const f32x4*)g)[lane + 64 * j]; ((f32x4*)xr)[lane + 64 * j] = v[j] * rstd * gg; }
    }
}
__device__ __forceinline__ void gdn_prep_item(const Params& p, int l, int item, float* L) {
    const int tid = otid(), lane = tid & 63, wave = tid >> 6;
    const int h = item & 7, ch = item >> 3;
    const bool isctx = ch >= 128;
    const int seg0 = isctx ? TLAT : 0, seglen = isctx ? TCTX : TLAT, t0 = isctx ? (ch - 128) * 64 : ch * 64;
    const float* P = (const float*)(p.ws + WS_P);
    const float* cw = p.in[9] + (size_t)l * 3 * 3072;
    float* qs = L; float* ks = L + 8448; float* KKm = L + 16896; float* QKm = L + 21056; float* TI = L + 25216;
    float* Gs = L + 33920; float* BETA = Gs + 128; float* EG = Gs + 256; float* GL = Gs + 384;
    bf16* const gd0 = (bf16*)(p.ws + WS_GDN) + ((size_t)h * 132 + (isctx ? (ch - 128) : 4 + ch)) * 36864;
    bf16* const gd1 = (bf16*)(p.ws + WS_GDN) + ((size_t)(8 + h) * 132 + (isctx ? 3 - (ch - 128) : 4 + 127 - ch)) * 36864;
#define GDP(d) ((d) ? gd1 : gd0)
    {
        const int i = tid >> 3, c0 = (tid & 7) * 16, tk = t0 + i;
        const size_t prow = (size_t)(seg0 + tk) * PINP;
#pragma unroll
        for (int which = 0; which < 2; ++which) {
            const int col = which * 1024 + h * 128 + c0;
            f32x4 y[4]; float ss = 0.f;
#pragma unroll
            for (int jj = 0; jj < 4; ++jj) {
                const f32x4 x0 = *(const f32x4*)(P + prow + col + 4 * jj);
                f32x4 xm = {0.f, 0.f, 0.f, 0.f}, xp = {0.f, 0.f, 0.f, 0.f};
                if (tk > 0) xm = *(const f32x4*)(P + prow - PINP + col + 4 * jj);
                if (tk < seglen - 1) xp = *(const f32x4*)(P + prow + PINP + col + 4 * jj);
                const f32x4 w0 = *(const f32x4*)(cw + col + 4 * jj), w1 = *(const f32x4*)(cw + 3072 + col + 4 * jj), w2 = *(const f32x4*)(cw + 6144 + col + 4 * jj);
                f32x4 t = xm * w0 + x0 * w1 + xp * w2;
                t.x = siluf_(t.x); t.y = siluf_(t.y); t.z = siluf_(t.z); t.w = siluf_(t.w);
                y[jj] = t; ss += t.x * t.x + t.y * t.y + t.z * t.z + t.w * t.w;
            }
            ss += __shfl_xor(ss, 1); ss += __shfl_xor(ss, 2); ss += __shfl_xor(ss, 4);
            const float sc = rsqrtf(ss + 1e-6f) * (which == 0 ? 0.08838834764831845f : 1.f);
            float* dst = (which ? ks : qs) + i * 132 + c0;
#pragma unroll
            for (int jj = 0; jj < 4; ++jj) *(f32x4*)(dst + 4 * jj) = y[jj] * sc;
        }
        {
            const int col = 3072 + h * 128 + c0; unsigned o[8];
#pragma unroll
            for (int jj = 0; jj < 4; ++jj) { const f32x4 z = *(const f32x4*)(P + prow + col + 4 * jj);
                o[2 * jj] = pk2(siluf_(z.x), siluf_(z.y)); o[2 * jj + 1] = pk2(siluf_(z.z), siluf_(z.w)); }
            bf16* sz = (bf16*)(p.ws + WS_SZ) + (size_t)(seg0 + tk) * 1024 + h * 128 + c0;
            *(v4u*)sz = (v4u){o[0], o[1], o[2], o[3]}; *(v4u*)(sz + 8) = (v4u){o[4], o[5], o[6], o[7]};
        }
    }
    if (tid < 128) {
        const int d = tid >> 6, ip = tid & 63, i = d ? 63 - ip : ip;
        const size_t prow = (size_t)(seg0 + t0 + i) * PINP;
        const float bb = P[prow + 4096 + d * 8 + h], al = P[prow + 4112 + d * 8 + h];
        const float A = expf(p.in[10][l * 16 + d * 8 + h]);
        float g = -A * softplusf_(al + p.in[11][l * 16 + d * 8 + h]);
#pragma unroll
        for (int o = 1; o < 64; o <<= 1) { const float t = __shfl_up(g, o); if (ip >= o) g += t; }
        Gs[d * 64 + ip] = g; BETA[d * 64 + ip] = sigmoidf_(bb); EG[d * 64 + ip] = expf(g);
        if (ip == 63) { GL[d] = g;
            const int np = isctx ? (d ? 3 - (ch - 128) : (ch - 128)) : (d ? 4 + 127 - ch : 4 + ch);
            ((float*)(p.ws + WS_DL))[(d * 8 + h) * 132 + np] = expf(g); }
    }
    __syncthreads();
    {
        const int ia = tid >> 4, jb = tid & 15;
        float akk[2][4], aqk[2][4];
#pragma unroll
        for (int a = 0; a < 2; ++a)
#pragma unroll
            for (int bq = 0; bq < 4; ++bq) { akk[a][bq] = 0.f; aqk[a][bq] = 0.f; }
        for (int c = 0; c < 128; c += 4) {
            f32x4 ki[2], qi[2], kj[4];
#pragma unroll
            for (int a = 0; a < 2; ++a) { ki[a] = *(const f32x4*)(ks + (ia + 32 * a) * 132 + c); qi[a] = *(const f32x4*)(qs + (ia + 32 * a) * 132 + c); }
#pragma unroll
            for (int bq = 0; bq < 4; ++bq) kj[bq] = *(const f32x4*)(ks + (jb + 16 * bq) * 132 + c);
#pragma unroll
            for (int a = 0; a < 2; ++a)
#pragma unroll
                for (int bq = 0; bq < 4; ++bq) {
                    akk[a][bq] += ki[a].x * kj[bq].x + ki[a].y * kj[bq].y + ki[a].z * kj[bq].z + ki[a].w * kj[bq].w;
                    aqk[a][bq] += qi[a].x * kj[bq].x + qi[a].y * kj[bq].y + qi[a].z * kj[bq].z + qi[a].w * kj[bq].w; }
        }
#pragma unroll
        for (int a = 0; a < 2; ++a)
#pragma unroll
            for (int bq = 0; bq < 4; ++bq) { KKm[(ia + 32 * a) * 65 + jb + 16 * bq] = akk[a][bq]; QKm[(ia + 32 * a) * 65 + jb + 16 * bq] = aqk[a][bq]; }
    }
    __syncthreads();
#pragma unroll 4
    for (int e = 0; e < 16; ++e) { const int idx = tid + 512 * e, d = idx >> 12, ip = (idx >> 6) & 63, jp = idx & 63;
        const int ri = d ? 63 - ip : ip, rj = d ? 63 - jp : jp;
        float v = 0.f;
        if (jp < ip) v = BETA[d * 64 + ip] * KKm[ri * 65 + rj] * expf(Gs[d * 64 + ip] - Gs[d * 64 + jp]);
        TI[d * 4352 + ip * 68 + jp] = v; }
    __syncthreads();
    if (wave < 2) {
        const int d = wave; float X[64];
        const float* Lb = TI + d * 4352;
#pragma unroll
        for (int i = 0; i < 64; ++i) {
            float acc = (i == lane) ? 1.f : 0.f;
#pragma unroll
            for (int j4 = 0; j4 < i; j4 += 4) {
                const f32x4 lv = *(const f32x4*)(Lb + i * 68 + j4);
                acc -= lv.x * X[j4];
                if (j4 + 1 < i) acc -= lv.y * X[j4 + 1];
                if (j4 + 2 < i) acc -= lv.z * X[j4 + 2];
                if (j4 + 3 < i) acc -= lv.w * X[j4 + 3];
            }
            X[i] = acc;
        }
        LDS_WAIT();
#pragma unroll
        for (int i = 0; i < 64; ++i) TI[d * 4352 + i * 68 + lane] = X[i];
    } else {
        const int t2 = tid - 128;
        for (int idx = t2; idx < 2048; idx += 384) {
            const int d = idx >> 10, ip = (idx >> 4) & 63, c8 = idx & 15, ri = d ? 63 - ip : ip; const float e = EG[d * 64 + ip];
            const f32x4 a = *(const f32x4*)(qs + ri * 132 + c8 * 8), bq = *(const f32x4*)(qs + ri * 132 + c8 * 8 + 4);
            *(v4u*)(GDP(d) + 8192 + ip * 128 + c8 * 8) = (v4u){pk2(a.x * e, a.y * e), pk2(a.z * e, a.w * e), pk2(bq.x * e, bq.y * e), pk2(bq.z * e, bq.w * e)};
        }
        for (int idx = t2; idx < 2048; idx += 384) {
            const int d = idx >> 10, c = (idx >> 3) & 127, i8 = idx & 7; const float gl = GL[d]; float v[8];
#pragma unroll
            for (int e = 0; e < 8; ++e) { const int ip = i8 * 8 + e, ri = d ? 63 - ip : ip; v[e] = ks[ri * 132 + c] * expf(gl - Gs[d * 64 + ip]); }
            *(v4u*)(GDP(d) + 16384 + c * 64 + i8 * 8) = (v4u){pk2(v[0], v[1]), pk2(v[2], v[3]), pk2(v[4], v[5]), pk2(v[6], v[7])};
        }
        for (int idx = t2; idx < 1024; idx += 384) {
            const int d = idx >> 9, ip = (idx >> 3) & 63, j8 = idx & 7, ri = d ? 63 - ip : ip; const float gi = Gs[d * 64 + ip]; float v[8];
#pragma unroll
            for (int e = 0; e < 8; ++e) { const int jp = j8 * 8 + e, rj = d ? 63 - jp : jp; v[e] = (jp <= ip) ? QKm[ri * 65 + rj] * expf(gi - Gs[d * 64 + jp]) : 0.f; }
            *(v4u*)(GDP(d) + 24576 + ip * 64 + j8 * 8) = (v4u){pk2(v[0], v[1]), pk2(v[2], v[3]), pk2(v[4], v[5]), pk2(v[6], v[7])};
        }
    }
    __syncthreads();
    {
        const int i = tid >> 3, c0 = (tid & 7) * 16, tk = t0 + i; const size_t prow = (size_t)(seg0 + tk) * PINP; const int col = 2048 + h * 128 + c0;
#pragma unroll
        for (int jj = 0; jj < 4; ++jj) {
            const f32x4 x0 = *(const f32x4*)(P + prow + col + 4 * jj);
            f32x4 xm = {0.f, 0.f, 0.f, 0.f}, xp = {0.f, 0.f, 0.f, 0.f};
            if (tk > 0) xm = *(const f32x4*)(P + prow - PINP + col + 4 * jj);
            if (tk < seglen - 1) xp = *(const f32x4*)(P + prow + PINP + col + 4 * jj);
            const f32x4 w0 = *(const f32x4*)(cw + col + 4 * jj), w1 = *(const f32x4*)(cw + 3072 + col + 4 * jj), w2 = *(const f32x4*)(cw + 6144 + col + 4 * jj);
            f32x4 t = xm * w0 + x0 * w1 + xp * w2;
            t.x = siluf_(t.x); t.y = siluf_(t.y); t.z = siluf_(t.z); t.w = siluf_(t.w);
            *(f32x4*)(qs + i * 132 + c0 + 4 * jj) = t;
        }
    }
    const int d5 = tid >> 8, tt = tid & 255, ig = tt >> 4, cg = tt & 15, jmax = ig * 4 + 3;
#pragma unroll
    for (int pass = 0; pass < 2; ++pass) {
        if (pass == 1) __syncthreads();
        const float* src = pass ? qs : ks;
        f32x4 acc[4][2];
#pragma unroll
        for (int ii = 0; ii < 4; ++ii) { acc[ii][0] = (f32x4){0.f, 0.f, 0.f, 0.f}; acc[ii][1] = (f32x4){0.f, 0.f, 0.f, 0.f}; }
        for (int j = 0; j <= jmax; ++j) {
            const int rj = d5 ? 63 - j : j;
            const float cf = pass ? BETA[d5 * 64 + j] : BETA[d5 * 64 + j] * EG[d5 * 64 + j];
            const f32x4 k0 = *(const f32x4*)(src + rj * 132 + cg * 4), k1 = *(const f32x4*)(src + rj * 132 + 64 + cg * 4);
#pragma unroll
            for (int ii = 0; ii < 4; ++ii) { const float t = TI[d5 * 4352 + (ig * 4 + ii) * 68 + j] * cf; acc[ii][0] += t * k0; acc[ii][1] += t * k1; }
        }
        bf16* dst = GDP(d5) + (pass ? 28672 : 0);
#pragma unroll
        for (int ii = 0; ii < 4; ++ii) {
            *(v2u*)(dst + (ig * 4 + ii) * 128 + cg * 4) = (v2u){pk2(acc[ii][0].x, acc[ii][0].y), pk2(acc[ii][0].z, acc[ii][0].w)};
            *(v2u*)(dst + (ig * 4 + ii) * 128 + 64 + cg * 4) = (v2u){pk2(acc[ii][1].x, acc[ii][1].y), pk2(acc[ii][1].z, acc[ii][1].w)};
        }
    }
    __syncthreads();
}

__device__ __forceinline__ void rw_tok(int sf, int& prow, int& up, int& dn) {
    if (sf < TCTX) { prow = TLAT + sf; up = sf > 0 ? prow - 1 : -1; dn = sf < TCTX - 1 ? prow + 1 : -1; }
    else { const int j = sf - TCTX, r = j & 127, cc = j >> 7; prow = r * 64 + cc; up = r > 0 ? prow - 64 : -1; dn = r < 127 ? prow + 64 : -1; }
}
__device__ __forceinline__ float rw_shift(const float* P, const float* mu, int prow, int up, int dn, int col) {
    const float x = P[(size_t)prow * PINP + 4128 + col];
    const float u = up >= 0 ? P[(size_t)up * PINP + 4128 + col] : 0.f;
    const float dv = dn >= 0 ? P[(size_t)dn * PINP + 4128 + col] : 0.f;
    return x + mu[col] * (0.5f * (u + dv) - x);
}
#define RW_NT 11
#define RW_MATMUL(Wm, KK_, koff) do { \
    _Pragma("unroll") for (int t = 0; t < RW_NT; ++t) { acc[t][0] = 0.f; acc[t][1] = 0.f; } \
    _Pragma("unroll 1") for (int k = 0; k < (KK_); k += 4) { float w0[4], w1[4]; \
        _Pragma("unroll") for (int kk = 0; kk < 4; ++kk) { w0[kk] = (Wm)[(size_t)(k + kk) * 1024 + c0]; w1[kk] = (Wm)[(size_t)(k + kk) * 1024 + c1]; } \
        _Pragma("unroll") for (int t = 0; t < RW_NT; ++t) { const f32x4 a = *(const f32x4*)(act + t * 416 + (koff) + k); \
            acc[t][0] += a.x * w0[0] + a.y * w0[1] + a.z * w0[2] + a.w * w0[3]; acc[t][1] += a.x * w1[0] + a.y * w1[1] + a.z * w1[2] + a.w * w1[3]; } } } while (0)
__device__ __forceinline__ void rwkv_prep_item(const Params& p, int l, int item, float* L) {
    const int tid = otid(), lane = tid & 63, wave = tid >> 6;
    const float* P = (const float*)(p.ws + WS_P);
    const float* mu = p.in[13] + (size_t)l * 3488;
    float* act = L; float* bon = L + RW_NT * 416;
    const int sf0 = item * RW_NT, c0 = tid, c1 = tid + 512;
    for (int e = tid; e < RW_NT * 416; e += NTHR) { const int t = e / 416, cc = e % 416; int prow, up, dn; rw_tok(sf0 + t, prow, up, dn);
        float v = rw_shift(P, mu, prow, up, dn, 3072 + cc);
        if (cc < 128) v = tanhf(v); else if (cc >= 256) v = sigmoidf_(v);
        act[e] = v; }
    for (int e = tid; e < RW_NT * 16; e += NTHR) bon[e] = 0.f;
    int* tinfo = (int*)(bon + RW_NT * 16);
    if (tid < RW_NT) { int prow, up, dn; rw_tok(sf0 + tid, prow, up, dn); tinfo[tid * 4] = prow; tinfo[tid * 4 + 1] = up; tinfo[tid * 4 + 2] = dn; }
    __syncthreads();
    float acc[RW_NT][2];
    const float* w0p = p.in[14] + (size_t)l * 2048; const float* a0p = p.in[16] + (size_t)l * 2048;
    const float* w2p = p.in[15] + (size_t)l * 2 * 64 * 1024; const float* a2p = p.in[17] + (size_t)l * 2 * 64 * 1024; const float* g2p = p.in[18] + (size_t)l * 160 * 1024;
    const float* k_k = p.in[19] + (size_t)l * 1024; const float* k_a = p.in[20] + (size_t)l * 1024; const float* r_k = p.in[21] + (size_t)l * 1024;
    unsigned char* RD = p.ws + WS_RWD; unsigned char* RS = p.ws + WS_RWS;
#pragma unroll 1
    for (int d = 0; d < 2; ++d) {
        RW_MATMUL(w2p + (size_t)d * 65536, 64, d * 64);
#pragma unroll
        for (int t = 0; t < RW_NT; ++t) { const int sf = sf0 + t, s = d ? (sf < TCTX ? TCTX - 1 - sf : 8703 - sf) : sf;
#pragma unroll
            for (int cc = 0; cc < 2; ++cc) { const int c = cc ? c1 : c0, hh = c >> 6;
                const float x = w0p[d * 1024 + c] + acc[t][cc];
                const float wl = -softplusf_(-x) - 0.5f;
                *(float*)(RD + ((size_t)(d * 16 + hh) * TTOK + s) * 512 + (c & 63) * 4) = expf(-expf(wl)); } }
        RW_MATMUL(a2p + (size_t)d * 65536, 64, 128 + d * 64);
#pragma unroll
        for (int t = 0; t < RW_NT; ++t) { const int sf = sf0 + t, s = d ? (sf < TCTX ? TCTX - 1 - sf : 8703 - sf) : sf; const int prow = tinfo[t * 4], up = tinfo[t * 4 + 1], dn = tinfo[t * 4 + 2];
#pragma unroll
            for (int cc = 0; cc < 2; ++cc) { const int c = cc ? c1 : c0, hh = c >> 6;
                const float a = sigmoidf_(a0p[d * 1024 + c] + acc[t][cc]);
                const float k = rw_shift(P, mu, prow, up, dn, 1024 + c), r = rw_shift(P, mu, prow, up, dn, c);
                const float kkr = k * k_k[c];
                const float kk = kkr * rsqrtf(wave_sum(kkr * kkr) + 1e-6f);
                const float kd = k * (1.f + (a - 1.f) * k_a[c]);
                unsigned char* rec = RD + ((size_t)(d * 16 + hh) * TTOK + s) * 512;
                *(bf16*)(rec + 256 + (c & 63) * 2) = (bf16)f2bf(kd);
                *(bf16*)(rec + 384 + (c & 63) * 2) = (bf16)f2bf(kk * a);
                const float bp = wave_sum(r * kd * r_k[c]);
                if (lane == 0) bon[t * 16 + hh] += bp;
                if (d == 0) { unsigned char* rs = RS + ((size_t)hh * TTOK + sf) * 384;
                    *(bf16*)(rs + (c & 63) * 2) = (bf16)f2bf(r);
                    *(bf16*)(rs + 128 + (c & 63) * 2) = (bf16)f2bf(kk);
                    *(bf16*)(rs + 256 + (c & 63) * 2) = (bf16)f2bf(rw_shift(P, mu, prow, up, dn, 2048 + c)); }
            } }
    }
    RW_MATMUL(g2p, 160, 256);
#pragma unroll
    for (int t = 0; t < RW_NT; ++t) { const int prow = tinfo[t * 4];
        bf16* gt = (bf16*)(p.ws + WS_GATE) + (size_t)prow * 1024;
        gt[c0] = (bf16)f2bf(acc[t][0]); gt[c1] = (bf16)f2bf(acc[t][1]); }
    __syncthreads();
    for (int e = tid; e < RW_NT * 16; e += NTHR) { int prow, up, dn; rw_tok(sf0 + e / 16, prow, up, dn); ((float*)(p.ws + WS_BONUS))[prow * 16 + (e & 15)] = bon[e]; }
    __syncthreads();
}
__device__ __forceinline__ f32x4 mfma16(bf16x8 a, bf16x8 b, f32x4 c) { return __builtin_amdgcn_mfma_f32_16x16x32_bf16(a, b, c, 0, 0, 0); }
__device__ __forceinline__ void gdn_scan(const Params& p, int b, unsigned char* lds) {
    const int tid = otid(), lane = tid & 63, wave = tid >> 6, r = lane & 15, q = lane >> 4;
    const int s = b & 3, h = (b >> 2) & 7, d = b >> 5;
    bf16* Wb = (bf16*)lds; bf16* Qb = Wb + 2 * 8704; bf16* KTb = Qb + 2 * 8704; bf16* Ab = KTb + 2 * 9216; bf16* Ub = Ab + 2 * 4608; bf16* ST = Ub + 2 * 2560; bf16* VT = ST + 4352;
    const bf16* G = (const bf16*)(p.ws + WS_GDN) + (size_t)((d * 8 + h) * 132) * 36864;
    const float* DLp = (const float*)(p.ws + WS_DL) + (d * 8 + h) * 132;
    float* O = (float*)(p.ws + WS_P) + (size_t)d * TTOK * 1024 + h * 128 + s * 32;
    for (int e = tid; e < 4352; e += NTHR) ST[e] = 0;
    f32x4 S0 = {0.f, 0.f, 0.f, 0.f}, S1 = {0.f, 0.f, 0.f, 0.f};
    v4u pw0, pw1, pq0, pq1, pk0, pk1, pa, pu;
    pu = (v4u){0u, 0u, 0u, 0u};
#define GDN_LOAD(n) do { const bf16* g_ = G + (size_t)(n) * 36864; \
        pw0 = *(const v4u*)(g_ + tid * 8); pw1 = *(const v4u*)(g_ + (tid + 512) * 8); \
        pq0 = *(const v4u*)(g_ + 8192 + tid * 8); pq1 = *(const v4u*)(g_ + 8192 + (tid + 512) * 8); \
        pk0 = *(const v4u*)(g_ + 16384 + tid * 8); pk1 = *(const v4u*)(g_ + 16384 + (tid + 512) * 8); \
        pa = *(const v4u*)(g_ + 24576 + tid * 8); \
        if (tid < 256) pu = *(const v4u*)(g_ + 28672 + (tid >> 2) * 128 + s * 32 + (tid & 3) * 8); } while (0)
#define GDN_STORE(bf) do { \
        *(v4u*)(Wb + (bf) * 8704 + (tid >> 4) * 136 + (tid & 15) * 8) = pw0; *(v4u*)(Wb + (bf) * 8704 + ((tid + 512) >> 4) * 136 + (tid & 15) * 8) = pw1; \
        *(v4u*)(Qb + (bf) * 8704 + (tid >> 4) * 136 + (tid & 15) * 8) = pq0; *(v4u*)(Qb + (bf) * 8704 + ((tid + 512) >> 4) * 136 + (tid & 15) * 8) = pq1; \
        *(v4u*)(KTb + (bf) * 9216 + (tid >> 3) * 72 + (tid & 7) * 8) = pk0; *(v4u*)(KTb + (bf) * 9216 + ((tid + 512) >> 3) * 72 + (tid & 7) * 8) = pk1; \
        *(v4u*)(Ab + (bf) * 4608 + (tid >> 3) * 72 + (tid & 7) * 8) = pa; \
        if (tid < 256) *(v4u*)(Ub + (bf) * 2560 + (tid >> 2) * 40 + (tid & 3) * 8) = pu; } while (0)
    GDN_LOAD(0); GDN_STORE(0);
    __syncthreads();
    const int mi = wave >> 1, nv = wave & 1;
    for (int n = 0; n < 132; ++n) {
        const int bf = n & 1;
        if (n + 1 < 132) GDN_LOAD(n + 1);
        const float dl = DLp[n];
        f32x4 co = {0.f, 0.f, 0.f, 0.f}, cv = {0.f, 0.f, 0.f, 0.f};
#pragma unroll
        for (int kk = 0; kk < 4; ++kk) {
            const bf16x8 sa = *(const bf16x8*)(ST + (16 * nv + r) * 136 + kk * 32 + 8 * q);
            const bf16x8 qa = *(const bf16x8*)(Qb + bf * 8704 + (16 * mi + r) * 136 + kk * 32 + 8 * q);
            const bf16x8 wb = *(const bf16x8*)(Wb + bf * 8704 + (16 * mi + r) * 136 + kk * 32 + 8 * q);
            co = mfma16(qa, sa, co);
            cv = mfma16(sa, wb, cv);
        }
        {
            const v2u uu = *(const v2u*)(Ub + bf * 2560 + (16 * mi + r) * 40 + 16 * nv + 4 * q);
            const float v0 = bflo(uu.x) - cv.x, v1 = bfhi(uu.x) - cv.y, v2 = bflo(uu.y) - cv.z, v3 = bfhi(uu.y) - cv.w;
            bf16* vt = VT + (16 * nv + 4 * q) * 72 + 16 * mi + r;
            vt[0] = (bf16)f2bf(v0); vt[72] = (bf16)f2bf(v1); vt[144] = (bf16)f2bf(v2); vt[216] = (bf16)f2bf(v3);
        }
        __syncthreads();
#pragma unroll
        for (int kk = 0; kk < 2; ++kk) {
            const bf16x8 aa = *(const bf16x8*)(Ab + bf * 4608 + (16 * mi + r) * 72 + kk * 32 + 8 * q);
            const bf16x8 vb = *(const bf16x8*)(VT + (16 * nv + r) * 72 + kk * 32 + 8 * q);
            co = mfma16(aa, vb, co);
        }
        {
            const bool cx = n < 4;
#pragma unroll
            for (int j = 0; j < 4; ++j) { const int ip = 16 * mi + 4 * q + j;
                const int tok = d == 0 ? (cx ? TLAT + n * 64 + ip : (n - 4) * 64 + ip) : (cx ? TLAT + (3 - n) * 64 + 63 - ip : (131 - n) * 64 + 63 - ip);
                O[(size_t)tok * 1024 + 16 * nv + r] = co[j]; }
        }
#pragma unroll
        for (int e = 0; e < 2; ++e) {
            f32x4 Sv = (e ? S1 : S0) * dl; const int nk = 2 * mi + e;
#pragma unroll
            for (int kk = 0; kk < 2; ++kk) {
                const bf16x8 va = *(const bf16x8*)(VT + (16 * nv + r) * 72 + kk * 32 + 8 * q);
                const bf16x8 kb = *(const bf16x8*)(KTb + bf * 9216 + (16 * nk + r) * 72 + kk * 32 + 8 * q);
                Sv = mfma16(va, kb, Sv);
            }
            if (e) S1 = Sv; else S0 = Sv;
            bf16* st = ST + (16 * nv + 4 * q) * 136 + 16 * nk + r;
            st[0] = (bf16)f2bf(Sv.x); st[136] = (bf16)f2bf(Sv.y); st[272] = (bf16)f2bf(Sv.z); st[408] = (bf16)f2bf(Sv.w);
        }
        if (n + 1 < 132) GDN_STORE(bf ^ 1);
        __syncthreads();
    }
}
__device__ __forceinline__ float red16(float x) {
    x += __builtin_bit_cast(float, __builtin_amdgcn_update_dpp(0, __builtin_bit_cast(int, x), 0x128, 0xf, 0xf, false));
    x += __builtin_bit_cast(float, __builtin_amdgcn_update_dpp(0, __builtin_bit_cast(int, x), 0x124, 0xf, 0xf, false));
    x += __builtin_bit_cast(float, __builtin_amdgcn_update_dpp(0, __builtin_bit_cast(int, x), 0x122, 0xf, 0xf, false));
    x += __builtin_bit_cast(float, __builtin_amdgcn_update_dpp(0, __builtin_bit_cast(int, x), 0x121, 0xf, 0xf, false));
    return x;
}
__device__ __forceinline__ void rwkv_scan(const Params& p, int b, float* L) {
    const int tid = otid(), lane = tid & 63, wave = tid >> 6;
    const int pair = b >> 2, qt = b & 3, d = pair >> 4, h = pair & 15;
    const unsigned char* RD = p.ws + WS_RWD + (size_t)(d * 16 + h) * TTOK * 512;
    const unsigned char* RS = p.ws + WS_RWS + (size_t)h * TTOK * 384;
    float* O = (float*)(p.ws + WS_P) + (size_t)(2 + d) * TTOK * 1024 + h * 64 + qt * 16;
    constexpr int TB = 32, SF = 336, NCH = TTOK / TB;
    const int rl = (wave & 3) * 4 + (lane >> 4), kg = lane & 15;
    f32x4 S = {0.f, 0.f, 0.f, 0.f};
    for (int c = -1; c < NCH; ++c) {
        if (wave >= 4) {
            if (c + 1 < NCH) {
                float* buf = L + ((c + 1) & 1) * (TB * SF);
                for (int u = tid - 256; u < TB * 50; u += 256) {
                    const int st = u / 50, x = u % 50, s = (c + 1) * TB + st;
                    const int sf = d == 0 ? s : (s < TCTX ? TCTX - 1 - s : 8703 - s);
                    float* dst = buf + st * SF;
                    if (x < 16) { *(f32x4*)(dst + x * 4) = *(const f32x4*)(RD + (size_t)s * 512 + x * 16); }
                    else { const unsigned char* src = x < 32 ? RD + (size_t)s * 512 + 256 + (x - 16) * 16 : (x < 48 ? RS + (size_t)sf * 384 + (x - 32) * 16 : RS + (size_t)sf * 384 + 256 + qt * 32 + (x - 48) * 16);
                        float* dd = x < 32 ? dst + 64 + (x - 16) * 8 : (x < 48 ? dst + 192 + (x - 32) * 8 : dst + 320 + (x - 48) * 8);
                        const v4u v = *(const v4u*)src;
                        *(f32x4*)dd = (f32x4){bflo(v.x), bfhi(v.x), bflo(v.y), bfhi(v.y)}; *(f32x4*)(dd + 4) = (f32x4){bflo(v.z), bfhi(v.z), bflo(v.w), bfhi(v.w)}; }
                }
            }
        } else if (c >= 0) {
            const float* buf = L + (c & 1) * (TB * SF);
#pragma unroll 4
            for (int st = 0; st < TB; ++st) {
                const float* sp = buf + st * SF;
                const f32x4 w = *(const f32x4*)(sp + 4 * kg), kd = *(const f32x4*)(sp + 64 + 4 * kg), kka = *(const f32x4*)(sp + 128 + 4 * kg),
                            rr = *(const f32x4*)(sp + 192 + 4 * kg), kk = *(const f32x4*)(sp + 256 + 4 * kg);
                const float v = sp[320 + rl];
                float dot = S.x * kk.x + S.y * kk.y + S.z * kk.z + S.w * kk.w;
                dot = red16(dot);
                S = S * w + v * kd - dot * kka;
                float o = S.x * rr.x + S.y * rr.y + S.z * rr.z + S.w * rr.w;
                o = red16(o);
                if (kg == 0) { const int s = c * TB + st;
                    int tok; if (s < TCTX) tok = TLAT + (d ? TCTX - 1 - s : s); else { const int j = d ? 8447 - s : s - TCTX; tok = (j & 127) * 64 + (j >> 7); }
                    O[(size_t)tok * 1024 + rl] = o; }
            }
        }
        __syncthreads();
    }
}

__device__ __forceinline__ void combine_phase(const Params& p, int l, int ntok) {
    const int tid = otid(), lane = tid & 63, gw = blockIdx.x * 8 + (tid >> 6), ngw = gridDim.x * 8;
    const float* OG = (const float*)(p.ws + WS_P); const float* OR = OG + (size_t)2 * TTOK * 1024;
    const bf16* SZ = (const bf16*)(p.ws + WS_SZ); const bf16* GT = (const bf16*)(p.ws + WS_GATE);
    const float* BON = (const float*)(p.ws + WS_BONUS);
    bf16* Y = (bf16*)(p.ws + WS_H);
    const float* ng = p.in[12] + (size_t)l * 128; const float* lng = p.in[22] + (size_t)l * 1024; const float* lnb = p.in[23] + (size_t)l * 1024;
    const f32x2 g2 = *(const f32x2*)(ng + 2 * lane);
    for (int tok = gw; tok < ntok; tok += ngw) {
        const float* of = OG + (size_t)tok * 1024; const float* ob = of + (size_t)TTOK * 1024;
#pragma unroll
        for (int hh = 0; hh < 8; ++hh) {
            const f32x2 a = *(const f32x2*)(of + hh * 128 + 2 * lane) + *(const f32x2*)(ob + hh * 128 + 2 * lane);
            const float rstd = rsqrtf(wave_sum(a.x * a.x + a.y * a.y) * (1.f / 128.f) + 1e-6f);
            const unsigned sz = *(const unsigned*)(SZ + (size_t)tok * 1024 + hh * 128 + 2 * lane);
            *(unsigned*)(Y + (size_t)tok * 2048 + hh * 128 + 2 * lane) = pk2(a.x * rstd * g2.x * bflo(sz), a.y * rstd * g2.y * bfhi(sz));
        }
        int sf; if (tok >= TLAT) sf = tok - TLAT; else sf = TCTX + (tok & 63) * 128 + (tok >> 6);
        const float* rf = OR + (size_t)tok * 1024; const float* rb = rf + (size_t)TTOK * 1024;
#pragma unroll
        for (int hh = 0; hh < 16; ++hh) {
            const int c = hh * 64 + lane;
            const float o = rf[c] + rb[c];
            const float mean = wave_sum(o) * (1.f / 64.f), dv = o - mean;
            const float var = wave_sum(dv * dv) * (1.f / 64.f);
            float y = dv * rsqrtf(var + 64e-5f) * lng[c] + lnb[c];
            const float v = bf2f(*(const bf16*)(p.ws + WS_RWS + ((size_t)hh * TTOK + sf) * 384 + 256 + lane * 2));
            y = (y + BON[tok * 16 + hh] * v) * bf2f(GT[(size_t)tok * 1024 + c]);
            Y[(size_t)tok * 2048 + 1024 + c] = (bf16)f2bf(y);
        }
    }
}
#ifndef ONE_LAUNCH
#define ONE_LAUNCH 1
#endif
constexpr int N_PHASES = 20;
#if ONE_LAUNCH
#define PH(k) (true)
#define SEAM(k) cg::this_grid().sync()
#else
#define PH(k) (p.ph_lo == (k))
#define SEAM(k) do {} while (0)
#endif
#define PHON(k) ((PHMASK >> (k)) & 1)
template <int PHMASK, int l> __device__ __forceinline__ void layer_phases(const Params& p, unsigned char* lds) {
    float* L = (float*)lds;
    const int b = blockIdx.x, G = gridDim.x;
    float* lat_c = (float*)(p.ws + WS_LATC);
    const float* mod = (const float*)(p.ws + WS_MOD);
    constexpr int M = l == 0 ? TTOK : TLAT;
    constexpr int B0 = 1 + 9 * l;
    const float* res_l = l == 0 ? p.in[0] : p.out; const float* res_c = l == 0 ? p.in[2] : lat_c;
    const float* mod_l = mod + (size_t)(l * 2) * 12288; const float* mod_c = mod_l + 12288;
    if (PH(B0 + 0) && PHON(0)) {
        if (l == 1) { const int tid = otid(); convert_weights(p, 1, b * 8 + (tid >> 6), G * 8, L + (tid >> 6) * 2112, tid & 63); }
        norm_phase(p, l, res_l, res_c, p.in[6] + (size_t)l * DM, 0, 1, TTOK);
    }
    SEAM(B0 + 0);
    if (PH(B0 + 1) && PHON(1)) {
        pg8::Gemm g{(const pg8::bf16_t*)(p.ws + WS_H), (const pg8::bf16_t*)(p.ws + WS_WT_IN), TTOK, PINP, DM}; pg8::StaticOrder S; S.init(TTOK, PINP, G, b);
        pg8::EpiF32 E{(float*)(p.ws + WS_P), PINP};
        pg8::gemm_phase<pg8::EpiF32, pg8::StaticOrder, true, true>((PG8_LAS unsigned char*)lds, g, S, E);
    }
    SEAM(B0 + 1);
    if (PH(B0 + 2)) {
        if (PHON(2)) for (int it = b; it < 768; it += G) rwkv_prep_item(p, l, it, L);
        if (PHON(11)) for (int it = b; it < 1056; it += G) gdn_prep_item(p, l, it, L);
    }
    SEAM(B0 + 2);
    if (PH(B0 + 3) && PHON(3)) {
        if (b < 64) gdn_scan(p, b, lds);
        if (b >= 64 && b < 192) rwkv_scan(p, b - 64, L);
    }
    SEAM(B0 + 3);
    if (PH(B0 + 4) && PHON(4)) combine_phase(p, l, M);
    SEAM(B0 + 4);
    if (PH(B0 + 5) && PHON(5)) {
        pg8::Gemm g{(const pg8::bf16_t*)(p.ws + WS_H), (const pg8::bf16_t*)(p.ws + WS_WT_OUT), M, DM, DM}; pg8::StaticOrder S; S.init(M, DM, G, b);
        pg8::EpiRes E{res_l, res_c, p.out, lat_c, mod_l + 2 * DM, mod_c + 2 * DM};
        pg8::gemm_phase<pg8::EpiRes, pg8::StaticOrder, true, true>((PG8_LAS unsigned char*)lds, g, S, E);
    }
    SEAM(B0 + 5);
    if (PH(B0 + 6) && PHON(6)) norm_phase(p, l, p.out, lat_c, p.in[7] + (size_t)l * DM, 3, 4, M);
    SEAM(B0 + 6);
    if (PH(B0 + 7) && PHON(7)) {
        pg8::Gemm g{(const pg8::bf16_t*)(p.ws + WS_H), (const pg8::bf16_t*)(p.ws + WS_WT_1), M, DFF, DM}; pg8::StaticOrder S; S.init(M, DFF, G, b);
        pg8::EpiRelu2 E{(pg8::bf16_t*)(p.ws + WS_P), DFF};
        pg8::gemm_phase<pg8::EpiRelu2, pg8::StaticOrder, true, true>((PG8_LAS unsigned char*)lds, g, S, E);
    }
    SEAM(B0 + 7);
    if (PH(B0 + 8) && PHON(8)) {
        pg8::Gemm g{(const pg8::bf16_t*)(p.ws + WS_P), (const pg8::bf16_t*)(p.ws + WS_WT_2), M, DM, DFF}; pg8::StaticOrder S; S.init(M, DM, G, b);
        pg8::EpiRes E{p.out, lat_c, p.out, lat_c, mod_l + 5 * DM, mod_c + 5 * DM};
        pg8::gemm_phase<pg8::EpiRes, pg8::StaticOrder, true, true>((PG8_LAS unsigned char*)lds, g, S, E);
    }
    SEAM(B0 + 8);
}
template <int PHMASK> __global__ void __launch_bounds__(NTHR) fwd_megakernel(Params p) {
    extern __shared__ __attribute__((aligned(16))) unsigned char lds[];
    if (PH(0) && PHON(9)) phase0(p, (float*)lds);
    SEAM(0);
    layer_phases<PHMASK, 0>(p, lds);
    layer_phases<PHMASK, 1>(p, lds);
    if (PH(19) && PHON(10)) final_norm(p);
}

extern "C" void kernel_launch(void* const* d_in, const int* in_sizes, int n_in, void* d_out, int out_size, void* d_ws, size_t ws_size, hipStream_t stream) {
    static int grid = 0;
    if (grid == 0) {
        if (n_in != 28 || ws_size < WS_END) { fprintf(stderr, "kernel_launch: need 28 inputs and %zu bytes of workspace (got %d, %zu)\n", (size_t)WS_END, n_in, ws_size); grid = -1; return; }
        int dev = 0, cus = 0, per_cu = 0;
        (void)hipGetDevice(&dev); (void)hipDeviceGetAttribute(&cus, hipDeviceAttributeMultiprocessorCount, dev);
#if ONE_LAUNCH
        (void)hipFuncSetAttribute((const void*)fwd_megakernel<0xFFFF>, hipFuncAttributeMaxDynamicSharedMemorySize, LDS_BYTES);
        (void)hipOccupancyMaxActiveBlocksPerMultiprocessor(&per_cu, (const void*)fwd_megakernel<0xFFFF>, NTHR, LDS_BYTES);
#else
#define SETATTR(K) (void)hipFuncSetAttribute((const void*)fwd_megakernel<(1 << K)>, hipFuncAttributeMaxDynamicSharedMemorySize, LDS_BYTES)
        SETATTR(0); SETATTR(1); SETATTR(2); SETATTR(3); SETATTR(4); SETATTR(5); SETATTR(6); SETATTR(7); SETATTR(8); SETATTR(9); SETATTR(10); SETATTR(11);
        per_cu = 1;
#endif
        if (per_cu < 1) { fprintf(stderr, "kernel_launch: occupancy query says %d blocks per CU\n", per_cu); grid = -1; return; }
        grid = cus;
        (void)hipGetLastError();
    }
    if (grid < 0) return;
    Params p{};
    for (int i = 0; i < 28; ++i) p.in[i] = (const float*)d_in[i];
    p.out = (float*)d_out; p.ws = (unsigned char*)d_ws;
#if ONE_LAUNCH
    p.ph_lo = 0; p.ph_hi = N_PHASES;
    void* args[] = {&p};
    hipError_t e = hipLaunchCooperativeKernel((const void*)fwd_megakernel<0xFFFF>, dim3(grid), dim3(NTHR), args, LDS_BYTES, stream);
    if (e != hipSuccess) fprintf(stderr, "cooperative launch failed: %s (grid %d)\n", hipGetErrorString(e), grid);
#else
#define LAUNCH1(K) hipLaunchKernelGGL(fwd_megakernel<(1 << K)>, dim3(grid), dim3(NTHR), LDS_BYTES, stream, p)
    for (int ph = 0; ph < N_PHASES; ++ph) { p.ph_lo = ph; p.ph_hi = ph + 1;
        if (ph == 0) { LAUNCH1(9); continue; }
        if (ph == 19) { LAUNCH1(10); continue; }
        switch ((ph - 1) % 9) {
        case 0: LAUNCH1(0); break; case 1: LAUNCH1(1); break; case 2: LAUNCH1(2); LAUNCH1(11); break; case 3: LAUNCH1(3); break; case 4: LAUNCH1(4); break;
        case 5: LAUNCH1(5); break; case 6: LAUNCH1(6); break; case 7: LAUNCH1(7); break; case 8: LAUNCH1(8); break; }
    }
#endif
}
```

```cpp
#include <hip/hip_runtime.h>
#include <hip/hip_cooperative_groups.h>
#include <cstdio>
#include <cstdint>
namespace cg = cooperative_groups;
__device__ __forceinline__ int otid() { int t = threadIdx.x; asm volatile("" : "+v"(t)); return t; }
namespace pg8 {
#define PG8_LAS __attribute__((address_space(3)))
typedef unsigned short bf16_t;
typedef short bf16x8 __attribute__((ext_vector_type(8)));
typedef float f32x4 __attribute__((ext_vector_type(4)));
typedef unsigned u32x4 __attribute__((ext_vector_type(4)));
constexpr int BM = 256, BK = 64, HALF = 128, HTB = HALF * BK * 2  , STAGE_BYTES = 8 * HTB, NXCD = 8, WGM = 8;

__host__ __device__ __forceinline__ int lds_byte(int r, int c) { const int st = (r >> 4) * 2 + (c >> 5), rr = r & 15, cc = c & 31, ob = rr * 64 + cc * 2; return st * 1024 + (ob ^ (((ob >> 9) & 1) << 5)); }
__host__ __device__ __forceinline__ void stage_rc(int b, int& R, int& C) { const int st = b / 1024, sb = b % 1024, swz = sb ^ (((sb >> 9) & 1) << 5); R = (st >> 1) * 16 + swz / 64; C = (st & 1) * 32 + (swz % 64) / 2; }
__host__ __device__ __forceinline__ int perm32(int rho) { const int n = rho >> 4, i = rho & 15; return 8 * (i >> 2) + 4 * n + (i & 3); }

struct Unit { int pm, pn; };
struct Gemm { const bf16_t* A; const bf16_t* Bt; int M, N, K; };

struct StaticOrder {
    int nM, nN, nwg, G, c;
    __host__ __device__ void init(int M, int N, int G_, int c_) { nM = M / BM; nN = N / BM; nwg = nM * nN; G = G_; c = c_; }
    __host__ __device__ bool next(int i, Unit& u) const {
        const long L = (long)i * G + c; if (L >= nwg) return false;
        int wgid = (int)L; { const int q = nwg / NXCD, r = nwg % NXCD, xcd = wgid % NXCD, off = wgid / NXCD; wgid = (xcd < r ? xcd * (q + 1) : r * (q + 1) + (xcd - r) * q) + off; }
        const int nig = WGM * nN, gid = wgid / nig, fm = gid * WGM, gsz = (nM - fm) < WGM ? (nM - fm) : WGM;
        u.pm = fm + ((wgid % nig) % gsz); u.pn = (wgid % nig) / gsz; return true;
    }
    __device__ __forceinline__ void a_ready(const Unit&) const {}
    __device__ __forceinline__ void done(const Unit&) const {}
};

__device__ __forceinline__ unsigned cvt_pk_bf16(float lo, float hi) { unsigned r; asm volatile("v_cvt_pk_bf16_f32 %0, %1, %2" : "=v"(r) : "v"(lo), "v"(hi)); return r; }
struct EpiF32 {
    static constexpr bool PERM = false, AFTER_DRAIN = false;
    float* O; int ldc;
    __device__ __forceinline__ void operator()(const f32x4 (&acc)[2][2][4][2], const Unit& u, int wr, int wc, int fr, int fq) const {
        const int row0 = u.pm * BM + wr * 64 + fr, col0 = u.pn * BM + wc * 32 + 4 * fq;
#pragma unroll
        for (int ai = 0; ai < 2; ++ai)
#pragma unroll
            for (int m = 0; m < 4; ++m) { float* rowp = O + (size_t)(row0 + ai * HALF + m * 16) * ldc + col0;
#pragma unroll
                for (int bj = 0; bj < 2; ++bj)
#pragma unroll
                    for (int n = 0; n < 2; ++n) *(f32x4*)(rowp + bj * HALF + n * 16) = acc[ai][bj][m][n]; }
    }
    __device__ __forceinline__ void fused(f32x4 (&)[2][2][4][2], const Unit&, int, int, int, int, PG8_LAS unsigned char*, int, int) const {}
};
struct EpiRes {
    static constexpr bool PERM = false, AFTER_DRAIN = false;
    const float* res_l; const float* res_c; float* out_l; float* out_c; const float* gate_l; const float* gate_c;
    __device__ __forceinline__ void operator()(const f32x4 (&acc)[2][2][4][2], const Unit& u, int wr, int wc, int fr, int fq) const {
        const bool isc = u.pm >= 32;
        const float* res = isc ? res_c : res_l; float* out = isc ? out_c : out_l; const float* gate = isc ? gate_c : gate_l;
        const int row0 = (isc ? u.pm - 32 : u.pm) * BM + wr * 64 + fr, col0 = u.pn * BM + wc * 32 + 4 * fq;
        f32x4 gv[2][2];
#pragma unroll
        for (int bj = 0; bj < 2; ++bj)
#pragma unroll
            for (int n = 0; n < 2; ++n) gv[bj][n] = *(const f32x4*)(gate + col0 + bj * HALF + n * 16);
#pragma unroll
        for (int ai = 0; ai < 2; ++ai)
#pragma unroll
            for (int m = 0; m < 4; ++m) { const size_t off = (size_t)(row0 + ai * HALF + m * 16) * 2048 + col0;
#pragma unroll
                for (int bj = 0; bj < 2; ++bj)
#pragma unroll
                    for (int n = 0; n < 2; ++n) { const f32x4 r = *(const f32x4*)(res + off + bj * HALF + n * 16);
                        *(f32x4*)(out + off + bj * HALF + n * 16) = r + gv[bj][n] * acc[ai][bj][m][n]; } }
    }
    __device__ __forceinline__ void fused(f32x4 (&)[2][2][4][2], const Unit&, int, int, int, int, PG8_LAS unsigned char*, int, int) const {}
};
struct EpiRelu2 {
    static constexpr bool PERM = true, AFTER_DRAIN = false;
    bf16_t* O; int ldc;
    __device__ __forceinline__ void operator()(const f32x4 (&acc)[2][2][4][2], const Unit& u, int wr, int wc, int fr, int fq) const {
        const int row0 = u.pm * BM + wr * 64 + fr, col0 = u.pn * BM + wc * 32 + 8 * fq;
#pragma unroll
        for (int ai = 0; ai < 2; ++ai)
#pragma unroll
            for (int m = 0; m < 4; ++m) { bf16_t* rowp = O + (size_t)(row0 + ai * HALF + m * 16) * ldc + col0;
#pragma unroll
                for (int bj = 0; bj < 2; ++bj) { f32x4 v0 = acc[ai][bj][m][0], v1 = acc[ai][bj][m][1];
#pragma unroll
                    for (int e = 0; e < 4; ++e) { const float a = fmaxf(v0[e], 0.f), b = fmaxf(v1[e], 0.f); v0[e] = a * a; v1[e] = b * b; }
                    u32x4 w; w.x = cvt_pk_bf16(v0[0], v0[1]); w.y = cvt_pk_bf16(v0[2], v0[3]); w.z = cvt_pk_bf16(v1[0], v1[1]); w.w = cvt_pk_bf16(v1[2], v1[3]);
                    *(u32x4*)(rowp + bj * HALF) = w; } }
    }
    __device__ __forceinline__ void fused(f32x4 (&)[2][2][4][2], const Unit&, int, int, int, int, PG8_LAS unsigned char*, int, int) const {}
};
template <class Epi, class Sched, bool ALIGN_EPI = false, bool SP2 = false>
__device__ __forceinline__ void gemm_phase(PG8_LAS unsigned char* lds, const Gemm g, const Sched& S, const Epi& E) {
    const int tid = otid(), wid = __builtin_amdgcn_readfirstlane(tid >> 6), lane = tid & 63, wr = wid >> 2, wc = wid & 3, fr = lane & 15, fq = lane >> 4;
    const int K = g.K, nt = K / BK;
    unsigned voffA[2], voffB[2];
#pragma unroll
    for (int i = 0; i < 2; ++i) { int R, C; stage_rc(tid * 16 + i * 8192, R, C); const int Rb = Epi::PERM ? ((R & ~31) + perm32(R & 31)) : R;
        voffA[i] = (unsigned)(R * K + C) * 2u; voffB[i] = (unsigned)(Rb * K + C) * 2u; }
    const size_t kstep = (size_t)(BK * 2);
    const size_t hstep = (size_t)HALF * K * 2;
    const size_t tstep = 2 * hstep;
    const unsigned ldsw = (unsigned)wid * 1024u;
    const int aoff = lds_byte(wr * 64 + fr, fq * 8), boff = lds_byte(wc * 32 + fr, fq * 8);
#define PG8_SA(b, h) (((b) * 2 + (h)) * HTB)
#define PG8_SB(b, h) ((4 + (b) * 2 + (h)) * HTB)
#define PG8_STAGE(bufoff, gbase, voff) do { _Pragma("unroll") for (int _i = 0; _i < 2; ++_i) \
        __builtin_amdgcn_global_load_lds((const unsigned*)((const char*)(gbase) + (voff)[_i]), (PG8_LAS unsigned*)(lds + (bufoff) + ldsw + _i * 8192), 16, 0, 0); } while (0)
#define PG8_LDA(dst, b, h) do { _Pragma("unroll") for (int m = 0; m < 4; ++m) _Pragma("unroll") for (int k = 0; k < 2; ++k) dst[m][k] = *(const PG8_LAS bf16x8*)(lds + PG8_SA(b, h) + aoff + m * 2048 + k * 1024); } while (0)
#define PG8_LDB(dst, b, h) do { _Pragma("unroll") for (int n = 0; n < 2; ++n) _Pragma("unroll") for (int k = 0; k < 2; ++k) dst[n][k] = *(const PG8_LAS bf16x8*)(lds + PG8_SB(b, h) + boff + n * 2048 + k * 1024); } while (0)
#define PG8_MMA(ai, bj, At, Bt) do { __builtin_amdgcn_s_setprio(1); _Pragma("unroll") for (int m = 0; m < 4; ++m) _Pragma("unroll") for (int n = 0; n < 2; ++n) _Pragma("unroll") for (int k = 0; k < 2; ++k) \
        acc[ai][bj][m][n] = __builtin_amdgcn_mfma_f32_16x16x32_bf16(Bt[n][k], At[m][k], acc[ai][bj][m][n], 0, 0, 0); __builtin_amdgcn_s_setprio(0); } while (0)
#define PG8_WAIT_V(n) asm volatile("s_waitcnt vmcnt(" #n ")" ::: "memory")
#define PG8_WAIT_L(n) asm volatile("s_waitcnt lgkmcnt(" #n ")" ::: "memory")
#define PG8_BAR __builtin_amdgcn_s_barrier()
#define PG8_SCHED __builtin_amdgcn_sched_barrier(0)
    Unit cur, nxt; int ui = 0;
    if (!S.next(0, cur)) return;
    f32x4 acc[2][2][4][2];
#pragma unroll
    for (int a = 0; a < 2; ++a)
#pragma unroll
        for (int b = 0; b < 2; ++b)
#pragma unroll
            for (int m = 0; m < 4; ++m)
#pragma unroll
                for (int n = 0; n < 2; ++n) acc[a][b][m][n] = (f32x4){0.f, 0.f, 0.f, 0.f};
    bf16x8 At[4][2], B0[2][2], B1[2][2];
    const char* cA = (const char*)g.A + (size_t)cur.pm * tstep; const char* cB = (const char*)g.Bt + (size_t)cur.pn * tstep;
    S.a_ready(cur);
    if constexpr (SP2) {
        PG8_STAGE(PG8_SB(0, 0), cB, voffB); PG8_STAGE(PG8_SB(0, 1), cB + hstep, voffB); PG8_STAGE(PG8_SA(0, 0), cA, voffA); PG8_STAGE(PG8_SA(0, 1), cA + hstep, voffA);
        if (wr == 1) PG8_BAR;
        PG8_WAIT_V(2); PG8_BAR;
        PG8_STAGE(PG8_SB(1, 0), cB + kstep, voffB); PG8_STAGE(PG8_SA(1, 0), cA + kstep, voffA); PG8_STAGE(PG8_SB(1, 1), cB + hstep + kstep, voffB);
        PG8_WAIT_V(6); PG8_BAR;
    } else {
        PG8_STAGE(PG8_SB(0, 0), cB, voffB); PG8_STAGE(PG8_SA(0, 0), cA, voffA); PG8_STAGE(PG8_SB(0, 1), cB + hstep, voffB); PG8_STAGE(PG8_SA(0, 1), cA + hstep, voffA);
        if (wr == 1) PG8_BAR;
        PG8_WAIT_V(4); PG8_BAR;
        PG8_STAGE(PG8_SB(1, 0), cB + kstep, voffB); PG8_STAGE(PG8_SA(1, 0), cA + kstep, voffA); PG8_STAGE(PG8_SB(1, 1), cB + hstep + kstep, voffB);
        PG8_WAIT_V(6); PG8_BAR;
    }
    for (;;) {
        const bool has_next = S.next(ui + 1, nxt);
        const char* nA = has_next ? (const char*)g.A + (size_t)nxt.pm * tstep : cA; const char* nB = has_next ? (const char*)g.Bt + (size_t)nxt.pn * tstep : cB;
        for (int t = 0; t < nt; t += 2) {
            const bool last = (t == nt - 2);
            const char* a1 = cA + (size_t)(t + 1) * kstep;
            const char* a2 = last ? nA : cA + (size_t)(t + 2) * kstep; const char* b2 = last ? nB : cB + (size_t)(t + 2) * kstep;
            const char* a3 = a2 + kstep; const char* b3 = b2 + kstep;
            if (last && has_next) S.a_ready(nxt);
            if constexpr (SP2) {
            PG8_LDB(B0, 0, 0); PG8_LDB(B1, 0, 1); PG8_SCHED; PG8_LDA(At, 0, 0); PG8_STAGE(PG8_SA(1, 1), a1 + hstep, voffA);
            PG8_WAIT_V(8); PG8_WAIT_L(0); PG8_BAR; PG8_MMA(0, 0, At, B0); PG8_MMA(0, 1, At, B1); PG8_BAR; PG8_SCHED;
            PG8_LDA(At, 0, 1); PG8_STAGE(PG8_SB(0, 0), b2, voffB); PG8_STAGE(PG8_SB(0, 1), b2 + hstep, voffB); PG8_STAGE(PG8_SA(0, 0), a2, voffA);
            PG8_WAIT_V(8); PG8_WAIT_L(0); PG8_BAR; PG8_MMA(1, 0, At, B0); PG8_MMA(1, 1, At, B1); PG8_BAR; PG8_SCHED;
            PG8_LDB(B0, 1, 0); PG8_LDB(B1, 1, 1); PG8_SCHED; PG8_LDA(At, 1, 0); PG8_STAGE(PG8_SA(0, 1), a2 + hstep, voffA);
            PG8_WAIT_V(8); PG8_WAIT_L(0); PG8_BAR; PG8_MMA(0, 0, At, B0); PG8_MMA(0, 1, At, B1); PG8_BAR; PG8_SCHED;
            PG8_LDA(At, 1, 1); PG8_STAGE(PG8_SB(1, 0), b3, voffB); PG8_STAGE(PG8_SB(1, 1), b3 + hstep, voffB); PG8_STAGE(PG8_SA(1, 0), a3, voffA);
            PG8_WAIT_V(8); PG8_WAIT_L(0); PG8_BAR; PG8_MMA(1, 0, At, B0); PG8_MMA(1, 1, At, B1); PG8_BAR; PG8_SCHED;
            } else {
            PG8_LDB(B0, 0, 0); PG8_SCHED; PG8_LDA(At, 0, 0); PG8_STAGE(PG8_SA(1, 1), a1 + hstep, voffA);
            PG8_WAIT_L(8); PG8_BAR; PG8_WAIT_L(0); PG8_MMA(0, 0, At, B0); PG8_BAR; PG8_SCHED;
            PG8_LDB(B1, 0, 1); PG8_STAGE(PG8_SB(0, 0), b2, voffB);
            PG8_BAR; PG8_WAIT_L(0); PG8_MMA(0, 1, At, B1); PG8_BAR;
            PG8_LDA(At, 0, 1); PG8_STAGE(PG8_SA(0, 0), a2, voffA);
            PG8_BAR; PG8_WAIT_L(0); PG8_MMA(1, 0, At, B0); PG8_BAR; PG8_SCHED;
            PG8_STAGE(PG8_SB(0, 1), b2 + hstep, voffB);
            PG8_WAIT_V(6); PG8_BAR; PG8_MMA(1, 1, At, B1); PG8_BAR;
            PG8_LDB(B0, 1, 0); PG8_SCHED; PG8_LDA(At, 1, 0); PG8_STAGE(PG8_SA(0, 1), a2 + hstep, voffA);
            PG8_WAIT_L(8); PG8_BAR; PG8_WAIT_L(0); PG8_MMA(0, 0, At, B0); PG8_BAR; PG8_SCHED;
            PG8_LDB(B1, 1, 1); PG8_STAGE(PG8_SB(1, 0), b3, voffB);
            PG8_BAR; PG8_WAIT_L(0); PG8_MMA(0, 1, At, B1); PG8_BAR;
            PG8_LDA(At, 1, 1); PG8_STAGE(PG8_SA(1, 0), a3, voffA);
            PG8_BAR; PG8_WAIT_L(0); PG8_MMA(1, 0, At, B0); PG8_BAR; PG8_SCHED;
            PG8_STAGE(PG8_SB(1, 1), b3 + hstep, voffB);
            PG8_WAIT_V(6); PG8_BAR; PG8_MMA(1, 1, At, B1); PG8_BAR;
            }
        }
        if constexpr (ALIGN_EPI) { if (wr == 0) PG8_BAR; }
        if constexpr (!Epi::AFTER_DRAIN) { E(acc, cur, wr, wc, fr, fq); S.done(cur); }
        if (!has_next) break;
#pragma unroll
        for (int a = 0; a < 2; ++a)
#pragma unroll
            for (int b = 0; b < 2; ++b)
#pragma unroll
                for (int m = 0; m < 4; ++m)
#pragma unroll
                    for (int n = 0; n < 2; ++n) acc[a][b][m][n] = (f32x4){0.f, 0.f, 0.f, 0.f};
        cur = nxt; cA = nA; cB = nB; ++ui;
        if constexpr (ALIGN_EPI) { if (wr == 1) PG8_BAR; }
    }
    PG8_WAIT_V(0);
    if constexpr (!ALIGN_EPI) { if (wr == 0) PG8_BAR; }
    PG8_BAR;
    if constexpr (Epi::AFTER_DRAIN) { E.fused(acc, cur, wr, wc, fr, fq, lds, wid, lane); S.done(cur); }
#undef PG8_SA
#undef PG8_SB
#undef PG8_STAGE
#undef PG8_LDA
#undef PG8_LDB
#undef PG8_MMA
#undef PG8_WAIT_V
#undef PG8_WAIT_L
#undef PG8_BAR
#undef PG8_SCHED
}
}
#define LAS __attribute__((address_space(3)))
typedef unsigned short bf16;
typedef float f32x4 __attribute__((ext_vector_type(4)));
typedef float f32x2 __attribute__((ext_vector_type(2)));
typedef short bf16x8 __attribute__((ext_vector_type(8)));
typedef unsigned v4u __attribute__((ext_vector_type(4)));
typedef unsigned v2u __attribute__((ext_vector_type(2)));

constexpr int NTHR = 512;
constexpr int LDS_BYTES = 155648;
constexpr int DM = 2048, TLAT = 8192, TCTX = 256, TTOK = 8448, PINP = 7680, DFF = 8192;
constexpr size_t MiB = 1u << 20;
constexpr size_t WS_MOD = 0;
constexpr size_t WS_DL = 256 * 1024;
constexpr size_t WS_BONUS = 512 * 1024;
constexpr size_t WS_LATC = 2 * MiB;
constexpr size_t WS_WT_IN = 4 * MiB, WS_WT_OUT = 34 * MiB, WS_WT_1 = 42 * MiB, WS_WT_2 = 74 * MiB;
constexpr size_t WS_H = 106 * MiB;
constexpr size_t WS_SZ = 139 * MiB;
constexpr size_t WS_GATE = WS_SZ + (size_t)TTOK * 1024 * 2;
constexpr size_t WS_P = 172 * MiB;
constexpr size_t WS_GDN = 420 * MiB;
constexpr size_t WS_RWD = 569 * MiB;
constexpr size_t WS_RWS = WS_RWD + (size_t)2 * 16 * TTOK * 512;
constexpr size_t WS_END = WS_RWS + (size_t)16 * TTOK * 384;
static_assert(WS_GATE + (size_t)TTOK * 1024 * 2 <= WS_P && WS_P + (size_t)TTOK * PINP * 4 <= WS_GDN && WS_GDN + (size_t)2 * 8 * 132 * 36864 * 2 <= WS_RWD, "ws map");
static_assert(WS_END <= 768 * MiB, "ws size");

struct Params { const float* in[28]; float* out; unsigned char* ws; int ph_lo, ph_hi; };

__device__ __forceinline__ unsigned f2bf(float f) { unsigned u = __builtin_bit_cast(unsigned, f); return (u + 0x7fffu + ((u >> 16) & 1u)) >> 16; }
__device__ __forceinline__ unsigned pk2(float lo, float hi) { return f2bf(lo) | (f2bf(hi) << 16); }
__device__ __forceinline__ float bf2f(unsigned b) { return __builtin_bit_cast(float, b << 16); }
__device__ __forceinline__ float bflo(unsigned w) { return __builtin_bit_cast(float, w << 16); }
__device__ __forceinline__ float bfhi(unsigned w) { return __builtin_bit_cast(float, w & 0xffff0000u); }
__device__ __forceinline__ float wave_sum(float v) {
#pragma unroll
    for (int o = 1; o < 64; o <<= 1) v += __shfl_xor(v, o);
    return v;
}
__device__ __forceinline__ float sigmoidf_(float x) { return 1.f / (1.f + expf(-x)); }
__device__ __forceinline__ float siluf_(float x) { return x / (1.f + expf(-x)); }
__device__ __forceinline__ float softplusf_(float x) { return x > 20.f ? x : log1pf(expf(x)); }
#define LDS_WAIT() asm volatile("s_waitcnt lgkmcnt(0)" ::: "memory")

__device__ __forceinline__ void transpose_item(const float* W, int K, int N, bf16* WT, float* scr, int item, int lane) {
    const int nblk = N / 32, kb = item / nblk, nb = item % nblk, k0 = 64 * kb, n0 = 32 * nb;
#pragma unroll 8
    for (int i = 0; i < 32; ++i) { const int kk = 2 * i + (lane >> 5); scr[kk * 33 + (lane & 31)] = W[(size_t)(k0 + kk) * N + n0 + (lane & 31)]; }
    LDS_WAIT();
    const int c = lane & 7;
#pragma unroll
    for (int j = 0; j < 4; ++j) { const int n = (lane >> 3) + 8 * j; const float* s = scr + (8 * c) * 33 + n;
        v4u o; o.x = pk2(s[0 * 33], s[1 * 33]); o.y = pk2(s[2 * 33], s[3 * 33]); o.z = pk2(s[4 * 33], s[5 * 33]); o.w = pk2(s[6 * 33], s[7 * 33]);
        *(v4u*)(WT + (size_t)(n0 + n) * K + k0 + 8 * c) = o; }
    LDS_WAIT();
}
__device__ __forceinline__ void convert_weights(const Params& p, int l, int gw, int ngw, float* scr, int lane) {
    const float* w_in = p.in[8] + (size_t)l * 2048 * 7616; const float* w_out = p.in[24] + (size_t)l * 2048 * 2048;
    const float* w1 = p.in[25] + (size_t)l * 2048 * 8192; const float* w2 = p.in[26] + (size_t)l * 8192 * 2048;
    bf16* t_in = (bf16*)(p.ws + WS_WT_IN); bf16* t_out = (bf16*)(p.ws + WS_WT_OUT); bf16* t_1 = (bf16*)(p.ws + WS_WT_1); bf16* t_2 = (bf16*)(p.ws + WS_WT_2);
    for (int it = gw; it < 26048; it += ngw) {
        int r = it;
        if (r < 7616) { transpose_item(w_in, 2048, 7616, t_in, scr, r, lane); continue; } r -= 7616;
        if (r < 2048) { transpose_item(w_out, 2048, 2048, t_out, scr, r, lane); continue; } r -= 2048;
        if (r < 8192) { transpose_item(w1, 2048, 8192, t_1, scr, r, lane); continue; } r -= 8192;
        transpose_item(w2, 8192, 2048, t_2, scr, r, lane);
    }
}
__device__ __forceinline__ void phase0(const Params& p, float* L) {
    const int tid = otid(), lane = tid & 63, wave = tid >> 6, G = gridDim.x, b = blockIdx.x;
    { v4u z = {0u, 0u, 0u, 0u}; v4u* dst = (v4u*)((bf16*)(p.ws + WS_WT_IN) + (size_t)7616 * 2048);
      for (int i = b * NTHR + tid; i < 64 * 2048 / 8; i += G * NTHR) dst[i] = z; }
    convert_weights(p, 0, b * 8 + wave, G * 8, L + wave * 2112, lane);
    __syncthreads();
    float* sl = L; float* sc = L + 2048; float* red = L + 4096;
    for (int k = tid; k < 2048; k += NTHR) { sl[k] = siluf_(p.in[1][k]); sc[k] = siluf_(p.in[3][k]); }
    __syncthreads();
    for (int it = b; it < 768; it += G) {
        const int l = it / 384, cb = it % 384, col = cb * 32 + (tid & 31), kp = tid >> 5;
        const float* W = p.in[4] + (size_t)l * 2048 * 12288 + col;
        float a0 = 0.f, a1 = 0.f;
#pragma unroll 8
        for (int k = kp * 128; k < kp * 128 + 128; ++k) { const float w = W[(size_t)k * 12288]; a0 += sl[k] * w; a1 += sc[k] * w; }
        red[(kp * 32 + (tid & 31)) * 2] = a0; red[(kp * 32 + (tid & 31)) * 2 + 1] = a1;
        __syncthreads();
        if (tid < 64) { const int cls = tid >> 5, c = tid & 31; float s = p.in[5][l * 12288 + cb * 32 + c];
            for (int q = 0; q < 16; ++q) s += red[(q * 32 + c) * 2 + cls];
            ((float*)(p.ws + WS_MOD))[(l * 2 + cls) * 12288 + cb * 32 + c] = s; }
        __syncthreads();
    }
}

__device__ __forceinline__ void norm_phase(const Params& p, int l, const float* xl, const float* xc, const float* g, int sh_idx, int sc_idx, int nrows) {
    const int tid = otid(), lane = tid & 63, gw = blockIdx.x * 8 + (tid >> 6), ngw = gridDim.x * 8;
    bf16* H = (bf16*)(p.ws + WS_H);
    const float* mod = (const float*)(p.ws + WS_MOD) + (size_t)l * 2 * 12288;
    for (int row = gw; row < nrows; row += ngw) {
        const bool isc = row >= TLAT;
        const float* xr = isc ? xc + (size_t)(row - TLAT) * DM : xl + (size_t)row * DM;
        const float* md = mod + (isc ? 12288 : 0);
        f32x4 v[8]; float ss = 0.f;
#pragma unroll
        for (int j = 0; j < 8; ++j) { v[j] = ((const f32x4*)xr)[lane + 64 * j]; ss += v[j].x * v[j].x + v[j].y * v[j].y + v[j].z * v[j].z + v[j].w * v[j].w; }
        const float rstd = rsqrtf(wave_sum(ss) * (1.f / DM) + 1e-6f);
#pragma unroll
        for (int j = 0; j < 8; ++j) { const int col = 4 * (lane + 64 * j);
            const f32x4 gg = *(const f32x4*)(g + col), s1 = *(const f32x4*)(md + sc_idx * DM + col), s0 = *(const f32x4*)(md + sh_idx * DM + col);
            const f32x4 y = v[j] * rstd * gg * (1.f + s1) + s0;
            v2u o; o.x = pk2(y.x, y.y); o.y = pk2(y.z, y.w);
            *(v2u*)(H + (size_t)row * DM + col) = o; }
    }
}
__device__ __forceinline__ void final_norm(const Params& p) {
    const int tid = otid(), lane = tid & 63, gw = blockIdx.x * 8 + (tid >> 6), ngw = gridDim.x * 8;
    const float* g = p.in[27];
    for (int row = gw; row < TLAT; row += ngw) {
        float* xr = p.out + (size_t)row * DM;
        f32x4 v[8]; float ss = 0.f;
#pragma unroll
        for (int j = 0; j < 8; ++j) { v[j] = ((const f32x4*)xr)[lane + 64 * j]; ss += v[j].x * v[j].x + v[j].y * v[j].y + v[j].z * v[j].z + v[j].w * v[j].w; }
        const float rstd = rsqrtf(wave_sum(ss) * (1.f / DM) + 1e-6f);
#pragma unroll
        for (int j = 0; j < 8; ++j) { const f32x4 gg = ((const f32x4*)g)[lane + 64 * j]; ((f32x4*)xr)[lane + 64 * j] = v[j] * rstd * gg; }
    }
}
__device__ __forceinline__ void gdn_prep_item(const Params& p, int l, int item, float* L) {
    const int tid = otid(), lane = tid & 63, wave = tid >> 6;
    const int h = item & 7, ch = item >> 3;
    const bool isctx = ch >= 128;
    const int seg0 = isctx ? TLAT : 0, seglen = isctx ? TCTX : TLAT, t0 = isctx ? (ch - 128) * 64 : ch * 64;
    const float* P = (const float*)(p.ws + WS_P);
    const float* cw = p.in[9] + (size_t)l * 3 * 3072;
    float* qs = L; float* ks = L + 8448; float* KKm = L + 16896; float* QKm = L + 21056; float* TI = L + 25216;
    float* Gs = L + 33920; float* BETA = Gs + 128; float* EG = Gs + 256; float* GL = Gs + 384;
    bf16* const gd0 = (bf16*)(p.ws + WS_GDN) + ((size_t)h * 132 + (isctx ? (ch - 128) : 4 + ch)) * 36864;
    bf16* const gd1 = (bf16*)(p.ws + WS_GDN) + ((size_t)(8 + h) * 132 + (isctx ? 3 - (ch - 128) : 4 + 127 - ch)) * 36864;
#define GDP(d) ((d) ? gd1 : gd0)
    {
        const int i = tid >> 3, c0 = (tid & 7) * 16, tk = t0 + i;
        const size_t prow = (size_t)(seg0 + tk) * PINP;
#pragma unroll
        for (int which = 0; which < 2; ++which) {
            const int col = which * 1024 + h * 128 + c0;
            f32x4 y[4]; float ss = 0.f;
#pragma unroll
            for (int jj = 0; jj < 4; ++jj) {
                const f32x4 x0 = *(const f32x4*)(P + prow + col + 4 * jj);
                f32x4 xm = {0.f, 0.f, 0.f, 0.f}, xp = {0.f, 0.f, 0.f, 0.f};
                if (tk > 0) xm = *(const f32x4*)(P + prow - PINP + col + 4 * jj);
                if (tk < seglen - 1) xp = *(const f32x4*)(P + prow + PINP + col + 4 * jj);
                const f32x4 w0 = *(const f32x4*)(cw + col + 4 * jj), w1 = *(const f32x4*)(cw + 3072 + col + 4 * jj), w2 = *(const f32x4*)(cw + 6144 + col + 4 * jj);
                f32x4 t = xm * w0 + x0 * w1 + xp * w2;
                t.x = siluf_(t.x); t.y = siluf_(t.y); t.z = siluf_(t.z); t.w = siluf_(t.w);
                y[jj] = t; ss += t.x * t.x + t.y * t.y + t.z * t.z + t.w * t.w;
            }
            ss += __shfl_xor(ss, 1); ss += __shfl_xor(ss, 2); ss += __shfl_xor(ss, 4);
            const float sc = rsqrtf(ss + 1e-6f) * (which == 0 ? 0.08838834764831845f : 1.f);
            float* dst = (which ? ks : qs) + i * 132 + c0;
#pragma unroll
            for (int jj = 0; jj < 4; ++jj) *(f32x4*)(dst + 4 * jj) = y[jj] * sc;
        }
        {
            const int col = 3072 + h * 128 + c0; unsigned o[8];
#pragma unroll
            for (int jj = 0; jj < 4; ++jj) { const f32x4 z = *(const f32x4*)(P + prow + col + 4 * jj);
                o[2 * jj] = pk2(siluf_(z.x), siluf_(z.y)); o[2 * jj + 1] = pk2(siluf_(z.z), siluf_(z.w)); }
            bf16* sz = (bf16*)(p.ws + WS_SZ) + (size_t)(seg0 + tk) * 1024 + h * 128 + c0;
            *(v4u*)sz = (v4u){o[0], o[1], o[2], o[3]}; *(v4u*)(sz + 8) = (v4u){o[4], o[5], o[6], o[7]};
        }
    }
    if (tid < 128) {
        const int d = tid >> 6, ip = tid & 63, i = d ? 63 - ip : ip;
        const size_t prow = (size_t)(seg0 + t0 + i) * PINP;
        const float bb = P[prow + 4096 + d * 8 + h], al = P[prow + 4112 + d * 8 + h];
        const float A = expf(p.in[10][l * 16 + d * 8 + h]);
        float g = -A * softplusf_(al + p.in[11][l * 16 + d * 8 + h]);
#pragma unroll
        for (int o = 1; o < 64; o <<= 1) { const float t = __shfl_up(g, o); if (ip >= o) g += t; }
        Gs[d * 64 + ip] = g; BETA[d * 64 + ip] = sigmoidf_(bb); EG[d * 64 + ip] = expf(g);
        if (ip == 63) { GL[d] = g;
            const int np = isctx ? (d ? 3 - (ch - 128) : (ch - 128)) : (d ? 4 + 127 - ch : 4 + ch);
            ((float*)(p.ws + WS_DL))[(d * 8 + h) * 132 + np] = expf(g); }
    }
    __syncthreads();
    {
        const int ia = tid >> 4, jb = tid & 15;
        float akk[2][4], aqk[2][4];
#pragma unroll
        for (int a = 0; a < 2; ++a)
#pragma unroll
            for (int bq = 0; bq < 4; ++bq) { akk[a][bq] = 0.f; aqk[a][bq] = 0.f; }
        for (int c = 0; c < 128; c += 4) {
            f32x4 ki[2], qi[2], kj[4];
#pragma unroll
            for (int a = 0; a < 2; ++a) { ki[a] = *(const f32x4*)(ks + (ia + 32 * a) * 132 + c); qi[a] = *(const f32x4*)(qs + (ia + 32 * a) * 132 + c); }
#pragma unroll
            for (int bq = 0; bq < 4; ++bq) kj[bq] = *(const f32x4*)(ks + (jb + 16 * bq) * 132 + c);
#pragma unroll
            for (int a = 0; a < 2; ++a)
#pragma unroll
                for (int bq = 0; bq < 4; ++bq) {
                    akk[a][bq] += ki[a].x * kj[bq].x + ki[a].y * kj[bq].y + ki[a].z * kj[bq].z + ki[a].w * kj[bq].w;
                    aqk[a][bq] += qi[a].x * kj[bq].x + qi[a].y * kj[bq].y + qi[a].z * kj[bq].z + qi[a].w * kj[bq].w; }
        }
#pragma unroll
        for (int a = 0; a < 2; ++a)
#pragma unroll
            for (int bq = 0; bq < 4; ++bq) { KKm[(ia + 32 * a) * 65 + jb + 16 * bq] = akk[a][bq]; QKm[(ia + 32 * a) * 65 + jb + 16 * bq] = aqk[a][bq]; }
    }
    __syncthreads();
#pragma unroll 4
    for (int e = 0; e < 16; ++e) { const int idx = tid + 512 * e, d = idx >> 12, ip = (idx >> 6) & 63, jp = idx & 63;
        const int ri = d ? 63 - ip : ip, rj = d ? 63 - jp : jp;
        float v = 0.f;
        if (jp < ip) v = BETA[d * 64 + ip] * KKm[ri * 65 + rj] * expf(Gs[d * 64 + ip] - Gs[d * 64 + jp]);
        TI[d * 4352 + ip * 68 + jp] = v; }
    __syncthreads();
    if (wave < 2) {
        const int d = wave; float X[64];
        const float* Lb = TI + d * 4352;
#pragma unroll
        for (int i = 0; i < 64; ++i) {
            float acc = (i == lane) ? 1.f : 0.f;
#pragma unroll
            for (int j4 = 0; j4 < i; j4 += 4) {
                const f32x4 lv = *(const f32x4*)(Lb + i * 68 + j4);
                acc -= lv.x * X[j4];
                if (j4 + 1 < i) acc -= lv.y * X[j4 + 1];
                if (j4 + 2 < i) acc -= lv.z * X[j4 + 2];
                if (j4 + 3 < i) acc -= lv.w * X[j4 + 3];
            }
            X[i] = acc;
        }
        LDS_WAIT();
#pragma unroll
        for (int i = 0; i < 64; ++i) TI[d * 4352 + i * 68 + lane] = X[i];
    } else {
        const int t2 = tid - 128;
        for (int idx = t2; idx < 2048; idx += 384) {
            const int d = idx >> 10, ip = (idx >> 4) & 63, c8 = idx & 15, ri = d ? 63 - ip : ip; const float e = EG[d * 64 + ip];
            const f32x4 a = *(const f32x4*)(qs + ri * 132 + c8 * 8), bq = *(const f32x4*)(qs + ri * 132 + c8 * 8 + 4);
            *(v4u*)(GDP(d) + 8192 + ip * 128 + c8 * 8) = (v4u){pk2(a.x * e, a.y * e), pk2(a.z * e, a.w * e), pk2(bq.x * e, bq.y * e), pk2(bq.z * e, bq.w * e)};
        }
        for (int idx = t2; idx < 2048; idx += 384) {
            const int d = idx >> 10, c = (idx >> 3) & 127, i8 = idx & 7; const float gl = GL[d]; float v[8];
#pragma unroll
            for (int e = 0; e < 8; ++e) { const int ip = i8 * 8 + e, ri = d ? 63 - ip : ip; v[e] = ks[ri * 132 + c] * expf(gl - Gs[d * 64 + ip]); }
            *(v4u*)(GDP(d) + 16384 + c * 64 + i8 * 8) = (v4u){pk2(v[0], v[1]), pk2(v[2], v[3]), pk2(v[4], v[5]), pk2(v[6], v[7])};
        }
        for (int idx = t2; idx < 1024; idx += 384) {
            const int d = idx >> 9, ip = (idx >> 3) & 63, j8 = idx & 7, ri = d ? 63 - ip : ip; const float gi = Gs[d * 64 + ip]; float v[8];
#pragma unroll
            for (int e = 0; e < 8; ++e) { const int jp = j8 * 8 + e, rj = d ? 63 - jp : jp; v[e] = (jp <= ip) ? QKm[ri * 65 + rj] * expf(gi - Gs[d * 64 + jp]) : 0.f; }
            *(v4u*)(GDP(d) + 24576 + ip * 64 + j8 * 8) = (v4u){pk2(v[0], v[1]), pk2(v[2], v[3]), pk2(v[4], v[5]), pk2(v[6], v[7])};
        }
    }
    __syncthreads();
    {
        const int i = tid >> 3, c0 = (tid & 7) * 16, tk = t0 + i; const size_t prow = (size_t)(seg0 + tk) * PINP; const int col = 2048 + h * 128 + c0;
#pragma unroll
        for (int jj = 0; jj < 4; ++jj) {
            const f32x4 x0 = *(const f32x4*)(P + prow + col + 4 * jj);
            f32x4 xm = {0.f, 0.f, 0.f, 0.f}, xp = {0.f, 0.f, 0.f, 0.f};
            if (tk > 0) xm = *(const f32x4*)(P + prow - PINP + col + 4 * jj);
            if (tk < seglen - 1) xp = *(const f32x4*)(P + prow + PINP + col + 4 * jj);
            const f32x4 w0 = *(const f32x4*)(cw + col + 4 * jj), w1 = *(const f32x4*)(cw + 3072 + col + 4 * jj), w2 = *(const f32x4*)(cw + 6144 + col + 4 * jj);
            f32x4 t = xm * w0 + x0 * w1 + xp * w2;
            t.x = siluf_(t.x); t.y = siluf_(t.y); t.z = siluf_(t.z); t.w = siluf_(t.w);
            *(f32x4*)(qs + i * 132 + c0 + 4 * jj) = t;
        }
    }
    const int d5 = tid >> 8, tt = tid & 255, ig = tt >> 4, cg = tt & 15, jmax = ig * 4 + 3;
#pragma unroll
    for (int pass = 0; pass < 2; ++pass) {
        if (pass == 1) __syncthreads();
        const float* src = pass ? qs : ks;
        f32x4 acc[4][2];
#pragma unroll
        for (int ii = 0; ii < 4; ++ii) { acc[ii][0] = (f32x4){0.f, 0.f, 0.f, 0.f}; acc[ii][1] = (f32x4){0.f, 0.f, 0.f, 0.f}; }
        for (int j = 0; j <= jmax; ++j) {
            const int rj = d5 ? 63 - j : j;
            const float cf = pass ? BETA[d5 * 64 + j] : BETA[d5 * 64 + j] * EG[d5 * 64 + j];
            const f32x4 k0 = *(const f32x4*)(src + rj * 132 + cg * 4), k1 = *(const f32x4*)(src + rj * 132 + 64 + cg * 4);
#pragma unroll
            for (int ii = 0; ii < 4; ++ii) { const float t = TI[d5 * 4352 + (ig * 4 + ii) * 68 + j] * cf; acc[ii][0] += t * k0; acc[ii][1] += t * k1; }
        }
        bf16* dst = GDP(d5) + (pass ? 28672 : 0);
#pragma unroll
        for (int ii = 0; ii < 4; ++ii) {
            *(v2u*)(dst + (ig * 4 + ii) * 128 + cg * 4) = (v2u){pk2(acc[ii][0].x, acc[ii][0].y), pk2(acc[ii][0].z, acc[ii][0].w)};
            *(v2u*)(dst + (ig * 4 + ii) * 128 + 64 + cg * 4) = (v2u){pk2(acc[ii][1].x, acc[ii][1].y), pk2(acc[ii][1].z, acc[ii][1].w)};
        }
    }
    __syncthreads();
}

__device__ __forceinline__ void rw_tok(int sf, int& prow, int& up, int& dn) {
    if (sf < TCTX) { prow = TLAT + sf; up = sf > 0 ? prow - 1 : -1; dn = sf < TCTX - 1 ? prow + 1 : -1; }
    else { const int j = sf - TCTX, r = j & 127, cc = j >> 7; prow = r * 64 + cc; up = r > 0 ? prow - 64 : -1; dn = r < 127 ? prow + 64 : -1; }
}
__device__ __forceinline__ float rw_shift(const float* P, const float* mu, int prow, int up, int dn, int col) {
    const float x = P[(size_t)prow * PINP + 4128 + col];
    const float u = up >= 0 ? P[(size_t)up * PINP + 4128 + col] : 0.f;
    const float dv = dn >= 0 ? P[(size_t)dn * PINP + 4128 + col] : 0.f;
    return x + mu[col] * (0.5f * (u + dv) - x);
}
#define RW_NT 11
#define RW_MATMUL(Wm, KK_, koff) do { \
    _Pragma("unroll") for (int t = 0; t < RW_NT; ++t) { acc[t][0] = 0.f; acc[t][1] = 0.f; } \
    float w0[4], w1[4], n0[4], n1[4]; \
    _Pragma("unroll") for (int kk = 0; kk < 4; ++kk) { w0[kk] = (Wm)[(size_t)kk * 1024 + c0]; w1[kk] = (Wm)[(size_t)kk * 1024 + c1]; } \
    _Pragma("unroll 1") for (int k = 0; k < (KK_); k += 4) { \
        const int kn = k + 4 < (KK_) ? k + 4 : k; \
        _Pragma("unroll") for (int kk = 0; kk < 4; ++kk) { n0[kk] = (Wm)[(size_t)(kn + kk) * 1024 + c0]; n1[kk] = (Wm)[(size_t)(kn + kk) * 1024 + c1]; } \
        _Pragma("unroll") for (int t = 0; t < RW_NT; ++t) { const f32x4 a = *(const f32x4*)(act + t * 416 + (koff) + k); \
            acc[t][0] += a.x * w0[0] + a.y * w0[1] + a.z * w0[2] + a.w * w0[3]; acc[t][1] += a.x * w1[0] + a.y * w1[1] + a.z * w1[2] + a.w * w1[3]; } \
        _Pragma("unroll") for (int kk = 0; kk < 4; ++kk) { w0[kk] = n0[kk]; w1[kk] = n1[kk]; } } } while (0)
__device__ __forceinline__ void rwkv_prep_item(const Params& p, int l, int item, float* L) {
    const int tid = otid(), lane = tid & 63, wave = tid >> 6;
    const float* P = (const float*)(p.ws + WS_P);
    const float* mu = p.in[13] + (size_t)l * 3488;
    float* act = L; float* bon = L + RW_NT * 416;
    const int sf0 = item * RW_NT, c0 = tid, c1 = tid + 512;
    for (int e = tid; e < RW_NT * 416; e += NTHR) { const int t = e / 416, cc = e % 416; int prow, up, dn; rw_tok(sf0 + t, prow, up, dn);
        float v = rw_shift(P, mu, prow, up, dn, 3072 + cc);
        if (cc < 128) v = tanhf(v); else if (cc >= 256) v = sigmoidf_(v);
        act[e] = v; }
    for (int e = tid; e < RW_NT * 16; e += NTHR) bon[e] = 0.f;
    int* tinfo = (int*)(bon + RW_NT * 16);
    if (tid < RW_NT) { int prow, up, dn; rw_tok(sf0 + tid, prow, up, dn); tinfo[tid * 4] = prow; tinfo[tid * 4 + 1] = up; tinfo[tid * 4 + 2] = dn; }
    __syncthreads();
    float acc[RW_NT][2];
    const float* w0p = p.in[14] + (size_t)l * 2048; const float* a0p = p.in[16] + (size_t)l * 2048;
    const float* w2p = p.in[15] + (size_t)l * 2 * 64 * 1024; const float* a2p = p.in[17] + (size_t)l * 2 * 64 * 1024; const float* g2p = p.in[18] + (size_t)l * 160 * 1024;
    const float* k_k = p.in[19] + (size_t)l * 1024; const float* k_a = p.in[20] + (size_t)l * 1024; const float* r_k = p.in[21] + (size_t)l * 1024;
    unsigned char* RD = p.ws + WS_RWD; unsigned char* RS = p.ws + WS_RWS;
#pragma unroll 1
    for (int d = 0; d < 2; ++d) {
        RW_MATMUL(w2p + (size_t)d * 65536, 64, d * 64);
#pragma unroll
        for (int t = 0; t < RW_NT; ++t) { const int sf = sf0 + t, s = d ? (sf < TCTX ? TCTX - 1 - sf : 8703 - sf) : sf;
#pragma unroll
            for (int cc = 0; cc < 2; ++cc) { const int c = cc ? c1 : c0, hh = c >> 6;
                const float x = w0p[d * 1024 + c] + acc[t][cc];
                const float wl = -softplusf_(-x) - 0.5f;
                *(float*)(RD + ((size_t)(d * 16 + hh) * TTOK + s) * 512 + (c & 63) * 4) = expf(-expf(wl)); } }
        RW_MATMUL(a2p + (size_t)d * 65536, 64, 128 + d * 64);
#pragma unroll
        for (int t = 0; t < RW_NT; ++t) { const int sf = sf0 + t, s = d ? (sf < TCTX ? TCTX - 1 - sf : 8703 - sf) : sf; const int prow = tinfo[t * 4], up = tinfo[t * 4 + 1], dn = tinfo[t * 4 + 2];
#pragma unroll
            for (int cc = 0; cc < 2; ++cc) { const int c = cc ? c1 : c0, hh = c >> 6;
                const float a = sigmoidf_(a0p[d * 1024 + c] + acc[t][cc]);
                const float k = rw_shift(P, mu, prow, up, dn, 1024 + c), r = rw_shift(P, mu, prow, up, dn, c);
                const float kkr = k * k_k[c];
                const float kk = kkr * rsqrtf(wave_sum(kkr * kkr) + 1e-6f);
                const float kd = k * (1.f + (a - 1.f) * k_a[c]);
                unsigned char* rec = RD + ((size_t)(d * 16 + hh) * TTOK + s) * 512;
                *(bf16*)(rec + 256 + (c & 63) * 2) = (bf16)f2bf(kd);
                *(bf16*)(rec + 384 + (c & 63) * 2) = (bf16)f2bf(-(kk * a));
                const float bp = wave_sum(r * kd * r_k[c]);
                if (lane == 0) bon[t * 16 + hh] += bp;
                if (d == 0) { unsigned char* rs = RS + ((size_t)hh * TTOK + sf) * 384;
                    *(bf16*)(rs + (c & 63) * 2) = (bf16)f2bf(r);
                    *(bf16*)(rs + 128 + (c & 63) * 2) = (bf16)f2bf(kk);
                    *(bf16*)(rs + 256 + (c & 63) * 2) = (bf16)f2bf(rw_shift(P, mu, prow, up, dn, 2048 + c)); }
            } }
    }
    RW_MATMUL(g2p, 160, 256);
#pragma unroll
    for (int t = 0; t < RW_NT; ++t) { const int prow = tinfo[t * 4];
        bf16* gt = (bf16*)(p.ws + WS_GATE) + (size_t)prow * 1024;
        gt[c0] = (bf16)f2bf(acc[t][0]); gt[c1] = (bf16)f2bf(acc[t][1]); }
    __syncthreads();
    for (int e = tid; e < RW_NT * 16; e += NTHR) { int prow, up, dn; rw_tok(sf0 + e / 16, prow, up, dn); ((float*)(p.ws + WS_BONUS))[prow * 16 + (e & 15)] = bon[e]; }
    __syncthreads();
}
#define LDS_BARRIER() do { asm volatile("s_waitcnt lgkmcnt(0)" ::: "memory"); __builtin_amdgcn_s_barrier(); asm volatile("" ::: "memory"); } while (0)
__device__ __forceinline__ f32x4 mfma16(bf16x8 a, bf16x8 b, f32x4 c) { return __builtin_amdgcn_mfma_f32_16x16x32_bf16(a, b, c, 0, 0, 0); }
__device__ __forceinline__ void gdn_scan(const Params& p, int b, unsigned char* lds) {
    const int tid = otid(), lane = tid & 63, wave = tid >> 6, r = lane & 15, q = lane >> 4;
    const int s = b & 3, h = (b >> 2) & 7, d = b >> 5;
    bf16* Wb = (bf16*)lds; bf16* Qb = Wb + 2 * 8704; bf16* KTb = Qb + 2 * 8704; bf16* Ab = KTb + 2 * 9216; bf16* Ub = Ab + 2 * 4608; bf16* ST = Ub + 2 * 2560; bf16* VT = ST + 4352;
    const bf16* G = (const bf16*)(p.ws + WS_GDN) + (size_t)((d * 8 + h) * 132) * 36864;
    const float* DLp = (const float*)(p.ws + WS_DL) + (d * 8 + h) * 132;
    float* O = (float*)(p.ws + WS_P) + (size_t)d * TTOK * 1024 + h * 128 + s * 32;
    for (int e = tid; e < 4352; e += NTHR) ST[e] = 0;
    f32x4 S0 = {0.f, 0.f, 0.f, 0.f}, S1 = {0.f, 0.f, 0.f, 0.f};
    v4u pw0, pw1, pq0, pq1, pk0, pk1, pa, pu;
    pu = (v4u){0u, 0u, 0u, 0u};
#define GDN_LOAD(n) do { const bf16* g_ = G + (size_t)(n) * 36864; \
        pw0 = *(const v4u*)(g_ + tid * 8); pw1 = *(const v4u*)(g_ + (tid + 512) * 8); \
        pq0 = *(const v4u*)(g_ + 8192 + tid * 8); pq1 = *(const v4u*)(g_ + 8192 + (tid + 512) * 8); \
        pk0 = *(const v4u*)(g_ + 16384 + tid * 8); pk1 = *(const v4u*)(g_ + 16384 + (tid + 512) * 8); \
        pa = *(const v4u*)(g_ + 24576 + tid * 8); \
        if (tid < 256) pu = *(const v4u*)(g_ + 28672 + (tid >> 2) * 128 + s * 32 + (tid & 3) * 8); } while (0)
#define GDN_STORE(bf) do { \
        *(v4u*)(Wb + (bf) * 8704 + (tid >> 4) * 136 + (tid & 15) * 8) = pw0; *(v4u*)(Wb + (bf) * 8704 + ((tid + 512) >> 4) * 136 + (tid & 15) * 8) = pw1; \
        *(v4u*)(Qb + (bf) * 8704 + (tid >> 4) * 136 + (tid & 15) * 8) = pq0; *(v4u*)(Qb + (bf) * 8704 + ((tid + 512) >> 4) * 136 + (tid & 15) * 8) = pq1; \
        *(v4u*)(KTb + (bf) * 9216 + (tid >> 3) * 72 + (tid & 7) * 8) = pk0; *(v4u*)(KTb + (bf) * 9216 + ((tid + 512) >> 3) * 72 + (tid & 7) * 8) = pk1; \
        *(v4u*)(Ab + (bf) * 4608 + (tid >> 3) * 72 + (tid & 7) * 8) = pa; \
        if (tid < 256) *(v4u*)(Ub + (bf) * 2560 + (tid >> 2) * 40 + (tid & 3) * 8) = pu; } while (0)
    GDN_LOAD(0); GDN_STORE(0);
    __syncthreads();
    const int mi = wave >> 1, nv = wave & 1;
    for (int n = 0; n < 132; ++n) {
        const int bf = n & 1;
        if (n + 1 < 132) GDN_LOAD(n + 1);
        const float dl = DLp[n];
        f32x4 co = {0.f, 0.f, 0.f, 0.f}, cv = {0.f, 0.f, 0.f, 0.f};
#pragma unroll
        for (int kk = 0; kk < 4; ++kk) {
            const bf16x8 sa = *(const bf16x8*)(ST + (16 * nv + r) * 136 + kk * 32 + 8 * q);
            const bf16x8 qa = *(const bf16x8*)(Qb + bf * 8704 + (16 * mi + r) * 136 + kk * 32 + 8 * q);
            const bf16x8 wb = *(const bf16x8*)(Wb + bf * 8704 + (16 * mi + r) * 136 + kk * 32 + 8 * q);
            co = mfma16(qa, sa, co);
            cv = mfma16(sa, wb, cv);
        }
        {
            const v2u uu = *(const v2u*)(Ub + bf * 2560 + (16 * mi + r) * 40 + 16 * nv + 4 * q);
            const float v0 = bflo(uu.x) - cv.x, v1 = bfhi(uu.x) - cv.y, v2 = bflo(uu.y) - cv.z, v3 = bfhi(uu.y) - cv.w;
            bf16* vt = VT + (16 * nv + 4 * q) * 72 + 16 * mi + r;
            vt[0] = (bf16)f2bf(v0); vt[72] = (bf16)f2bf(v1); vt[144] = (bf16)f2bf(v2); vt[216] = (bf16)f2bf(v3);
        }
        LDS_BARRIER();
#pragma unroll
        for (int kk = 0; kk < 2; ++kk) {
            const bf16x8 aa = *(const bf16x8*)(Ab + bf * 4608 + (16 * mi + r) * 72 + kk * 32 + 8 * q);
            const bf16x8 vb = *(const bf16x8*)(VT + (16 * nv + r) * 72 + kk * 32 + 8 * q);
            co = mfma16(aa, vb, co);
        }
        {
            const bool cx = n < 4;
#pragma unroll
            for (int j = 0; j < 4; ++j) { const int ip = 16 * mi + 4 * q + j;
                const int tok = d == 0 ? (cx ? TLAT + n * 64 + ip : (n - 4) * 64 + ip) : (cx ? TLAT + (3 - n) * 64 + 63 - ip : (131 - n) * 64 + 63 - ip);
                O[(size_t)tok * 1024 + 16 * nv + r] = co[j]; }
        }
#pragma unroll
        for (int e = 0; e < 2; ++e) {
            f32x4 Sv = (e ? S1 : S0) * dl; const int nk = 2 * mi + e;
#pragma unroll
            for (int kk = 0; kk < 2; ++kk) {
                const bf16x8 va = *(const bf16x8*)(VT + (16 * nv + r) * 72 + kk * 32 + 8 * q);
                const bf16x8 kb = *(const bf16x8*)(KTb + bf * 9216 + (16 * nk + r) * 72 + kk * 32 + 8 * q);
                Sv = mfma16(va, kb, Sv);
            }
            if (e) S1 = Sv; else S0 = Sv;
            bf16* st = ST + (16 * nv + 4 * q) * 136 + 16 * nk + r;
            st[0] = (bf16)f2bf(Sv.x); st[136] = (bf16)f2bf(Sv.y); st[272] = (bf16)f2bf(Sv.z); st[408] = (bf16)f2bf(Sv.w);
        }
        if (n + 1 < 132) GDN_STORE(bf ^ 1);
        LDS_BARRIER();
    }
}
__device__ __forceinline__ float red16(float x) {
    x += __builtin_bit_cast(float, __builtin_amdgcn_update_dpp(0, __builtin_bit_cast(int, x), 0x128, 0xf, 0xf, false));
    x += __builtin_bit_cast(float, __builtin_amdgcn_update_dpp(0, __builtin_bit_cast(int, x), 0x124, 0xf, 0xf, false));
    x += __builtin_bit_cast(float, __builtin_amdgcn_update_dpp(0, __builtin_bit_cast(int, x), 0x122, 0xf, 0xf, false));
    x += __builtin_bit_cast(float, __builtin_amdgcn_update_dpp(0, __builtin_bit_cast(int, x), 0x121, 0xf, 0xf, false));
    return x;
}
__device__ __forceinline__ void rwkv_compute_chunk(const float* buf, float* opb, int rl, int kg, f32x4& S) {
    constexpr int TB = 32, SF = 336;
    const float* sp = buf + 4 * kg; const float* vp = buf + 320 + rl; float* op = opb + rl * 16 + kg;
    f32x4 w = *(const f32x4*)sp, kd = *(const f32x4*)(sp + 64), nk = *(const f32x4*)(sp + 128), rr = *(const f32x4*)(sp + 192), kk = *(const f32x4*)(sp + 256);
    float v = vp[0];
#pragma unroll 4
    for (int st = 0; st < TB; ++st) {
        const int sn = st < TB - 1 ? st + 1 : st;
        const f32x4 w_n = *(const f32x4*)(sp + sn * SF), kd_n = *(const f32x4*)(sp + sn * SF + 64), nk_n = *(const f32x4*)(sp + sn * SF + 128),
                    rr_n = *(const f32x4*)(sp + sn * SF + 192), kk_n = *(const f32x4*)(sp + sn * SF + 256);
        const float v_n = vp[sn * SF];
        f32x2 d2 = (f32x2){S.x, S.y} * (f32x2){kk.x, kk.y};
        d2 = (f32x2){S.z, S.w} * (f32x2){kk.z, kk.w} + d2;
        const float dot = red16(d2.x + d2.y);
        S = S * w + v * kd + dot * nk;
        f32x2 o2 = (f32x2){S.x, S.y} * (f32x2){rr.x, rr.y};
        o2 = (f32x2){S.z, S.w} * (f32x2){rr.z, rr.w} + o2;
        op[st * 256] = o2.x + o2.y;
        w = w_n; kd = kd_n; nk = nk_n; rr = rr_n; kk = kk_n; v = v_n;
    }
}
__device__ __forceinline__ void rwkv_scan(const Params& p, int b, float* L) {
    const int tid = otid(), lane = tid & 63, wave = tid >> 6;
    const int pair = b >> 2, qt = b & 3, d = pair >> 4, h = pair & 15;
    const unsigned char* RD = p.ws + WS_RWD + (size_t)(d * 16 + h) * TTOK * 512;
    const unsigned char* RS = p.ws + WS_RWS + (size_t)h * TTOK * 384;
    float* O = (float*)(p.ws + WS_P) + (size_t)(2 + d) * TTOK * 1024 + h * 64 + qt * 16;
    constexpr int TB = 32, SF = 336, NCH = TTOK / TB;
    float* OP = L + 2 * TB * SF;
    const int rl = (wave & 3) * 4 + (lane >> 4), kg = lane & 15;
    const int lt = tid - 256;
    float* const dummy = L + 2 * TB * SF + 2 * TB * 256;
    int so[7], dofA[7], dofB[7]; bool isd[7];
#pragma unroll
    for (int i = 0; i < 7; ++i) { const int u = lt + 256 * i, st = u / 50, x = u % 50, sg = d ? -st : st; const bool valid = u < TB * 50;
        so[i] = !valid ? 0 : (x < 32 ? st * 512 + x * 16 : (x < 48 ? sg * 384 + (x - 32) * 16 : sg * 384 + 256 + qt * 32 + (x - 48) * 16));
        isd[i] = !valid || x < 32;
        const int base = st * SF + (x < 16 ? x * 4 : (x < 32 ? 64 + (x - 16) * 8 : (x < 48 ? 192 + (x - 32) * 8 : 320 + (x - 48) * 8)));
        dofA[i] = valid ? base : -1;
        dofB[i] = (valid && x >= 16) ? base + 4 : -1; }
    v4u ldA[7], ldB[7];
#define RW_LOADSET(ld, cc_) do { const int c_ = (cc_) < NCH ? (cc_) : NCH - 1; const unsigned char* rdb = RD + (size_t)c_ * (TB * 512); \
        const int sfb = d == 0 ? c_ * TB : (c_ < 8 ? TCTX - 1 - c_ * TB : 8703 - c_ * TB); const unsigned char* rsb = RS + (size_t)sfb * 384; \
        _Pragma("unroll") for (int i = 0; i < 7; ++i) ld[i] = *(const v4u*)((isd[i] ? rdb : rsb) + so[i]); } while (0)
#define RW_STORESET(ld, cc_) do { const bool live = (cc_) < NCH; float* buf = L + ((cc_) & 1) * (TB * SF); \
        _Pragma("unroll") for (int i = 0; i < 7; ++i) { const v4u v = ld[i]; const bool f32u = dofB[i] < 0; \
            float* d0 = (live && dofA[i] >= 0) ? buf + dofA[i] : dummy; float* d1 = (live && dofB[i] >= 0) ? buf + dofB[i] : dummy; \
            const f32x4 lo = {bflo(v.x), bfhi(v.x), bflo(v.y), bfhi(v.y)}, hi = {bflo(v.z), bfhi(v.z), bflo(v.w), bfhi(v.w)}; \
            *(f32x4*)d0 = f32u ? __builtin_bit_cast(f32x4, v) : lo; *(f32x4*)d1 = hi; } } while (0)
#define RW_ITER(c, LSET, SSET) do { \
        if (wave >= 4) { \
            RW_LOADSET(LSET, (c) + 2); \
            {     \
                const int cm = (c) >= 1 ? (c) - 1 : 0; const float* op = OP + (cm & 1) * (TB * 256); \
                const int st = lt >> 3, r2 = (lt & 7) * 2, s = cm * TB + st; float o[2]; \
                _Pragma("unroll") for (int e = 0; e < 2; ++e) { const float* q = op + st * 256 + (r2 + e) * 16; \
                    const f32x4 a = *(const f32x4*)q, bq = *(const f32x4*)(q + 4), cq = *(const f32x4*)(q + 8), dq = *(const f32x4*)(q + 12); \
                    o[e] = ((a.x + a.y) + (a.z + a.w)) + ((bq.x + bq.y) + (bq.z + bq.w)) + ((cq.x + cq.y) + (cq.z + cq.w)) + ((dq.x + dq.y) + (dq.z + dq.w)); } \
                const int j = s < TCTX ? 0 : (d ? 8447 - s : s - TCTX); \
                const int tok = s < TCTX ? TLAT + (d ? TCTX - 1 - s : s) : (j & 127) * 64 + (j >> 7); \
                *(f32x2*)(O + (size_t)tok * 1024 + r2) = (f32x2){o[0], o[1]}; } \
            RW_STORESET(SSET, (c) + 1); \
        } else if ((c) >= 0 && (c) < NCH) { rwkv_compute_chunk(L + ((c) & 1) * (TB * SF), OP + ((c) & 1) * (TB * 256), rl, kg, S); } \
        LDS_BARRIER(); } while (0)
    f32x4 S = {0.f, 0.f, 0.f, 0.f};
    if (wave >= 4) RW_LOADSET(ldA, 0);
    for (int c = -1; c <= NCH; c += 2) { RW_ITER(c, ldB, ldA); RW_ITER(c + 1, ldA, ldB); }
    __syncthreads();
}

__device__ __forceinline__ void combine_phase(const Params& p, int l, int ntok) {
    const int tid = otid(), lane = tid & 63, gw = blockIdx.x * 8 + (tid >> 6), ngw = gridDim.x * 8;
    const float* OG = (const float*)(p.ws + WS_P); const float* OR = OG + (size_t)2 * TTOK * 1024;
    const bf16* SZ = (const bf16*)(p.ws + WS_SZ); const bf16* GT = (const bf16*)(p.ws + WS_GATE);
    const float* BON = (const float*)(p.ws + WS_BONUS);
    bf16* Y = (bf16*)(p.ws + WS_H);
    const float* ng = p.in[12] + (size_t)l * 128; const float* lng = p.in[22] + (size_t)l * 1024; const float* lnb = p.in[23] + (size_t)l * 1024;
    const f32x2 g2 = *(const f32x2*)(ng + 2 * lane);
    for (int tok = gw; tok < ntok; tok += ngw) {
        const float* of = OG + (size_t)tok * 1024; const float* ob = of + (size_t)TTOK * 1024;
#pragma unroll
        for (int hh = 0; hh < 8; ++hh) {
            const f32x2 a = *(const f32x2*)(of + hh * 128 + 2 * lane) + *(const f32x2*)(ob + hh * 128 + 2 * lane);
            const float rstd = rsqrtf(wave_sum(a.x * a.x + a.y * a.y) * (1.f / 128.f) + 1e-6f);
            const unsigned sz = *(const unsigned*)(SZ + (size_t)tok * 1024 + hh * 128 + 2 * lane);
            *(unsigned*)(Y + (size_t)tok * 2048 + hh * 128 + 2 * lane) = pk2(a.x * rstd * g2.x * bflo(sz), a.y * rstd * g2.y * bfhi(sz));
        }
        int sf; if (tok >= TLAT) sf = tok - TLAT; else sf = TCTX + (tok & 63) * 128 + (tok >> 6);
        const float* rf = OR + (size_t)tok * 1024; const float* rb = rf + (size_t)TTOK * 1024;
#pragma unroll
        for (int hh = 0; hh < 16; ++hh) {
            const int c = hh * 64 + lane;
            const float o = rf[c] + rb[c];
            const float mean = wave_sum(o) * (1.f / 64.f), dv = o - mean;
            const float var = wave_sum(dv * dv) * (1.f / 64.f);
            float y = dv * rsqrtf(var + 64e-5f) * lng[c] + lnb[c];
            const float v = bf2f(*(const bf16*)(p.ws + WS_RWS + ((size_t)hh * TTOK + sf) * 384 + 256 + lane * 2));
            y = (y + BON[tok * 16 + hh] * v) * bf2f(GT[(size_t)tok * 1024 + c]);
            Y[(size_t)tok * 2048 + 1024 + c] = (bf16)f2bf(y);
        }
    }
}
#ifndef ONE_LAUNCH
#define ONE_LAUNCH 1
#endif
constexpr int N_PHASES = 20;
#if ONE_LAUNCH
#define PH(k) (true)
#define SEAM(k) cg::this_grid().sync()
#else
#define PH(k) (p.ph_lo == (k))
#define SEAM(k) do {} while (0)
#endif
#define PHON(k) ((PHMASK >> (k)) & 1)
#ifndef DUPMASK
#define DUPMASK 0
#endif
#define REP(k) for (int rep_ = 0; rep_ <= ((DUPMASK >> (k)) & 1); ++rep_) if (rep_ == 0 || (cg::this_grid().sync(), true))
template <int PHMASK, int l> __device__ __forceinline__ void layer_phases(const Params& p, unsigned char* lds) {
    float* L = (float*)lds;
    const int b = blockIdx.x, G = gridDim.x;
    float* lat_c = (float*)(p.ws + WS_LATC);
    const float* mod = (const float*)(p.ws + WS_MOD);
    constexpr int M = l == 0 ? TTOK : TLAT;
    constexpr int B0 = 1 + 9 * l;
    const float* res_l = l == 0 ? p.in[0] : p.out; const float* res_c = l == 0 ? p.in[2] : lat_c;
    const float* mod_l = mod + (size_t)(l * 2) * 12288; const float* mod_c = mod_l + 12288;
    REP(0) if (PH(B0 + 0) && PHON(0)) {
        if (l == 1) { const int tid = otid(); convert_weights(p, 1, b * 8 + (tid >> 6), G * 8, L + (tid >> 6) * 2112, tid & 63); }
        norm_phase(p, l, res_l, res_c, p.in[6] + (size_t)l * DM, 0, 1, TTOK);
    }
    SEAM(B0 + 0);
    REP(1) if (PH(B0 + 1) && PHON(1)) {
        pg8::Gemm g{(const pg8::bf16_t*)(p.ws + WS_H), (const pg8::bf16_t*)(p.ws + WS_WT_IN), TTOK, PINP, DM}; pg8::StaticOrder S; S.init(TTOK, PINP, G, b);
        pg8::EpiF32 E{(float*)(p.ws + WS_P), PINP};
        pg8::gemm_phase<pg8::EpiF32, pg8::StaticOrder, true, true>((PG8_LAS unsigned char*)lds, g, S, E);
    }
    SEAM(B0 + 1);
    REP(2) if (PH(B0 + 2)) {
        if (PHON(2)) for (int r2_ = 0; r2_ <= ((DUPMASK >> 14) & 1); ++r2_) for (int it = b; it < 768; it += G) rwkv_prep_item(p, l, it, L);
        if (PHON(11)) for (int r2_ = 0; r2_ <= ((DUPMASK >> 15) & 1); ++r2_) for (int it = b; it < 1056; it += G) gdn_prep_item(p, l, it, L);
    }
    SEAM(B0 + 2);
    REP(3) if (PH(B0 + 3) && PHON(3)) {
        if (b < 64) for (int r2_ = 0; r2_ <= ((DUPMASK >> 12) & 1); ++r2_) { if (r2_) __syncthreads(); gdn_scan(p, b, lds); }
        if (b >= 64 && b < 192) for (int r2_ = 0; r2_ <= ((DUPMASK >> 13) & 1); ++r2_) rwkv_scan(p, b - 64, L);
    }
    SEAM(B0 + 3);
    REP(4) if (PH(B0 + 4) && PHON(4)) combine_phase(p, l, M);
    SEAM(B0 + 4);
    REP(5) if (PH(B0 + 5) && PHON(5)) {
        pg8::Gemm g{(const pg8::bf16_t*)(p.ws + WS_H), (const pg8::bf16_t*)(p.ws + WS_WT_OUT), M, DM, DM}; pg8::StaticOrder S; S.init(M, DM, G, b);
        pg8::EpiRes E{res_l, res_c, p.out, lat_c, mod_l + 2 * DM, mod_c + 2 * DM};
        pg8::gemm_phase<pg8::EpiRes, pg8::StaticOrder, true, true>((PG8_LAS unsigned char*)lds, g, S, E);
    }
    SEAM(B0 + 5);
    REP(6) if (PH(B0 + 6) && PHON(6)) norm_phase(p, l, p.out, lat_c, p.in[7] + (size_t)l * DM, 3, 4, M);
    SEAM(B0 + 6);
    REP(7) if (PH(B0 + 7) && PHON(7)) {
        pg8::Gemm g{(const pg8::bf16_t*)(p.ws + WS_H), (const pg8::bf16_t*)(p.ws + WS_WT_1), M, DFF, DM}; pg8::StaticOrder S; S.init(M, DFF, G, b);
        pg8::EpiRelu2 E{(pg8::bf16_t*)(p.ws + WS_P), DFF};
        pg8::gemm_phase<pg8::EpiRelu2, pg8::StaticOrder, true, true>((PG8_LAS unsigned char*)lds, g, S, E);
    }
    SEAM(B0 + 7);
    REP(8) if (PH(B0 + 8) && PHON(8)) {
        pg8::Gemm g{(const pg8::bf16_t*)(p.ws + WS_P), (const pg8::bf16_t*)(p.ws + WS_WT_2), M, DM, DFF}; pg8::StaticOrder S; S.init(M, DM, G, b);
        pg8::EpiRes E{p.out, lat_c, p.out, lat_c, mod_l + 5 * DM, mod_c + 5 * DM};
        pg8::gemm_phase<pg8::EpiRes, pg8::StaticOrder, true, true>((PG8_LAS unsigned char*)lds, g, S, E);
    }
    SEAM(B0 + 8);
}
template <int PHMASK> __global__ void __launch_bounds__(NTHR) fwd_megakernel(Params p) {
    extern __shared__ __attribute__((aligned(16))) unsigned char lds[];
    REP(9) if (PH(0) && PHON(9)) phase0(p, (float*)lds);
    SEAM(0);
    layer_phases<PHMASK, 0>(p, lds);
    layer_phases<PHMASK, 1>(p, lds);
    if (PH(19) && PHON(10)) final_norm(p);
}

extern "C" void kernel_launch(void* const* d_in, const int* in_sizes, int n_in, void* d_out, int out_size, void* d_ws, size_t ws_size, hipStream_t stream) {
    static int grid = 0;
    if (grid == 0) {
        if (n_in != 28 || ws_size < WS_END) { fprintf(stderr, "kernel_launch: need 28 inputs and %zu bytes of workspace (got %d, %zu)\n", (size_t)WS_END, n_in, ws_size); grid = -1; return; }
        int dev = 0, cus = 0, per_cu = 0;
        (void)hipGetDevice(&dev); (void)hipDeviceGetAttribute(&cus, hipDeviceAttributeMultiprocessorCount, dev);
#if ONE_LAUNCH
        (void)hipFuncSetAttribute((const void*)fwd_megakernel<0xFFFF>, hipFuncAttributeMaxDynamicSharedMemorySize, LDS_BYTES);
        (void)hipOccupancyMaxActiveBlocksPerMultiprocessor(&per_cu, (const void*)fwd_megakernel<0xFFFF>, NTHR, LDS_BYTES);
#else
#define SETATTR(K) (void)hipFuncSetAttribute((const void*)fwd_megakernel<(1 << K)>, hipFuncAttributeMaxDynamicSharedMemorySize, LDS_BYTES)
        SETATTR(0); SETATTR(1); SETATTR(2); SETATTR(3); SETATTR(4); SETATTR(5); SETATTR(6); SETATTR(7); SETATTR(8); SETATTR(9); SETATTR(10); SETATTR(11);
        per_cu = 1;
#endif
        if (per_cu < 1) { fprintf(stderr, "kernel_launch: occupancy query says %d blocks per CU\n", per_cu); grid = -1; return; }
        grid = cus;
        (void)hipGetLastError();
    }
    if (grid < 0) return;
    Params p{};
    for (int i = 0; i < 28; ++i) p.in[i] = (const float*)d_in[i];
    p.out = (float*)d_out; p.ws = (unsigned char*)d_ws;
#if ONE_LAUNCH
    p.ph_lo = 0; p.ph_hi = N_PHASES;
    void* args[] = {&p};
    hipError_t e = hipLaunchCooperativeKernel((const void*)fwd_megakernel<0xFFFF>, dim3(grid), dim3(NTHR), args, LDS_BYTES, stream);
    if (e != hipSuccess) fprintf(stderr, "cooperative launch failed: %s (grid %d)\n", hipGetErrorString(e), grid);
#else
#define LAUNCH1(K) hipLaunchKernelGGL(fwd_megakernel<(1 << K)>, dim3(grid), dim3(NTHR), LDS_BYTES, stream, p)
    for (int ph = 0; ph < N_PHASES; ++ph) { p.ph_lo = ph; p.ph_hi = ph + 1;
        if (ph == 0) { LAUNCH1(9); continue; }
        if (ph == 19) { LAUNCH1(10); continue; }
        switch ((ph - 1) % 9) {
        case 0: LAUNCH1(0); break; case 1: LAUNCH1(1); break; case 2: LAUNCH1(2); LAUNCH1(11); break; case 3: LAUNCH1(3); break; case 4: LAUNCH1(4); break;
        case 5: LAUNCH1(5); break; case 6: LAUNCH1(6); break; case 7: LAUNCH1(7); break; case 8: LAUNCH1(8); break; }
    }
#endif
}
```

```cpp
#include <hip/hip_runtime.h>
#include <hip/hip_cooperative_groups.h>
#include <cstdio>
#include <cstdint>
namespace cg = cooperative_groups;
__device__ __forceinline__ int otid() { int t = threadIdx.x; asm volatile("" : "+v"(t)); return t; }
namespace pg8 {
#define PG8_LAS __attribute__((address_space(3)))
typedef unsigned short bf16_t;
typedef short bf16x8 __attribute__((ext_vector_type(8)));
typedef float f32x4 __attribute__((ext_vector_type(4)));
typedef unsigned u32x4 __attribute__((ext_vector_type(4)));
constexpr int BM = 256, BK = 64, HALF = 128, HTB = HALF * BK * 2  , STAGE_BYTES = 8 * HTB, NXCD = 8, WGM = 8;

__host__ __device__ __forceinline__ int lds_byte(int r, int c) { const int st = (r >> 4) * 2 + (c >> 5), rr = r & 15, cc = c & 31, ob = rr * 64 + cc * 2; return st * 1024 + (ob ^ (((ob >> 9) & 1) << 5)); }
__host__ __device__ __forceinline__ void stage_rc(int b, int& R, int& C) { const int st = b / 1024, sb = b % 1024, swz = sb ^ (((sb >> 9) & 1) << 5); R = (st >> 1) * 16 + swz / 64; C = (st & 1) * 32 + (swz % 64) / 2; }
__host__ __device__ __forceinline__ int perm32(int rho) { const int n = rho >> 4, i = rho & 15; return 8 * (i >> 2) + 4 * n + (i & 3); }

struct Unit { int pm, pn; };
struct Gemm { const bf16_t* A; const bf16_t* Bt; int M, N, K; };

struct StaticOrder {
    int nM, nN, nwg, G, c;
    __host__ __device__ void init(int M, int N, int G_, int c_) { nM = M / BM; nN = N / BM; nwg = nM * nN; G = G_; c = c_; }
    __host__ __device__ bool next(int i, Unit& u) const {
        const long L = (long)i * G + c; if (L >= nwg) return false;
        int wgid = (int)L; { const int q = nwg / NXCD, r = nwg % NXCD, xcd = wgid % NXCD, off = wgid / NXCD; wgid = (xcd < r ? xcd * (q + 1) : r * (q + 1) + (xcd - r) * q) + off; }
        const int nig = WGM * nN, gid = wgid / nig, fm = gid * WGM, gsz = (nM - fm) < WGM ? (nM - fm) : WGM;
        u.pm = fm + ((wgid % nig) % gsz); u.pn = (wgid % nig) / gsz; return true;
    }
    __device__ __forceinline__ void a_ready(const Unit&) const {}
    __device__ __forceinline__ void done(const Unit&) const {}
};

__device__ __forceinline__ unsigned cvt_pk_bf16(float lo, float hi) { unsigned r; asm volatile("v_cvt_pk_bf16_f32 %0, %1, %2" : "=v"(r) : "v"(lo), "v"(hi)); return r; }
struct EpiF32 {
    static constexpr bool PERM = false, AFTER_DRAIN = false;
    float* O; int ldc;
    __device__ __forceinline__ void operator()(const f32x4 (&acc)[2][2][4][2], const Unit& u, int wr, int wc, int fr, int fq) const {
        const int row0 = u.pm * BM + wr * 64 + fr, col0 = u.pn * BM + wc * 32 + 4 * fq;
#pragma unroll
        for (int ai = 0; ai < 2; ++ai)
#pragma unroll
            for (int m = 0; m < 4; ++m) { float* rowp = O + (size_t)(row0 + ai * HALF + m * 16) * ldc + col0;
#pragma unroll
                for (int bj = 0; bj < 2; ++bj)
#pragma unroll
                    for (int n = 0; n < 2; ++n) *(f32x4*)(rowp + bj * HALF + n * 16) = acc[ai][bj][m][n]; }
    }
    __device__ __forceinline__ void fused(f32x4 (&)[2][2][4][2], const Unit&, int, int, int, int, PG8_LAS unsigned char*, int, int) const {}
};
struct EpiRes {
    static constexpr bool PERM = false, AFTER_DRAIN = false;
    const float* res_l; const float* res_c; float* out_l; float* out_c; const float* gate_l; const float* gate_c;
    __device__ __forceinline__ void operator()(const f32x4 (&acc)[2][2][4][2], const Unit& u, int wr, int wc, int fr, int fq) const {
        const bool isc = u.pm >= 32;
        const float* res = isc ? res_c : res_l; float* out = isc ? out_c : out_l; const float* gate = isc ? gate_c : gate_l;
        const int row0 = (isc ? u.pm - 32 : u.pm) * BM + wr * 64 + fr, col0 = u.pn * BM + wc * 32 + 4 * fq;
        f32x4 gv[2][2];
#pragma unroll
        for (int bj = 0; bj < 2; ++bj)
#pragma unroll
            for (int n = 0; n < 2; ++n) gv[bj][n] = *(const f32x4*)(gate + col0 + bj * HALF + n * 16);
#pragma unroll
        for (int ai = 0; ai < 2; ++ai)
#pragma unroll
            for (int m = 0; m < 4; ++m) { const size_t off = (size_t)(row0 + ai * HALF + m * 16) * 2048 + col0;
#pragma unroll
                for (int bj = 0; bj < 2; ++bj)
#pragma unroll
                    for (int n = 0; n < 2; ++n) { const f32x4 r = *(const f32x4*)(res + off + bj * HALF + n * 16);
                        *(f32x4*)(out + off + bj * HALF + n * 16) = r + gv[bj][n] * acc[ai][bj][m][n]; } }
    }
    __device__ __forceinline__ void fused(f32x4 (&)[2][2][4][2], const Unit&, int, int, int, int, PG8_LAS unsigned char*, int, int) const {}
};
struct EpiRelu2 {
    static constexpr bool PERM = true, AFTER_DRAIN = false;
    bf16_t* O; int ldc;
    __device__ __forceinline__ void operator()(const f32x4 (&acc)[2][2][4][2], const Unit& u, int wr, int wc, int fr, int fq) const {
        const int row0 = u.pm * BM + wr * 64 + fr, col0 = u.pn * BM + wc * 32 + 8 * fq;
#pragma unroll
        for (int ai = 0; ai < 2; ++ai)
#pragma unroll
            for (int m = 0; m < 4; ++m) { bf16_t* rowp = O + (size_t)(row0 + ai * HALF + m * 16) * ldc + col0;
#pragma unroll
                for (int bj = 0; bj < 2; ++bj) { f32x4 v0 = acc[ai][bj][m][0], v1 = acc[ai][bj][m][1];
#pragma unroll
                    for (int e = 0; e < 4; ++e) { const float a = fmaxf(v0[e], 0.f), b = fmaxf(v1[e], 0.f); v0[e] = a * a; v1[e] = b * b; }
                    u32x4 w; w.x = cvt_pk_bf16(v0[0], v0[1]); w.y = cvt_pk_bf16(v0[2], v0[3]); w.z = cvt_pk_bf16(v1[0], v1[1]); w.w = cvt_pk_bf16(v1[2], v1[3]);
                    *(u32x4*)(rowp + bj * HALF) = w; } }
    }
    __device__ __forceinline__ void fused(f32x4 (&)[2][2][4][2], const Unit&, int, int, int, int, PG8_LAS unsigned char*, int, int) const {}
};
template <class Epi, class Sched, bool ALIGN_EPI = false, bool SP2 = false>
__device__ __forceinline__ void gemm_phase(PG8_LAS unsigned char* lds, const Gemm g, const Sched& S, const Epi& E) {
    const int tid = otid(), wid = __builtin_amdgcn_readfirstlane(tid >> 6), lane = tid & 63, wr = wid >> 2, wc = wid & 3, fr = lane & 15, fq = lane >> 4;
    const int K = g.K, nt = K / BK;
    unsigned voffA[2], voffB[2];
#pragma unroll
    for (int i = 0; i < 2; ++i) { int R, C; stage_rc(tid * 16 + i * 8192, R, C); const int Rb = Epi::PERM ? ((R & ~31) + perm32(R & 31)) : R;
        voffA[i] = (unsigned)(R * K + C) * 2u; voffB[i] = (unsigned)(Rb * K + C) * 2u; }
    const size_t kstep = (size_t)(BK * 2);
    const size_t hstep = (size_t)HALF * K * 2;
    const size_t tstep = 2 * hstep;
    const unsigned ldsw = (unsigned)wid * 1024u;
    const int aoff = lds_byte(wr * 64 + fr, fq * 8), boff = lds_byte(wc * 32 + fr, fq * 8);
#define PG8_SA(b, h) (((b) * 2 + (h)) * HTB)
#define PG8_SB(b, h) ((4 + (b) * 2 + (h)) * HTB)
#define PG8_STAGE(bufoff, gbase, voff) do { _Pragma("unroll") for (int _i = 0; _i < 2; ++_i) \
        __builtin_amdgcn_global_load_lds((const unsigned*)((const char*)(gbase) + (voff)[_i]), (PG8_LAS unsigned*)(lds + (bufoff) + ldsw + _i * 8192), 16, 0, 0); } while (0)
#define PG8_LDA(dst, b, h) do { _Pragma("unroll") for (int m = 0; m < 4; ++m) _Pragma("unroll") for (int k = 0; k < 2; ++k) dst[m][k] = *(const PG8_LAS bf16x8*)(lds + PG8_SA(b, h) + aoff + m * 2048 + k * 1024); } while (0)
#define PG8_LDB(dst, b, h) do { _Pragma("unroll") for (int n = 0; n < 2; ++n) _Pragma("unroll") for (int k = 0; k < 2; ++k) dst[n][k] = *(const PG8_LAS bf16x8*)(lds + PG8_SB(b, h) + boff + n * 2048 + k * 1024); } while (0)
#define PG8_MMA(ai, bj, At, Bt) do { __builtin_amdgcn_s_setprio(1); _Pragma("unroll") for (int m = 0; m < 4; ++m) _Pragma("unroll") for (int n = 0; n < 2; ++n) _Pragma("unroll") for (int k = 0; k < 2; ++k) \
        acc[ai][bj][m][n] = __builtin_amdgcn_mfma_f32_16x16x32_bf16(Bt[n][k], At[m][k], acc[ai][bj][m][n], 0, 0, 0); __builtin_amdgcn_s_setprio(0); } while (0)
#define PG8_WAIT_V(n) asm volatile("s_waitcnt vmcnt(" #n ")" ::: "memory")
#define PG8_WAIT_L(n) asm volatile("s_waitcnt lgkmcnt(" #n ")" ::: "memory")
#define PG8_BAR __builtin_amdgcn_s_barrier()
#define PG8_SCHED __builtin_amdgcn_sched_barrier(0)
    Unit cur, nxt; int ui = 0;
    if (!S.next(0, cur)) return;
    f32x4 acc[2][2][4][2];
#pragma unroll
    for (int a = 0; a < 2; ++a)
#pragma unroll
        for (int b = 0; b < 2; ++b)
#pragma unroll
            for (int m = 0; m < 4; ++m)
#pragma unroll
                for (int n = 0; n < 2; ++n) acc[a][b][m][n] = (f32x4){0.f, 0.f, 0.f, 0.f};
    bf16x8 At[4][2], B0[2][2], B1[2][2];
    const char* cA = (const char*)g.A + (size_t)cur.pm * tstep; const char* cB = (const char*)g.Bt + (size_t)cur.pn * tstep;
    S.a_ready(cur);
    if constexpr (SP2) {
        PG8_STAGE(PG8_SB(0, 0), cB, voffB); PG8_STAGE(PG8_SB(0, 1), cB + hstep, voffB); PG8_STAGE(PG8_SA(0, 0), cA, voffA); PG8_STAGE(PG8_SA(0, 1), cA + hstep, voffA);
        if (wr == 1) PG8_BAR;
        PG8_WAIT_V(2); PG8_BAR;
        PG8_STAGE(PG8_SB(1, 0), cB + kstep, voffB); PG8_STAGE(PG8_SA(1, 0), cA + kstep, voffA); PG8_STAGE(PG8_SB(1, 1), cB + hstep + kstep, voffB);
        PG8_WAIT_V(6); PG8_BAR;
    } else {
        PG8_STAGE(PG8_SB(0, 0), cB, voffB); PG8_STAGE(PG8_SA(0, 0), cA, voffA); PG8_STAGE(PG8_SB(0, 1), cB + hstep, voffB); PG8_STAGE(PG8_SA(0, 1), cA + hstep, voffA);
        if (wr == 1) PG8_BAR;
        PG8_WAIT_V(4); PG8_BAR;
        PG8_STAGE(PG8_SB(1, 0), cB + kstep, voffB); PG8_STAGE(PG8_SA(1, 0), cA + kstep, voffA); PG8_STAGE(PG8_SB(1, 1), cB + hstep + kstep, voffB);
        PG8_WAIT_V(6); PG8_BAR;
    }
    for (;;) {
        const bool has_next = S.next(ui + 1, nxt);
        const char* nA = has_next ? (const char*)g.A + (size_t)nxt.pm * tstep : cA; const char* nB = has_next ? (const char*)g.Bt + (size_t)nxt.pn * tstep : cB;
        for (int t = 0; t < nt; t += 2) {
            const bool last = (t == nt - 2);
            const char* a1 = cA + (size_t)(t + 1) * kstep;
            const char* a2 = last ? nA : cA + (size_t)(t + 2) * kstep; const char* b2 = last ? nB : cB + (size_t)(t + 2) * kstep;
            const char* a3 = a2 + kstep; const char* b3 = b2 + kstep;
            if (last && has_next) S.a_ready(nxt);
            if constexpr (SP2) {
            PG8_LDB(B0, 0, 0); PG8_LDB(B1, 0, 1); PG8_SCHED; PG8_LDA(At, 0, 0); PG8_STAGE(PG8_SA(1, 1), a1 + hstep, voffA);
            PG8_WAIT_V(8); PG8_WAIT_L(0); PG8_BAR; PG8_MMA(0, 0, At, B0); PG8_MMA(0, 1, At, B1); PG8_BAR; PG8_SCHED;
            PG8_LDA(At, 0, 1); PG8_STAGE(PG8_SB(0, 0), b2, voffB); PG8_STAGE(PG8_SB(0, 1), b2 + hstep, voffB); PG8_STAGE(PG8_SA(0, 0), a2, voffA);
            PG8_WAIT_V(8); PG8_WAIT_L(0); PG8_BAR; PG8_MMA(1, 0, At, B0); PG8_MMA(1, 1, At, B1); PG8_BAR; PG8_SCHED;
            PG8_LDB(B0, 1, 0); PG8_LDB(B1, 1, 1); PG8_SCHED; PG8_LDA(At, 1, 0); PG8_STAGE(PG8_SA(0, 1), a2 + hstep, voffA);
            PG8_WAIT_V(8); PG8_WAIT_L(0); PG8_BAR; PG8_MMA(0, 0, At, B0); PG8_MMA(0, 1, At, B1); PG8_BAR; PG8_SCHED;
            PG8_LDA(At, 1, 1); PG8_STAGE(PG8_SB(1, 0), b3, voffB); PG8_STAGE(PG8_SB(1, 1), b3 + hstep, voffB); PG8_STAGE(PG8_SA(1, 0), a3, voffA);
            PG8_WAIT_V(8); PG8_WAIT_L(0); PG8_BAR; PG8_MMA(1, 0, At, B0); PG8_MMA(1, 1, At, B1); PG8_BAR; PG8_SCHED;
            } else {
            PG8_LDB(B0, 0, 0); PG8_SCHED; PG8_LDA(At, 0, 0); PG8_STAGE(PG8_SA(1, 1), a1 + hstep, voffA);
            PG8_WAIT_L(8); PG8_BAR; PG8_WAIT_L(0); PG8_MMA(0, 0, At, B0); PG8_BAR; PG8_SCHED;
            PG8_LDB(B1, 0, 1); PG8_STAGE(PG8_SB(0, 0), b2, voffB);
            PG8_BAR; PG8_WAIT_L(0); PG8_MMA(0, 1, At, B1); PG8_BAR;
            PG8_LDA(At, 0, 1); PG8_STAGE(PG8_SA(0, 0), a2, voffA);
            PG8_BAR; PG8_WAIT_L(0); PG8_MMA(1, 0, At, B0); PG8_BAR; PG8_SCHED;
            PG8_STAGE(PG8_SB(0, 1), b2 + hstep, voffB);
            PG8_WAIT_V(6); PG8_BAR; PG8_MMA(1, 1, At, B1); PG8_BAR;
            PG8_LDB(B0, 1, 0); PG8_SCHED; PG8_LDA(At, 1, 0); PG8_STAGE(PG8_SA(0, 1), a2 + hstep, voffA);
            PG8_WAIT_L(8); PG8_BAR; PG8_WAIT_L(0); PG8_MMA(0, 0, At, B0); PG8_BAR; PG8_SCHED;
            PG8_LDB(B1, 1, 1); PG8_STAGE(PG8_SB(1, 0), b3, voffB);
            PG8_BAR; PG8_WAIT_L(0); PG8_MMA(0, 1, At, B1); PG8_BAR;
            PG8_LDA(At, 1, 1); PG8_STAGE(PG8_SA(1, 0), a3, voffA);
            PG8_BAR; PG8_WAIT_L(0); PG8_MMA(1, 0, At, B0); PG8_BAR; PG8_SCHED;
            PG8_STAGE(PG8_SB(1, 1), b3 + hstep, voffB);
            PG8_WAIT_V(6); PG8_BAR; PG8_MMA(1, 1, At, B1); PG8_BAR;
            }
        }
        if constexpr (ALIGN_EPI) { if (wr == 0) PG8_BAR; }
        if constexpr (!Epi::AFTER_DRAIN) { E(acc, cur, wr, wc, fr, fq); S.done(cur); }
        if (!has_next) break;
#pragma unroll
        for (int a = 0; a < 2; ++a)
#pragma unroll
            for (int b = 0; b < 2; ++b)
#pragma unroll
                for (int m = 0; m < 4; ++m)
#pragma unroll
                    for (int n = 0; n < 2; ++n) acc[a][b][m][n] = (f32x4){0.f, 0.f, 0.f, 0.f};
        cur = nxt; cA = nA; cB = nB; ++ui;
        if constexpr (ALIGN_EPI) { if (wr == 1) PG8_BAR; }
    }
    PG8_WAIT_V(0);
    if constexpr (!ALIGN_EPI) { if (wr == 0) PG8_BAR; }
    PG8_BAR;
    if constexpr (Epi::AFTER_DRAIN) { E.fused(acc, cur, wr, wc, fr, fq, lds, wid, lane); S.done(cur); }
#undef PG8_SA
#undef PG8_SB
#undef PG8_STAGE
#undef PG8_LDA
#undef PG8_LDB
#undef PG8_MMA
#undef PG8_WAIT_V
#undef PG8_WAIT_L
#undef PG8_BAR
#undef PG8_SCHED
}
}
#define LAS __attribute__((address_space(3)))
typedef unsigned short bf16;
typedef float f32x4 __attribute__((ext_vector_type(4)));
typedef float f32x2 __attribute__((ext_vector_type(2)));
typedef short bf16x8 __attribute__((ext_vector_type(8)));
typedef unsigned v4u __attribute__((ext_vector_type(4)));
typedef unsigned v2u __attribute__((ext_vector_type(2)));

constexpr int NTHR = 512;
constexpr int LDS_BYTES = 155648;
constexpr int DM = 2048, TLAT = 8192, TCTX = 256, TTOK = 8448, PINP = 7680, DFF = 8192;
constexpr size_t MiB = 1u << 20;
constexpr size_t WS_MOD = 0;
constexpr size_t WS_DL = 256 * 1024;
constexpr size_t WS_BONUS = 512 * 1024;
constexpr size_t WS_BAR = 1536 * 1024;
constexpr size_t WS_LATC = 2 * MiB;
constexpr size_t WS_WT_IN = 4 * MiB, WS_WT_OUT = 34 * MiB, WS_WT_1 = 42 * MiB, WS_WT_2 = 74 * MiB;
constexpr size_t WS_H = 106 * MiB;
constexpr size_t WS_SZ = 139 * MiB;
constexpr size_t WS_GATE = WS_SZ + (size_t)TTOK * 1024 * 2;
constexpr size_t WS_P = 172 * MiB;
constexpr size_t WS_GDN = 420 * MiB;
constexpr size_t WS_RWD = 569 * MiB;
constexpr size_t WS_RWS = WS_RWD + (size_t)2 * 16 * TTOK * 512;
constexpr size_t WS_WSM = 752 * MiB;
constexpr size_t WS_END = WS_WSM + (size_t)2 * 1024 * 416 * 2;
static_assert(WS_RWS + (size_t)16 * TTOK * 384 <= WS_WSM, "ws map");
static_assert(WS_GATE + (size_t)TTOK * 1024 * 2 <= WS_P && WS_P + (size_t)TTOK * PINP * 4 <= WS_GDN && WS_GDN + (size_t)2 * 8 * 132 * 36864 * 2 <= WS_RWD, "ws map");
static_assert(WS_END <= 768 * MiB, "ws size");

struct Params { const float* in[28]; float* out; unsigned char* ws; int ph_lo, ph_hi; };

__device__ __forceinline__ unsigned f2bf(float f) { unsigned u = __builtin_bit_cast(unsigned, f); return (u + 0x7fffu + ((u >> 16) & 1u)) >> 16; }
__device__ __forceinline__ unsigned pk2(float lo, float hi) { return f2bf(lo) | (f2bf(hi) << 16); }
__device__ __forceinline__ float bf2f(unsigned b) { return __builtin_bit_cast(float, b << 16); }
__device__ __forceinline__ float bflo(unsigned w) { return __builtin_bit_cast(float, w << 16); }
__device__ __forceinline__ float bfhi(unsigned w) { return __builtin_bit_cast(float, w & 0xffff0000u); }
__device__ __forceinline__ float wave_sum(float v) {
#pragma unroll
    for (int o = 1; o < 64; o <<= 1) v += __shfl_xor(v, o);
    return v;
}
__device__ __forceinline__ float sigmoidf_(float x) { return 1.f / (1.f + expf(-x)); }
__device__ __forceinline__ float siluf_(float x) { return x / (1.f + expf(-x)); }
__device__ __forceinline__ float softplusf_(float x) { return x > 20.f ? x : log1pf(expf(x)); }
#define LDS_WAIT() asm volatile("s_waitcnt lgkmcnt(0)" ::: "memory")

__device__ __forceinline__ void transpose_item(const float* W, int K, int N, bf16* WT, float* scr, int item, int lane) {
    const int nblk = N / 32, kb = item / nblk, nb = item % nblk, k0 = 64 * kb, n0 = 32 * nb;
#pragma unroll 8
    for (int i = 0; i < 32; ++i) { const int kk = 2 * i + (lane >> 5); scr[kk * 33 + (lane & 31)] = W[(size_t)(k0 + kk) * N + n0 + (lane & 31)]; }
    LDS_WAIT();
    const int c = lane & 7;
#pragma unroll
    for (int j = 0; j < 4; ++j) { const int n = (lane >> 3) + 8 * j; const float* s = scr + (8 * c) * 33 + n;
        v4u o; o.x = pk2(s[0 * 33], s[1 * 33]); o.y = pk2(s[2 * 33], s[3 * 33]); o.z = pk2(s[4 * 33], s[5 * 33]); o.w = pk2(s[6 * 33], s[7 * 33]);
        *(v4u*)(WT + (size_t)(n0 + n) * K + k0 + 8 * c) = o; }
    LDS_WAIT();
}
__device__ __forceinline__ void convert_weights(const Params& p, int l, int gw, int ngw, float* scr, int lane) {
    const float* w_in = p.in[8] + (size_t)l * 2048 * 7616; const float* w_out = p.in[24] + (size_t)l * 2048 * 2048;
    const float* w1 = p.in[25] + (size_t)l * 2048 * 8192; const float* w2 = p.in[26] + (size_t)l * 8192 * 2048;
    bf16* t_in = (bf16*)(p.ws + WS_WT_IN); bf16* t_out = (bf16*)(p.ws + WS_WT_OUT); bf16* t_1 = (bf16*)(p.ws + WS_WT_1); bf16* t_2 = (bf16*)(p.ws + WS_WT_2);
    for (int it = gw; it < 26048; it += ngw) {
        int r = it;
        if (r < 7616) { transpose_item(w_in, 2048, 7616, t_in, scr, r, lane); continue; } r -= 7616;
        if (r < 2048) { transpose_item(w_out, 2048, 2048, t_out, scr, r, lane); continue; } r -= 2048;
        if (r < 8192) { transpose_item(w1, 2048, 8192, t_1, scr, r, lane); continue; } r -= 8192;
        transpose_item(w2, 8192, 2048, t_2, scr, r, lane);
    }
}
__device__ __forceinline__ void phase0(const Params& p, float* L) {
    const int tid = otid(), lane = tid & 63, wave = tid >> 6, G = gridDim.x, b = blockIdx.x;
    { v4u z = {0u, 0u, 0u, 0u}; v4u* dst = (v4u*)((bf16*)(p.ws + WS_WT_IN) + (size_t)7616 * 2048);
      for (int i = b * NTHR + tid; i < 64 * 2048 / 8; i += G * NTHR) dst[i] = z; }
    convert_weights(p, 0, b * 8 + wave, G * 8, L + wave * 2112, lane);
    for (int t = b * NTHR + tid; t < 2 * 52 * 1024; t += G * NTHR) {
        const int n = t & 1023, kg = (t >> 10) % 52, l = t / (52 * 1024), k0 = kg * 8;
        const float* src; int kk0;
        if (k0 < 128) { src = p.in[15] + ((size_t)(l * 2 + (k0 >> 6)) * 64) * 1024; kk0 = k0 & 63; }
        else if (k0 < 256) { src = p.in[17] + ((size_t)(l * 2 + ((k0 - 128) >> 6)) * 64) * 1024; kk0 = k0 & 63; }
        else { src = p.in[18] + (size_t)l * 160 * 1024; kk0 = k0 - 256; }
        float v[8];
#pragma unroll
        for (int e = 0; e < 8; ++e) v[e] = src[(size_t)(kk0 + e) * 1024 + n];
        *(v4u*)((bf16*)(p.ws + WS_WSM) + ((size_t)l * 1024 + n) * 416 + k0) = (v4u){pk2(v[0], v[1]), pk2(v[2], v[3]), pk2(v[4], v[5]), pk2(v[6], v[7])};
    }
    __syncthreads();
    float* sl = L; float* sc = L + 2048; float* red = L + 4096;
    for (int k = tid; k < 2048; k += NTHR) { sl[k] = siluf_(p.in[1][k]); sc[k] = siluf_(p.in[3][k]); }
    __syncthreads();
    for (int it = b; it < 768; it += G) {
        const int l = it / 384, cb = it % 384, col = cb * 32 + (tid & 31), kp = tid >> 5;
        const float* W = p.in[4] + (size_t)l * 2048 * 12288 + col;
        float a0 = 0.f, a1 = 0.f;
#pragma unroll 8
        for (int k = kp * 128; k < kp * 128 + 128; ++k) { const float w = W[(size_t)k * 12288]; a0 += sl[k] * w; a1 += sc[k] * w; }
        red[(kp * 32 + (tid & 31)) * 2] = a0; red[(kp * 32 + (tid & 31)) * 2 + 1] = a1;
        __syncthreads();
        if (tid < 64) { const int cls = tid >> 5, c = tid & 31; float s = p.in[5][l * 12288 + cb * 32 + c];
            for (int q = 0; q < 16; ++q) s += red[(q * 32 + c) * 2 + cls];
            ((float*)(p.ws + WS_MOD))[(l * 2 + cls) * 12288 + cb * 32 + c] = s; }
        __syncthreads();
    }
}

__device__ __forceinline__ void norm_phase(const Params& p, int l, const float* xl, const float* xc, const float* g, int sh_idx, int sc_idx, int nrows) {
    const int tid = otid(), lane = tid & 63, gw = blockIdx.x * 8 + (tid >> 6), ngw = gridDim.x * 8;
    bf16* H = (bf16*)(p.ws + WS_H);
    const float* mod = (const float*)(p.ws + WS_MOD) + (size_t)l * 2 * 12288;
    for (int row = gw; row < nrows; row += ngw) {
        const bool isc = row >= TLAT;
        const float* xr = isc ? xc + (size_t)(row - TLAT) * DM : xl + (size_t)row * DM;
        const float* md = mod + (isc ? 12288 : 0);
        f32x4 v[8]; float ss = 0.f;
#pragma unroll
        for (int j = 0; j < 8; ++j) { v[j] = ((const f32x4*)xr)[lane + 64 * j]; ss += v[j].x * v[j].x + v[j].y * v[j].y + v[j].z * v[j].z + v[j].w * v[j].w; }
        const float rstd = rsqrtf(wave_sum(ss) * (1.f / DM) + 1e-6f);
#pragma unroll
        for (int j = 0; j < 8; ++j) { const int col = 4 * (lane + 64 * j);
            const f32x4 gg = *(const f32x4*)(g + col), s1 = *(const f32x4*)(md + sc_idx * DM + col), s0 = *(const f32x4*)(md + sh_idx * DM + col);
            const f32x4 y = v[j] * rstd * gg * (1.f + s1) + s0;
            v2u o; o.x = pk2(y.x, y.y); o.y = pk2(y.z, y.w);
            *(v2u*)(H + (size_t)row * DM + col) = o; }
    }
}
__device__ __forceinline__ void final_norm(const Params& p) {
    const int tid = otid(), lane = tid & 63, gw = blockIdx.x * 8 + (tid >> 6), ngw = gridDim.x * 8;
    const float* g = p.in[27];
    for (int row = gw; row < TLAT; row += ngw) {
        float* xr = p.out + (size_t)row * DM;
        f32x4 v[8]; float ss = 0.f;
#pragma unroll
        for (int j = 0; j < 8; ++j) { v[j] = ((const f32x4*)xr)[lane + 64 * j]; ss += v[j].x * v[j].x + v[j].y * v[j].y + v[j].z * v[j].z + v[j].w * v[j].w; }
        const float rstd = rsqrtf(wave_sum(ss) * (1.f / DM) + 1e-6f);
#pragma unroll
        for (int j = 0; j < 8; ++j) { const f32x4 gg = ((const f32x4*)g)[lane + 64 * j]; ((f32x4*)xr)[lane + 64 * j] = v[j] * rstd * gg; }
    }
}
typedef __attribute__((address_space(1))) unsigned gu32;
#define XB_TMO      128
#define XB_XCNT(j)  (256  + 64 * (j))
#define XB_XSUB(j)  (1280 + 64 * (j))
#define XB_XGEN(j)  (2304 + 64 * (j))
#define XB_TOP      3328
#define XB_TOPGEN   3392
#define XCD_BAR_WORDS 3456
#define XB_SPIN_CAP (1u << 18)

__device__ __forceinline__ unsigned xb_ld(unsigned* p)              { return __hip_atomic_load(p, __ATOMIC_RELAXED, __HIP_MEMORY_SCOPE_AGENT); }
__device__ __forceinline__ unsigned xb_add(unsigned* p, unsigned v) { return __hip_atomic_fetch_add(p, v, __ATOMIC_RELAXED, __HIP_MEMORY_SCOPE_AGENT); }
__device__ __forceinline__ unsigned xb_xcc_id() { return (unsigned)__builtin_amdgcn_s_getreg((3 << 11) | 20) & 0xFu; }
#define XB_SPIN(cond, bar) do { unsigned _sp = 0; while (cond) { __builtin_amdgcn_s_sleep(1); \
    if ((++_sp & 255u) == 0u) { if (xb_ld(&(bar)[XB_TMO])) break; if (_sp > XB_SPIN_CAP) { atomicAdd(&(bar)[XB_TMO], 1u); break; } } } } while (0)

struct XcdBarrier {
    unsigned* bar; unsigned x;
    volatile LAS unsigned* st;
};

__device__ __forceinline__ XcdBarrier xcd_barrier_post(unsigned* bar, volatile LAS unsigned* st) {
    XcdBarrier b; b.bar = bar; b.x = xb_xcc_id(); b.st = st;
    if (threadIdx.x == 0) (void)xb_add(&bar[XB_XCNT(b.x)], 1u);
    return b;
}
__device__ __forceinline__ void xcd_barrier_complete(unsigned* bar, unsigned x, unsigned& nloc, unsigned& nx) {
    const unsigned G = gridDim.x * gridDim.y * gridDim.z;
    unsigned sum, cnt, mine, sp = 0u;
    for (;;) {
        sum = 0u; cnt = 0u; mine = 0u;
#pragma unroll
        for (unsigned j = 0; j < 16; ++j) { const unsigned c = xb_ld(&bar[XB_XCNT(j)]); sum += c; cnt += (c > 0u) ? 1u : 0u; mine = (j == x) ? c : mine; }
        if (sum == G) break;
        __builtin_amdgcn_s_sleep(1);
        if ((++sp & 255u) == 0u) { if (xb_ld(&bar[XB_TMO])) break; if (sp > XB_SPIN_CAP) { atomicAdd(&bar[XB_TMO], 1u); break; } }
    }
    nloc = mine > 0u ? mine : 1u; nx = cnt > 0u ? cnt : 1u;
}

__device__ __forceinline__ void xcd_barrier(const XcdBarrier& b) {
    asm volatile("s_waitcnt vmcnt(0)" ::: "memory");
    __syncthreads();
    if (threadIdx.x == 0) {
        unsigned* bar = b.bar;
        __builtin_amdgcn_s_waitcnt(0);
        unsigned nloc = b.st[0], nx = b.st[1];
        if (nloc == 0u) { xcd_barrier_complete(bar, b.x, nloc, nx); b.st[0] = nloc; b.st[1] = nx; }
        const unsigned old = xb_add(&bar[XB_XSUB(b.x)], 1u);
        const unsigned gen = old / nloc;
        if (old + 1u == (gen + 1u) * nloc) {
            __builtin_amdgcn_fence(__ATOMIC_RELEASE, "agent");
            asm volatile("s_waitcnt vmcnt(0)" ::: "memory");
            const unsigned og = xb_add(&bar[XB_TOP], 1u);
            const unsigned tg = og / nx;
            if (og + 1u == (tg + 1u) * nx) xb_add(&bar[XB_TOPGEN], 1u);
            else XB_SPIN(xb_ld(&bar[XB_TOPGEN]) == tg, bar);
            __builtin_amdgcn_fence(__ATOMIC_ACQUIRE, "agent");
            xb_add(&bar[XB_XGEN(b.x)], 1u);
            asm volatile("s_waitcnt vmcnt(0)" ::: "memory");
        } else {
            XB_SPIN(xb_ld(&bar[XB_XGEN(b.x)]) == gen, bar);
            __builtin_amdgcn_fence(__ATOMIC_ACQUIRE, "agent");
            asm volatile("s_waitcnt vmcnt(0)" ::: "memory");
        }
    }
    __syncthreads();
}

__device__ __forceinline__ void gdn_prep_item(const Params& p, int l, int item, float* L) {
    const int tid = otid(), lane = tid & 63, wave = tid >> 6;
    const int h = item & 7, ch = item >> 3;
    const bool isctx = ch >= 128;
    const int seg0 = isctx ? TLAT : 0, seglen = isctx ? TCTX : TLAT, t0 = isctx ? (ch - 128) * 64 : ch * 64;
    const float* P = (const float*)(p.ws + WS_P);
    const float* cw = p.in[9] + (size_t)l * 3 * 3072;
    float* qs = L; float* ks = L + 8448; float* KKm = L + 16896; float* QKm = L + 21056; float* TI = L + 25216;
    float* Gs = L + 33920; float* BETA = Gs + 128; float* EG = Gs + 256; float* GL = Gs + 384;
    bf16* const gd0 = (bf16*)(p.ws + WS_GDN) + ((size_t)h * 132 + (isctx ? (ch - 128) : 4 + ch)) * 36864;
    bf16* const gd1 = (bf16*)(p.ws + WS_GDN) + ((size_t)(8 + h) * 132 + (isctx ? 3 - (ch - 128) : 4 + 127 - ch)) * 36864;
#define GDP(d) ((d) ? gd1 : gd0)
    {
        const int i = tid >> 3, c0 = (tid & 7) * 16, tk = t0 + i;
        const size_t prow = (size_t)(seg0 + tk) * PINP;
#pragma unroll
        for (int which = 0; which < 2; ++which) {
            const int col = which * 1024 + h * 128 + c0;
            f32x4 y[4]; float ss = 0.f;
#pragma unroll
            for (int jj = 0; jj < 4; ++jj) {
                const f32x4 x0 = *(const f32x4*)(P + prow + col + 4 * jj);
                f32x4 xm = {0.f, 0.f, 0.f, 0.f}, xp = {0.f, 0.f, 0.f, 0.f};
                if (tk > 0) xm = *(const f32x4*)(P + prow - PINP + col + 4 * jj);
                if (tk < seglen - 1) xp = *(const f32x4*)(P + prow + PINP + col + 4 * jj);
                const f32x4 w0 = *(const f32x4*)(cw + col + 4 * jj), w1 = *(const f32x4*)(cw + 3072 + col + 4 * jj), w2 = *(const f32x4*)(cw + 6144 + col + 4 * jj);
                f32x4 t = xm * w0 + x0 * w1 + xp * w2;
                t.x = siluf_(t.x); t.y = siluf_(t.y); t.z = siluf_(t.z); t.w = siluf_(t.w);
                y[jj] = t; ss += t.x * t.x + t.y * t.y + t.z * t.z + t.w * t.w;
            }
            ss += __shfl_xor(ss, 1); ss += __shfl_xor(ss, 2); ss += __shfl_xor(ss, 4);
            const float sc = rsqrtf(ss + 1e-6f) * (which == 0 ? 0.08838834764831845f : 1.f);
            float* dst = (which ? ks : qs) + i * 132 + c0;
#pragma unroll
            for (int jj = 0; jj < 4; ++jj) *(f32x4*)(dst + 4 * jj) = y[jj] * sc;
        }
        {
            const int col = 3072 + h * 128 + c0; unsigned o[8];
#pragma unroll
            for (int jj = 0; jj < 4; ++jj) { const f32x4 z = *(const f32x4*)(P + prow + col + 4 * jj);
                o[2 * jj] = pk2(siluf_(z.x), siluf_(z.y)); o[2 * jj + 1] = pk2(siluf_(z.z), siluf_(z.w)); }
            bf16* sz = (bf16*)(p.ws + WS_SZ) + (size_t)(seg0 + tk) * 1024 + h * 128 + c0;
            *(v4u*)sz = (v4u){o[0], o[1], o[2], o[3]}; *(v4u*)(sz + 8) = (v4u){o[4], o[5], o[6], o[7]};
        }
    }
    if (tid < 128) {
        const int d = tid >> 6, ip = tid & 63, i = d ? 63 - ip : ip;
        const size_t prow = (size_t)(seg0 + t0 + i) * PINP;
        const float bb = P[prow + 4096 + d * 8 + h], al = P[prow + 4112 + d * 8 + h];
        const float A = expf(p.in[10][l * 16 + d * 8 + h]);
        float g = -A * softplusf_(al + p.in[11][l * 16 + d * 8 + h]);
#pragma unroll
        for (int o = 1; o < 64; o <<= 1) { const float t = __shfl_up(g, o); if (ip >= o) g += t; }
        Gs[d * 64 + ip] = g; BETA[d * 64 + ip] = sigmoidf_(bb); EG[d * 64 + ip] = expf(g);
        if (ip == 63) { GL[d] = g;
            const int np = isctx ? (d ? 3 - (ch - 128) : (ch - 128)) : (d ? 4 + 127 - ch : 4 + ch);
            ((float*)(p.ws + WS_DL))[(d * 8 + h) * 132 + np] = expf(g); }
    }
    __syncthreads();
    {
        const int ia = tid >> 4, jb = tid & 15;
        float akk[2][4], aqk[2][4];
#pragma unroll
        for (int a = 0; a < 2; ++a)
#pragma unroll
            for (int bq = 0; bq < 4; ++bq) { akk[a][bq] = 0.f; aqk[a][bq] = 0.f; }
        for (int c = 0; c < 128; c += 4) {
            f32x4 ki[2], qi[2], kj[4];
#pragma unroll
            for (int a = 0; a < 2; ++a) { ki[a] = *(const f32x4*)(ks + (ia + 32 * a) * 132 + c); qi[a] = *(const f32x4*)(qs + (ia + 32 * a) * 132 + c); }
#pragma unroll
            for (int bq = 0; bq < 4; ++bq) kj[bq] = *(const f32x4*)(ks + (jb + 16 * bq) * 132 + c);
#pragma unroll
            for (int a = 0; a < 2; ++a)
#pragma unroll
                for (int bq = 0; bq < 4; ++bq) {
                    akk[a][bq] += ki[a].x * kj[bq].x + ki[a].y * kj[bq].y + ki[a].z * kj[bq].z + ki[a].w * kj[bq].w;
                    aqk[a][bq] += qi[a].x * kj[bq].x + qi[a].y * kj[bq].y + qi[a].z * kj[bq].z + qi[a].w * kj[bq].w; }
        }
#pragma unroll
        for (int a = 0; a < 2; ++a)
#pragma unroll
            for (int bq = 0; bq < 4; ++bq) { KKm[(ia + 32 * a) * 65 + jb + 16 * bq] = akk[a][bq]; QKm[(ia + 32 * a) * 65 + jb + 16 * bq] = aqk[a][bq]; }
    }
    __syncthreads();
#pragma unroll 4
    for (int e = 0; e < 16; ++e) { const int idx = tid + 512 * e, d = idx >> 12, ip = (idx >> 6) & 63, jp = idx & 63;
        const int ri = d ? 63 - ip : ip, rj = d ? 63 - jp : jp;
        float v = 0.f;
        if (jp < ip) v = BETA[d * 64 + ip] * KKm[ri * 65 + rj] * expf(Gs[d * 64 + ip] - Gs[d * 64 + jp]);
        TI[d * 4352 + ip * 68 + jp] = v; }
    __syncthreads();
    if (wave < 2) {
        const int d = wave; float X[64];
        const float* Lb = TI + d * 4352;
#pragma unroll
        for (int i = 0; i < 64; ++i) {
            float acc = (i == lane) ? 1.f : 0.f;
#pragma unroll
            for (int j4 = 0; j4 < i; j4 += 4) {
                const f32x4 lv = *(const f32x4*)(Lb + i * 68 + j4);
                acc -= lv.x * X[j4];
                if (j4 + 1 < i) acc -= lv.y * X[j4 + 1];
                if (j4 + 2 < i) acc -= lv.z * X[j4 + 2];
                if (j4 + 3 < i) acc -= lv.w * X[j4 + 3];
            }
            X[i] = acc;
        }
        LDS_WAIT();
#pragma unroll
        for (int i = 0; i < 64; ++i) TI[d * 4352 + i * 68 + lane] = X[i];
    } else {
        const int t2 = tid - 128;
        for (int idx = t2; idx < 2048; idx += 384) {
            const int d = idx >> 10, ip = (idx >> 4) & 63, c8 = idx & 15, ri = d ? 63 - ip : ip; const float e = EG[d * 64 + ip];
            const f32x4 a = *(const f32x4*)(qs + ri * 132 + c8 * 8), bq = *(const f32x4*)(qs + ri * 132 + c8 * 8 + 4);
            *(v4u*)(GDP(d) + 8192 + ip * 128 + c8 * 8) = (v4u){pk2(a.x * e, a.y * e), pk2(a.z * e, a.w * e), pk2(bq.x * e, bq.y * e), pk2(bq.z * e, bq.w * e)};
        }
        for (int idx = t2; idx < 2048; idx += 384) {
            const int d = idx >> 10, c = (idx >> 3) & 127, i8 = idx & 7; const float gl = GL[d]; float v[8];
#pragma unroll
            for (int e = 0; e < 8; ++e) { const int ip = i8 * 8 + e, ri = d ? 63 - ip : ip; v[e] = ks[ri * 132 + c] * expf(gl - Gs[d * 64 + ip]); }
            *(v4u*)(GDP(d) + 16384 + c * 64 + i8 * 8) = (v4u){pk2(v[0], v[1]), pk2(v[2], v[3]), pk2(v[4], v[5]), pk2(v[6], v[7])};
        }
        for (int idx = t2; idx < 1024; idx += 384) {
            const int d = idx >> 9, ip = (idx >> 3) & 63, j8 = idx & 7, ri = d ? 63 - ip : ip; const float gi = Gs[d * 64 + ip]; float v[8];
#pragma unroll
            for (int e = 0; e < 8; ++e) { const int jp = j8 * 8 + e, rj = d ? 63 - jp : jp; v[e] = (jp <= ip) ? QKm[ri * 65 + rj] * expf(gi - Gs[d * 64 + jp]) : 0.f; }
            *(v4u*)(GDP(d) + 24576 + ip * 64 + j8 * 8) = (v4u){pk2(v[0], v[1]), pk2(v[2], v[3]), pk2(v[4], v[5]), pk2(v[6], v[7])};
        }
    }
    __syncthreads();
    {
        const int i = tid >> 3, c0 = (tid & 7) * 16, tk = t0 + i; const size_t prow = (size_t)(seg0 + tk) * PINP; const int col = 2048 + h * 128 + c0;
#pragma unroll
        for (int jj = 0; jj < 4; ++jj) {
            const f32x4 x0 = *(const f32x4*)(P + prow + col + 4 * jj);
            f32x4 xm = {0.f, 0.f, 0.f, 0.f}, xp = {0.f, 0.f, 0.f, 0.f};
            if (tk > 0) xm = *(const f32x4*)(P + prow - PINP + col + 4 * jj);
            if (tk < seglen - 1) xp = *(const f32x4*)(P + prow + PINP + col + 4 * jj);
            const f32x4 w0 = *(const f32x4*)(cw + col + 4 * jj), w1 = *(const f32x4*)(cw + 3072 + col + 4 * jj), w2 = *(const f32x4*)(cw + 6144 + col + 4 * jj);
            f32x4 t = xm * w0 + x0 * w1 + xp * w2;
            t.x = siluf_(t.x); t.y = siluf_(t.y); t.z = siluf_(t.z); t.w = siluf_(t.w);
            *(f32x4*)(qs + i * 132 + c0 + 4 * jj) = t;
        }
    }
    const int d5 = tid >> 8, tt = tid & 255, ig = tt >> 4, cg = tt & 15, jmax = ig * 4 + 3;
#pragma unroll
    for (int pass = 0; pass < 2; ++pass) {
        if (pass == 1) __syncthreads();
        const float* src = pass ? qs : ks;
        f32x4 acc[4][2];
#pragma unroll
        for (int ii = 0; ii < 4; ++ii) { acc[ii][0] = (f32x4){0.f, 0.f, 0.f, 0.f}; acc[ii][1] = (f32x4){0.f, 0.f, 0.f, 0.f}; }
        for (int j = 0; j <= jmax; ++j) {
            const int rj = d5 ? 63 - j : j;
            const float cf = pass ? BETA[d5 * 64 + j] : BETA[d5 * 64 + j] * EG[d5 * 64 + j];
            const f32x4 k0 = *(const f32x4*)(src + rj * 132 + cg * 4), k1 = *(const f32x4*)(src + rj * 132 + 64 + cg * 4);
#pragma unroll
            for (int ii = 0; ii < 4; ++ii) { const float t = TI[d5 * 4352 + (ig * 4 + ii) * 68 + j] * cf; acc[ii][0] += t * k0; acc[ii][1] += t * k1; }
        }
        bf16* dst = GDP(d5) + (pass ? 28672 : 0);
#pragma unroll
        for (int ii = 0; ii < 4; ++ii) {
            *(v2u*)(dst + (ig * 4 + ii) * 128 + cg * 4) = (v2u){pk2(acc[ii][0].x, acc[ii][0].y), pk2(acc[ii][0].z, acc[ii][0].w)};
            *(v2u*)(dst + (ig * 4 + ii) * 128 + 64 + cg * 4) = (v2u){pk2(acc[ii][1].x, acc[ii][1].y), pk2(acc[ii][1].z, acc[ii][1].w)};
        }
    }
    __syncthreads();
}

__device__ __forceinline__ void rw_tok(int sf, int& prow, int& up, int& dn) {
    if (sf < TCTX) { prow = TLAT + sf; up = sf > 0 ? prow - 1 : -1; dn = sf < TCTX - 1 ? prow + 1 : -1; }
    else { const int j = sf - TCTX, r = j & 127, cc = j >> 7; prow = r * 64 + cc; up = r > 0 ? prow - 64 : -1; dn = r < 127 ? prow + 64 : -1; }
}
__device__ __forceinline__ float rw_shift(const float* P, const float* mu, int prow, int up, int dn, int col) {
    const float x = P[(size_t)prow * PINP + 4128 + col];
    const float u = up >= 0 ? P[(size_t)up * PINP + 4128 + col] : 0.f;
    const float dv = dn >= 0 ? P[(size_t)dn * PINP + 4128 + col] : 0.f;
    return x + mu[col] * (0.5f * (u + dv) - x);
}
__device__ __forceinline__ float fexp(float x) { return __expf(x); }
__device__ __forceinline__ float fsig(float x) { return __frcp_rn(1.f + __expf(-x)); }
__device__ __forceinline__ void rwkv_prep_item(const Params& p, int l, int item, float* L) {
    const int tid = otid(), lane = tid & 63, wave = tid >> 6, r = lane & 15, q = lane >> 4;
    const float* P = (const float*)(p.ws + WS_P);
    const float* mu = p.in[13] + (size_t)l * 3488;
    bf16* actb = (bf16*)L;
    int* tinfo = (int*)(L + 3392);
    const int sf0 = item * 16;
    if (tid < 16) { int prow, up, dn; rw_tok(sf0 + tid, prow, up, dn); tinfo[tid * 4] = prow; tinfo[tid * 4 + 1] = up; tinfo[tid * 4 + 2] = dn; }
    __syncthreads();
#pragma unroll
    for (int i = 0; i < 13; ++i) { const int e = tid + 512 * i, t = e / 416, cc = e - t * 416;
        const int prow = tinfo[t * 4], up = tinfo[t * 4 + 1], dn = tinfo[t * 4 + 2];
        float v = rw_shift(P, mu, prow, up, dn, 3072 + cc);
        if (cc < 128) v = 1.f - 2.f * __frcp_rn(__expf(2.f * v) + 1.f); else if (cc >= 256) v = fsig(v);
        actb[t * 424 + cc] = (bf16)f2bf(v); }
    __syncthreads();
    const int prow = tinfo[r * 4], up = tinfo[r * 4 + 1], dn = tinfo[r * 4 + 2], sf = sf0 + r;
    const int s1 = sf < TCTX ? TCTX - 1 - sf : 8703 - sf;
    const float mup = up >= 0 ? 0.5f : 0.f, mdn = dn >= 0 ? 0.5f : 0.f;
    const float* Pr = P + (size_t)prow * PINP + 4128; const float* Pu = P + (size_t)(up >= 0 ? up : prow) * PINP + 4128; const float* Pd = P + (size_t)(dn >= 0 ? dn : prow) * PINP + 4128;
    const bf16* Wsm = (const bf16*)(p.ws + WS_WSM) + (size_t)l * 1024 * 416;
    const float* w0p = p.in[14] + (size_t)l * 2048; const float* a0p = p.in[16] + (size_t)l * 2048;
    const float* k_k = p.in[19] + (size_t)l * 1024; const float* k_a = p.in[20] + (size_t)l * 1024; const float* r_k = p.in[21] + (size_t)l * 1024;
#pragma unroll 1
    for (int hi = 0; hi < 2; ++hi) {
        const int hh = wave * 2 + hi;
        f32x4 acc[4][5];
#pragma unroll
        for (int ct = 0; ct < 4; ++ct)
#pragma unroll
            for (int m = 0; m < 5; ++m) acc[ct][m] = (f32x4){0.f, 0.f, 0.f, 0.f};
#pragma unroll
        for (int kk = 0; kk < 13; ++kk) {
            const bf16x8 bfr = *(const bf16x8*)(actb + r * 424 + kk * 32 + 8 * q);
            constexpr int MAT[13] = {0, 0, 1, 1, 2, 2, 3, 3, 4, 4, 4, 4, 4};
#pragma unroll
            for (int ct = 0; ct < 4; ++ct) {
                const bf16x8 afr = *(const bf16x8*)(Wsm + (size_t)(hh * 64 + ct * 16 + r) * 416 + kk * 32 + 8 * q);
                acc[ct][MAT[kk]] = __builtin_amdgcn_mfma_f32_16x16x32_bf16(afr, bfr, acc[ct][MAT[kk]], 0, 0, 0);
            }
            if (kk & 1) asm volatile("" ::: "memory");
        }
        f32x4 kv[4], rv[4], vv[4]; float ss = 0.f;
#pragma unroll
        for (int ct = 0; ct < 4; ++ct) { const int c = hh * 64 + ct * 16 + 4 * q;
#pragma unroll
            for (int ten = 0; ten < 3; ++ten) { const int cc = ten * 1024 + c;
                const f32x4 x = *(const f32x4*)(Pr + cc), u = *(const f32x4*)(Pu + cc), dv = *(const f32x4*)(Pd + cc), m = *(const f32x4*)(mu + cc);
                const f32x4 y = x + m * (u * mup + dv * mdn - x);
                if (ten == 0) rv[ct] = y; else if (ten == 1) kv[ct] = y; else vv[ct] = y; }
            const f32x4 kkr = kv[ct] * *(const f32x4*)(k_k + c);
            ss += kkr.x * kkr.x + kkr.y * kkr.y + kkr.z * kkr.z + kkr.w * kkr.w;
            asm volatile("" ::: "memory"); }
        ss += __shfl_xor(ss, 16); ss += __shfl_xor(ss, 32);
        const float rn = rsqrtf(ss + 1e-6f);
        unsigned char* rd0 = p.ws + WS_RWD + ((size_t)hh * TTOK + sf) * 512; unsigned char* rd1 = p.ws + WS_RWD + ((size_t)(16 + hh) * TTOK + s1) * 512;
        unsigned char* rs = p.ws + WS_RWS + ((size_t)hh * TTOK + sf) * 384;
        bf16* gt = (bf16*)(p.ws + WS_GATE) + (size_t)prow * 1024;
        float bon = 0.f;
#pragma unroll
        for (int ct = 0; ct < 4; ++ct) { const int c = hh * 64 + ct * 16 + 4 * q, co = ct * 16 + 4 * q;
            const f32x4 kkv = kv[ct] * *(const f32x4*)(k_k + c) * rn, ka = *(const f32x4*)(k_a + c), rk = *(const f32x4*)(r_k + c);
            f32x4 ksum = {0.f, 0.f, 0.f, 0.f};
#pragma unroll
            for (int d = 0; d < 2; ++d) {
                const f32x4 xw = *(const f32x4*)(w0p + d * 1024 + c) + acc[ct][d], xa = *(const f32x4*)(a0p + d * 1024 + c) + acc[ct][2 + d];
                f32x4 dec, kd, nk;
#pragma unroll
                for (int j = 0; j < 4; ++j) { const float y = -xw[j]; const float sp = y > 20.f ? y : __logf(1.f + __expf(y));
                    dec[j] = __expf(-__expf(-sp - 0.5f));
                    const float a = fsig(xa[j]); kd[j] = kv[ct][j] * (1.f + (a - 1.f) * ka[j]); nk[j] = -(kkv[j] * a); }
                ksum += kd;
                unsigned char* rd = d ? rd1 : rd0;
                *(f32x4*)(rd + co * 4) = dec;
                *(v2u*)(rd + 256 + co * 2) = (v2u){pk2(kd.x, kd.y), pk2(kd.z, kd.w)};
                *(v2u*)(rd + 384 + co * 2) = (v2u){pk2(nk.x, nk.y), pk2(nk.z, nk.w)};
            }
            const f32x4 bt = rv[ct] * ksum * rk; bon += (bt.x + bt.y) + (bt.z + bt.w);
            *(v2u*)(rs + co * 2) = (v2u){pk2(rv[ct].x, rv[ct].y), pk2(rv[ct].z, rv[ct].w)};
            *(v2u*)(rs + 128 + co * 2) = (v2u){pk2(kkv.x, kkv.y), pk2(kkv.z, kkv.w)};
            *(v2u*)(rs + 256 + co * 2) = (v2u){pk2(vv[ct].x, vv[ct].y), pk2(vv[ct].z, vv[ct].w)};
            *(v2u*)(gt + c) = (v2u){pk2(acc[ct][4].x, acc[ct][4].y), pk2(acc[ct][4].z, acc[ct][4].w)};
            asm volatile("" ::: "memory");
        }
        bon += __shfl_xor(bon, 16); bon += __shfl_xor(bon, 32);
        if (q == 0) ((float*)(p.ws + WS_BONUS))[prow * 16 + hh] = bon;
    }
    __syncthreads();
}
#define LDS_BARRIER() do { asm volatile("s_waitcnt lgkmcnt(0)" ::: "memory"); __builtin_amdgcn_s_barrier(); asm volatile("" ::: "memory"); } while (0)
__device__ __forceinline__ f32x4 mfma16(bf16x8 a, bf16x8 b, f32x4 c) { return __builtin_amdgcn_mfma_f32_16x16x32_bf16(a, b, c, 0, 0, 0); }
__device__ __forceinline__ void gdn_scan(const Params& p, int b, unsigned char* lds) {
    const int tid = otid(), lane = tid & 63, wave = tid >> 6, r = lane & 15, q = lane >> 4;
    const int s = b & 3, h = (b >> 2) & 7, d = b >> 5;
    bf16* Wb = (bf16*)lds; bf16* Qb = Wb + 2 * 8704; bf16* KTb = Qb + 2 * 8704; bf16* Ab = KTb + 2 * 9216; bf16* Ub = Ab + 2 * 4608; bf16* ST = Ub + 2 * 2560; bf16* VT = ST + 4352;
    const bf16* G = (const bf16*)(p.ws + WS_GDN) + (size_t)((d * 8 + h) * 132) * 36864;
    const float* DLp = (const float*)(p.ws + WS_DL) + (d * 8 + h) * 132;
    float* O = (float*)(p.ws + WS_P) + (size_t)d * TTOK * 1024 + h * 128 + s * 32;
    for (int e = tid; e < 4352; e += NTHR) ST[e] = 0;
    f32x4 S0 = {0.f, 0.f, 0.f, 0.f}, S1 = {0.f, 0.f, 0.f, 0.f};
    v4u pw0, pw1, pq0, pq1, pk0, pk1, pa, pu;
    pu = (v4u){0u, 0u, 0u, 0u};
#define GDN_LOAD(n) do { const bf16* g_ = G + (size_t)(n) * 36864; \
        pw0 = *(const v4u*)(g_ + tid * 8); pw1 = *(const v4u*)(g_ + (tid + 512) * 8); \
        pq0 = *(const v4u*)(g_ + 8192 + tid * 8); pq1 = *(const v4u*)(g_ + 8192 + (tid + 512) * 8); \
        pk0 = *(const v4u*)(g_ + 16384 + tid * 8); pk1 = *(const v4u*)(g_ + 16384 + (tid + 512) * 8); \
        pa = *(const v4u*)(g_ + 24576 + tid * 8); \
        if (tid < 256) pu = *(const v4u*)(g_ + 28672 + (tid >> 2) * 128 + s * 32 + (tid & 3) * 8); } while (0)
#define GDN_STORE(bf) do { \
        *(v4u*)(Wb + (bf) * 8704 + (tid >> 4) * 136 + (tid & 15) * 8) = pw0; *(v4u*)(Wb + (bf) * 8704 + ((tid + 512) >> 4) * 136 + (tid & 15) * 8) = pw1; \
        *(v4u*)(Qb + (bf) * 8704 + (tid >> 4) * 136 + (tid & 15) * 8) = pq0; *(v4u*)(Qb + (bf) * 8704 + ((tid + 512) >> 4) * 136 + (tid & 15) * 8) = pq1; \
        *(v4u*)(KTb + (bf) * 9216 + (tid >> 3) * 72 + (tid & 7) * 8) = pk0; *(v4u*)(KTb + (bf) * 9216 + ((tid + 512) >> 3) * 72 + (tid & 7) * 8) = pk1; \
        *(v4u*)(Ab + (bf) * 4608 + (tid >> 3) * 72 + (tid & 7) * 8) = pa; \
        if (tid < 256) *(v4u*)(Ub + (bf) * 2560 + (tid >> 2) * 40 + (tid & 3) * 8) = pu; } while (0)
    GDN_LOAD(0); GDN_STORE(0);
    __syncthreads();
    const int mi = wave >> 1, nv = wave & 1;
    for (int n = 0; n < 132; ++n) {
        const int bf = n & 1;
        if (n + 1 < 132) GDN_LOAD(n + 1);
        const float dl = DLp[n];
        f32x4 co = {0.f, 0.f, 0.f, 0.f}, cv = {0.f, 0.f, 0.f, 0.f};
#pragma unroll
        for (int kk = 0; kk < 4; ++kk) {
            const bf16x8 sa = *(const bf16x8*)(ST + (16 * nv + r) * 136 + kk * 32 + 8 * q);
            const bf16x8 qa = *(const bf16x8*)(Qb + bf * 8704 + (16 * mi + r) * 136 + kk * 32 + 8 * q);
            const bf16x8 wb = *(const bf16x8*)(Wb + bf * 8704 + (16 * mi + r) * 136 + kk * 32 + 8 * q);
            co = mfma16(qa, sa, co);
            cv = mfma16(sa, wb, cv);
        }
        {
            const v2u uu = *(const v2u*)(Ub + bf * 2560 + (16 * mi + r) * 40 + 16 * nv + 4 * q);
            const float v0 = bflo(uu.x) - cv.x, v1 = bfhi(uu.x) - cv.y, v2 = bflo(uu.y) - cv.z, v3 = bfhi(uu.y) - cv.w;
            bf16* vt = VT + (16 * nv + 4 * q) * 72 + 16 * mi + r;
            vt[0] = (bf16)f2bf(v0); vt[72] = (bf16)f2bf(v1); vt[144] = (bf16)f2bf(v2); vt[216] = (bf16)f2bf(v3);
        }
        LDS_BARRIER();
#pragma unroll
        for (int kk = 0; kk < 2; ++kk) {
            const bf16x8 aa = *(const bf16x8*)(Ab + bf * 4608 + (16 * mi + r) * 72 + kk * 32 + 8 * q);
            const bf16x8 vb = *(const bf16x8*)(VT + (16 * nv + r) * 72 + kk * 32 + 8 * q);
            co = mfma16(aa, vb, co);
        }
        {
            const bool cx = n < 4;
#pragma unroll
            for (int j = 0; j < 4; ++j) { const int ip = 16 * mi + 4 * q + j;
                const int tok = d == 0 ? (cx ? TLAT + n * 64 + ip : (n - 4) * 64 + ip) : (cx ? TLAT + (3 - n) * 64 + 63 - ip : (131 - n) * 64 + 63 - ip);
                O[(size_t)tok * 1024 + 16 * nv + r] = co[j]; }
        }
#pragma unroll
        for (int e = 0; e < 2; ++e) {
            f32x4 Sv = (e ? S1 : S0) * dl; const int nk = 2 * mi + e;
#pragma unroll
            for (int kk = 0; kk < 2; ++kk) {
                const bf16x8 va = *(const bf16x8*)(VT + (16 * nv + r) * 72 + kk * 32 + 8 * q);
                const bf16x8 kb = *(const bf16x8*)(KTb + bf * 9216 + (16 * nk + r) * 72 + kk * 32 + 8 * q);
                Sv = mfma16(va, kb, Sv);
            }
            if (e) S1 = Sv; else S0 = Sv;
            bf16* st = ST + (16 * nv + 4 * q) * 136 + 16 * nk + r;
            st[0] = (bf16)f2bf(Sv.x); st[136] = (bf16)f2bf(Sv.y); st[272] = (bf16)f2bf(Sv.z); st[408] = (bf16)f2bf(Sv.w);
        }
        if (n + 1 < 132) GDN_STORE(bf ^ 1);
        LDS_BARRIER();
    }
}
__device__ __forceinline__ float red16(float x) {
    x += __builtin_bit_cast(float, __builtin_amdgcn_update_dpp(0, __builtin_bit_cast(int, x), 0x128, 0xf, 0xf, false));
    x += __builtin_bit_cast(float, __builtin_amdgcn_update_dpp(0, __builtin_bit_cast(int, x), 0x124, 0xf, 0xf, false));
    x += __builtin_bit_cast(float, __builtin_amdgcn_update_dpp(0, __builtin_bit_cast(int, x), 0x122, 0xf, 0xf, false));
    x += __builtin_bit_cast(float, __builtin_amdgcn_update_dpp(0, __builtin_bit_cast(int, x), 0x121, 0xf, 0xf, false));
    return x;
}
__device__ __forceinline__ void rwkv_compute_chunk(const float* buf, float* opb, int rl, int kg, f32x4& S) {
    constexpr int TB = 32, SF = 336;
    const float* sp = buf + 4 * kg; const float* vp = buf + 320 + rl; float* op = opb + rl * 16 + kg;
    f32x4 w = *(const f32x4*)sp, kd = *(const f32x4*)(sp + 64), nk = *(const f32x4*)(sp + 128), rr = *(const f32x4*)(sp + 192), kk = *(const f32x4*)(sp + 256);
    float v = vp[0];
#pragma unroll 4
    for (int st = 0; st < TB; ++st) {
        const int sn = st < TB - 1 ? st + 1 : st;
        const f32x4 w_n = *(const f32x4*)(sp + sn * SF), kd_n = *(const f32x4*)(sp + sn * SF + 64), nk_n = *(const f32x4*)(sp + sn * SF + 128),
                    rr_n = *(const f32x4*)(sp + sn * SF + 192), kk_n = *(const f32x4*)(sp + sn * SF + 256);
        const float v_n = vp[sn * SF];
        f32x2 d2 = (f32x2){S.x, S.y} * (f32x2){kk.x, kk.y};
        d2 = (f32x2){S.z, S.w} * (f32x2){kk.z, kk.w} + d2;
        const float dot = red16(d2.x + d2.y);
        S = S * w + v * kd + dot * nk;
        f32x2 o2 = (f32x2){S.x, S.y} * (f32x2){rr.x, rr.y};
        o2 = (f32x2){S.z, S.w} * (f32x2){rr.z, rr.w} + o2;
        op[st * 256] = o2.x + o2.y;
        w = w_n; kd = kd_n; nk = nk_n; rr = rr_n; kk = kk_n; v = v_n;
    }
}
__device__ __forceinline__ void rwkv_scan(const Params& p, int b, float* L) {
    const int tid = otid(), lane = tid & 63, wave = tid >> 6;
    const int pair = b >> 2, qt = b & 3, d = pair >> 4, h = pair & 15;
    const unsigned char* RD = p.ws + WS_RWD + (size_t)(d * 16 + h) * TTOK * 512;
    const unsigned char* RS = p.ws + WS_RWS + (size_t)h * TTOK * 384;
    float* O = (float*)(p.ws + WS_P) + (size_t)(2 + d) * TTOK * 1024 + h * 64 + qt * 16;
    constexpr int TB = 32, SF = 336, NCH = TTOK / TB;
    float* OP = L + 2 * TB * SF;
    const int rl = (wave & 3) * 4 + (lane >> 4), kg = lane & 15;
    const int lt = tid - 256;
    float* const dummy = L + 2 * TB * SF + 2 * TB * 256;
    int so[7], dofA[7], dofB[7]; bool isd[7];
#pragma unroll
    for (int i = 0; i < 7; ++i) { const int u = lt + 256 * i, st = u / 50, x = u % 50, sg = d ? -st : st; const bool valid = u < TB * 50;
        so[i] = !valid ? 0 : (x < 32 ? st * 512 + x * 16 : (x < 48 ? sg * 384 + (x - 32) * 16 : sg * 384 + 256 + qt * 32 + (x - 48) * 16));
        isd[i] = !valid || x < 32;
        const int base = st * SF + (x < 16 ? x * 4 : (x < 32 ? 64 + (x - 16) * 8 : (x < 48 ? 192 + (x - 32) * 8 : 320 + (x - 48) * 8)));
        dofA[i] = valid ? base : -1;
        dofB[i] = (valid && x >= 16) ? base + 4 : -1; }
    v4u ldA[7], ldB[7];
#define RW_LOADSET(ld, cc_) do { const int c_ = (cc_) < NCH ? (cc_) : NCH - 1; const unsigned char* rdb = RD + (size_t)c_ * (TB * 512); \
        const int sfb = d == 0 ? c_ * TB : (c_ < 8 ? TCTX - 1 - c_ * TB : 8703 - c_ * TB); const unsigned char* rsb = RS + (size_t)sfb * 384; \
        _Pragma("unroll") for (int i = 0; i < 7; ++i) ld[i] = *(const v4u*)((isd[i] ? rdb : rsb) + so[i]); } while (0)
#define RW_STORESET(ld, cc_) do { const bool live = (cc_) < NCH; float* buf = L + ((cc_) & 1) * (TB * SF); \
        _Pragma("unroll") for (int i = 0; i < 7; ++i) { const v4u v = ld[i]; const bool f32u = dofB[i] < 0; \
            float* d0 = (live && dofA[i] >= 0) ? buf + dofA[i] : dummy; float* d1 = (live && dofB[i] >= 0) ? buf + dofB[i] : dummy; \
            const f32x4 lo = {bflo(v.x), bfhi(v.x), bflo(v.y), bfhi(v.y)}, hi = {bflo(v.z), bfhi(v.z), bflo(v.w), bfhi(v.w)}; \
            *(f32x4*)d0 = f32u ? __builtin_bit_cast(f32x4, v) : lo; *(f32x4*)d1 = hi; } } while (0)
#define RW_ITER(c, LSET, SSET) do { \
        if (wave >= 4) { \
            RW_LOADSET(LSET, (c) + 2); \
            {     \
                const int cm = (c) >= 1 ? (c) - 1 : 0; const float* op = OP + (cm & 1) * (TB * 256); \
                const int st = lt >> 3, r2 = (lt & 7) * 2, s = cm * TB + st; float o[2]; \
                _Pragma("unroll") for (int e = 0; e < 2; ++e) { const float* q = op + st * 256 + (r2 + e) * 16; \
                    const f32x4 a = *(const f32x4*)q, bq = *(const f32x4*)(q + 4), cq = *(const f32x4*)(q + 8), dq = *(const f32x4*)(q + 12); \
                    o[e] = ((a.x + a.y) + (a.z + a.w)) + ((bq.x + bq.y) + (bq.z + bq.w)) + ((cq.x + cq.y) + (cq.z + cq.w)) + ((dq.x + dq.y) + (dq.z + dq.w)); } \
                const int j = s < TCTX ? 0 : (d ? 8447 - s : s - TCTX); \
                const int tok = s < TCTX ? TLAT + (d ? TCTX - 1 - s : s) : (j & 127) * 64 + (j >> 7); \
                *(f32x2*)(O + (size_t)tok * 1024 + r2) = (f32x2){o[0], o[1]}; } \
            RW_STORESET(SSET, (c) + 1); \
        } else if ((c) >= 0 && (c) < NCH) { rwkv_compute_chunk(L + ((c) & 1) * (TB * SF), OP + ((c) & 1) * (TB * 256), rl, kg, S); } \
        LDS_BARRIER(); } while (0)
    f32x4 S = {0.f, 0.f, 0.f, 0.f};
    if (wave >= 4) RW_LOADSET(ldA, 0);
    for (int c = -1; c <= NCH; c += 2) { RW_ITER(c, ldB, ldA); RW_ITER(c + 1, ldA, ldB); }
    __syncthreads();
}

__device__ __forceinline__ void combine_phase(const Params& p, int l, int ntok) {
    const int tid = otid(), lane = tid & 63, gw = blockIdx.x * 8 + (tid >> 6), ngw = gridDim.x * 8;
    const float* OG = (const float*)(p.ws + WS_P); const float* OR = OG + (size_t)2 * TTOK * 1024;
    const bf16* SZ = (const bf16*)(p.ws + WS_SZ); const bf16* GT = (const bf16*)(p.ws + WS_GATE);
    const float* BON = (const float*)(p.ws + WS_BONUS);
    bf16* Y = (bf16*)(p.ws + WS_H);
    const float* ng = p.in[12] + (size_t)l * 128; const float* lng = p.in[22] + (size_t)l * 1024; const float* lnb = p.in[23] + (size_t)l * 1024;
    const f32x2 g2 = *(const f32x2*)(ng + 2 * lane);
    for (int tok = gw; tok < ntok; tok += ngw) {
        const float* of = OG + (size_t)tok * 1024; const float* ob = of + (size_t)TTOK * 1024;
#pragma unroll
        for (int hh = 0; hh < 8; ++hh) {
            const f32x2 a = *(const f32x2*)(of + hh * 128 + 2 * lane) + *(const f32x2*)(ob + hh * 128 + 2 * lane);
            const float rstd = rsqrtf(wave_sum(a.x * a.x + a.y * a.y) * (1.f / 128.f) + 1e-6f);
            const unsigned sz = *(const unsigned*)(SZ + (size_t)tok * 1024 + hh * 128 + 2 * lane);
            *(unsigned*)(Y + (size_t)tok * 2048 + hh * 128 + 2 * lane) = pk2(a.x * rstd * g2.x * bflo(sz), a.y * rstd * g2.y * bfhi(sz));
        }
        int sf; if (tok >= TLAT) sf = tok - TLAT; else sf = TCTX + (tok & 63) * 128 + (tok >> 6);
        const float* rf = OR + (size_t)tok * 1024; const float* rb = rf + (size_t)TTOK * 1024;
#pragma unroll
        for (int hh = 0; hh < 16; ++hh) {
            const int c = hh * 64 + lane;
            const float o = rf[c] + rb[c];
            const float mean = wave_sum(o) * (1.f / 64.f), dv = o - mean;
            const float var = wave_sum(dv * dv) * (1.f / 64.f);
            float y = dv * rsqrtf(var + 64e-5f) * lng[c] + lnb[c];
            const float v = bf2f(*(const bf16*)(p.ws + WS_RWS + ((size_t)hh * TTOK + sf) * 384 + 256 + lane * 2));
            y = (y + BON[tok * 16 + hh] * v) * bf2f(GT[(size_t)tok * 1024 + c]);
            Y[(size_t)tok * 2048 + 1024 + c] = (bf16)f2bf(y);
        }
    }
}
#ifndef ONE_LAUNCH
#define ONE_LAUNCH 1
#endif
constexpr int N_PHASES = 20;
#if ONE_LAUNCH
#define PH(k) (true)
#define SEAM(k) xcd_barrier(gbar)
#else
#define PH(k) (p.ph_lo == (k))
#define SEAM(k) do {} while (0)
#endif
#define PHON(k) ((PHMASK >> (k)) & 1)
#ifndef DUPMASK
#define DUPMASK 0
#endif
#define REP(k) for (int rep_ = 0; rep_ <= ((DUPMASK >> (k)) & 1); ++rep_) if (rep_ == 0 || (cg::this_grid().sync(), true))
template <int PHMASK, int l> __device__ __forceinline__ void layer_phases(const Params& p, unsigned char* lds, const XcdBarrier& gbar) {
    float* L = (float*)lds;
    const int b = blockIdx.x, G = gridDim.x;
    float* lat_c = (float*)(p.ws + WS_LATC);
    const float* mod = (const float*)(p.ws + WS_MOD);
    constexpr int M = l == 0 ? TTOK : TLAT;
    constexpr int B0 = 1 + 9 * l;
    const float* res_l = l == 0 ? p.in[0] : p.out; const float* res_c = l == 0 ? p.in[2] : lat_c;
    const float* mod_l = mod + (size_t)(l * 2) * 12288; const float* mod_c = mod_l + 12288;
    REP(0) if (PH(B0 + 0) && PHON(0)) {
        if (l == 1) { const int tid = otid(); convert_weights(p, 1, b * 8 + (tid >> 6), G * 8, L + (tid >> 6) * 2112, tid & 63); }
        norm_phase(p, l, res_l, res_c, p.in[6] + (size_t)l * DM, 0, 1, TTOK);
    }
    SEAM(B0 + 0);
    REP(1) if (PH(B0 + 1) && PHON(1)) {
        pg8::Gemm g{(const pg8::bf16_t*)(p.ws + WS_H), (const pg8::bf16_t*)(p.ws + WS_WT_IN), TTOK, PINP, DM}; pg8::StaticOrder S; S.init(TTOK, PINP, G, b);
        pg8::EpiF32 E{(float*)(p.ws + WS_P), PINP};
        pg8::gemm_phase<pg8::EpiF32, pg8::StaticOrder, true, true>((PG8_LAS unsigned char*)lds, g, S, E);
    }
    SEAM(B0 + 1);
    REP(2) if (PH(B0 + 2)) {
        if (PHON(2)) for (int r2_ = 0; r2_ <= ((DUPMASK >> 14) & 1); ++r2_) for (int it = b; it < 528; it += G) rwkv_prep_item(p, l, it, L);
        if (PHON(11)) for (int r2_ = 0; r2_ <= ((DUPMASK >> 15) & 1); ++r2_) for (int it = b; it < 1056; it += G) gdn_prep_item(p, l, it, L);
    }
    SEAM(B0 + 2);
    REP(3) if (PH(B0 + 3) && PHON(3)) {
        if (b < 64) for (int r2_ = 0; r2_ <= ((DUPMASK >> 12) & 1); ++r2_) { if (r2_) __syncthreads(); gdn_scan(p, b, lds); }
        if (b >= 64 && b < 192) for (int r2_ = 0; r2_ <= ((DUPMASK >> 13) & 1); ++r2_) rwkv_scan(p, b - 64, L);
    }
    SEAM(B0 + 3);
    REP(4) if (PH(B0 + 4) && PHON(4)) combine_phase(p, l, M);
    SEAM(B0 + 4);
    REP(5) if (PH(B0 + 5) && PHON(5)) {
        pg8::Gemm g{(const pg8::bf16_t*)(p.ws + WS_H), (const pg8::bf16_t*)(p.ws + WS_WT_OUT), M, DM, DM}; pg8::StaticOrder S; S.init(M, DM, G, b);
        pg8::EpiRes E{res_l, res_c, p.out, lat_c, mod_l + 2 * DM, mod_c + 2 * DM};
        pg8::gemm_phase<pg8::EpiRes, pg8::StaticOrder, true, true>((PG8_LAS unsigned char*)lds, g, S, E);
    }
    SEAM(B0 + 5);
    REP(6) if (PH(B0 + 6) && PHON(6)) norm_phase(p, l, p.out, lat_c, p.in[7] + (size_t)l * DM, 3, 4, M);
    SEAM(B0 + 6);
    REP(7) if (PH(B0 + 7) && PHON(7)) {
        pg8::Gemm g{(const pg8::bf16_t*)(p.ws + WS_H), (const pg8::bf16_t*)(p.ws + WS_WT_1), M, DFF, DM}; pg8::StaticOrder S; S.init(M, DFF, G, b);
        pg8::EpiRelu2 E{(pg8::bf16_t*)(p.ws + WS_P), DFF};
        pg8::gemm_phase<pg8::EpiRelu2, pg8::StaticOrder, true, true>((PG8_LAS unsigned char*)lds, g, S, E);
    }
    SEAM(B0 + 7);
    REP(8) if (PH(B0 + 8) && PHON(8)) {
        pg8::Gemm g{(const pg8::bf16_t*)(p.ws + WS_P), (const pg8::bf16_t*)(p.ws + WS_WT_2), M, DM, DFF}; pg8::StaticOrder S; S.init(M, DM, G, b);
        pg8::EpiRes E{p.out, lat_c, p.out, lat_c, mod_l + 5 * DM, mod_c + 5 * DM};
        pg8::gemm_phase<pg8::EpiRes, pg8::StaticOrder, true, true>((PG8_LAS unsigned char*)lds, g, S, E);
    }
    SEAM(B0 + 8);
}
template <int PHMASK> __global__ void __launch_bounds__(NTHR) fwd_megakernel(Params p) {
    extern __shared__ __attribute__((aligned(16))) unsigned char lds[];
    volatile LAS unsigned* bst = (volatile LAS unsigned*)((LAS unsigned char*)lds + LDS_BYTES - 16);
    if (threadIdx.x < 4) bst[threadIdx.x] = 0u;
    __syncthreads();
    XcdBarrier gbar; gbar.bar = (unsigned*)(p.ws + WS_BAR); gbar.x = 0; gbar.st = bst;
#if ONE_LAUNCH
    gbar = xcd_barrier_post((unsigned*)(p.ws + WS_BAR), bst);
#endif
    REP(9) if (PH(0) && PHON(9)) phase0(p, (float*)lds);
#if ONE_LAUNCH
    cg::this_grid().sync();
#endif
    layer_phases<PHMASK, 0>(p, lds, gbar);
    layer_phases<PHMASK, 1>(p, lds, gbar);
    if (PH(19) && PHON(10)) final_norm(p);
}

extern "C" void kernel_launch(void* const* d_in, const int* in_sizes, int n_in, void* d_out, int out_size, void* d_ws, size_t ws_size, hipStream_t stream) {
    static int grid = 0;
    if (grid == 0) {
        if (n_in != 28 || ws_size < WS_END) { fprintf(stderr, "kernel_launch: need 28 inputs and %zu bytes of workspace (got %d, %zu)\n", (size_t)WS_END, n_in, ws_size); grid = -1; return; }
        int dev = 0, cus = 0, per_cu = 0;
        (void)hipGetDevice(&dev); (void)hipDeviceGetAttribute(&cus, hipDeviceAttributeMultiprocessorCount, dev);
#if ONE_LAUNCH
        (void)hipFuncSetAttribute((const void*)fwd_megakernel<0xFFFF>, hipFuncAttributeMaxDynamicSharedMemorySize, LDS_BYTES);
        (void)hipOccupancyMaxActiveBlocksPerMultiprocessor(&per_cu, (const void*)fwd_megakernel<0xFFFF>, NTHR, LDS_BYTES);
#else
#define SETATTR(K) (void)hipFuncSetAttribute((const void*)fwd_megakernel<(1 << K)>, hipFuncAttributeMaxDynamicSharedMemorySize, LDS_BYTES)
        SETATTR(0); SETATTR(1); SETATTR(2); SETATTR(3); SETATTR(4); SETATTR(5); SETATTR(6); SETATTR(7); SETATTR(8); SETATTR(9); SETATTR(10); SETATTR(11);
        per_cu = 1;
#endif
        if (per_cu < 1) { fprintf(stderr, "kernel_launch: occupancy query says %d blocks per CU\n", per_cu); grid = -1; return; }
        grid = cus;
        (void)hipGetLastError();
    }
    if (grid < 0) return;
    (void)hipMemsetAsync((char*)d_ws + WS_BAR, 0, 16384, stream);
    Params p{};
    for (int i = 0; i < 28; ++i) p.in[i] = (const float*)d_in[i];
    p.out = (float*)d_out; p.ws = (unsigned char*)d_ws;
#if ONE_LAUNCH
    p.ph_lo = 0; p.ph_hi = N_PHASES;
    void* args[] = {&p};
    hipError_t e = hipLaunchCooperativeKernel((const void*)fwd_megakernel<0xFFFF>, dim3(grid), dim3(NTHR), args, LDS_BYTES, stream);
    if (e != hipSuccess) fprintf(stderr, "cooperative launch failed: %s (grid %d)\n", hipGetErrorString(e), grid);
#else
#define LAUNCH1(K) hipLaunchKernelGGL(fwd_megakernel<(1 << K)>, dim3(grid), dim3(NTHR), LDS_BYTES, stream, p)
    for (int ph = 0; ph < N_PHASES; ++ph) { p.ph_lo = ph; p.ph_hi = ph + 1;
        if (ph == 0) { LAUNCH1(9); continue; }
        if (ph == 19) { LAUNCH1(10); continue; }
        switch ((ph - 1) % 9) {
        case 0: LAUNCH1(0); break; case 1: LAUNCH1(1); break; case 2: LAUNCH1(2); LAUNCH1(11); break; case 3: LAUNCH1(3); break; case 4: LAUNCH1(4); break;
        case 5: LAUNCH1(5); break; case 6: LAUNCH1(6); break; case 7: LAUNCH1(7); break; case 8: LAUNCH1(8); break; }
    }
#endif
}
```

```cpp
#include <hip/hip_runtime.h>
#include <hip/hip_cooperative_groups.h>
#include <cstdio>
#include <cstdint>
namespace cg = cooperative_groups;
__device__ __forceinline__ int otid() { int t = threadIdx.x; asm volatile("" : "+v"(t)); return t; }
namespace pg8 {
#define PG8_LAS __attribute__((address_space(3)))
typedef unsigned short bf16_t;
typedef short bf16x8 __attribute__((ext_vector_type(8)));
typedef float f32x4 __attribute__((ext_vector_type(4)));
typedef unsigned u32x4 __attribute__((ext_vector_type(4)));
constexpr int BM = 256, BK = 64, HALF = 128, HTB = HALF * BK * 2  , STAGE_BYTES = 8 * HTB, NXCD = 8, WGM = 8;

__host__ __device__ __forceinline__ int lds_byte(int r, int c) { const int st = (r >> 4) * 2 + (c >> 5), rr = r & 15, cc = c & 31, ob = rr * 64 + cc * 2; return st * 1024 + (ob ^ (((ob >> 9) & 1) << 5)); }
__host__ __device__ __forceinline__ void stage_rc(int b, int& R, int& C) { const int st = b / 1024, sb = b % 1024, swz = sb ^ (((sb >> 9) & 1) << 5); R = (st >> 1) * 16 + swz / 64; C = (st & 1) * 32 + (swz % 64) / 2; }
__host__ __device__ __forceinline__ int perm32(int rho) { const int n = rho >> 4, i = rho & 15; return 8 * (i >> 2) + 4 * n + (i & 3); }

struct Unit { int pm, pn, ko; };
struct Gemm { const bf16_t* A; const bf16_t* Bt; int M, N, K, ldk; };

struct StaticOrder {
    int nM, nN, nwg, G, c;
    __host__ __device__ void init(int M, int N, int G_, int c_) { nM = M / BM; nN = N / BM; nwg = nM * nN; G = G_; c = c_; }
    __host__ __device__ bool next(int i, Unit& u) const {
        const long L = (long)i * G + c; if (L >= nwg) return false;
        int wgid = (int)L; { const int q = nwg / NXCD, r = nwg % NXCD, xcd = wgid % NXCD, off = wgid / NXCD; wgid = (xcd < r ? xcd * (q + 1) : r * (q + 1) + (xcd - r) * q) + off; }
        const int nig = WGM * nN, gid = wgid / nig, fm = gid * WGM, gsz = (nM - fm) < WGM ? (nM - fm) : WGM;
        u.pm = fm + ((wgid % nig) % gsz); u.pn = (wgid % nig) / gsz; u.ko = 0; return true;
    }
    __device__ __forceinline__ void a_ready(const Unit&) const {}
    __device__ __forceinline__ void done(const Unit&) const {}
};


struct SplitKOrder {
    int nN, S, Kc, G, c, pm;
    __host__ __device__ void init(int N, int S_, int Kc_, int G_, int c_, int pm_) { nN = N / BM; S = S_; Kc = Kc_; G = G_; c = c_; pm = pm_; }
    __host__ __device__ bool next(int i, Unit& u) const { const long L = (long)i * G + c; if (L >= (long)nN * S) return false; u.pm = pm; u.pn = (int)L / S; u.ko = ((int)L % S) * Kc; return true; }
    __device__ __forceinline__ void a_ready(const Unit&) const {}
    __device__ __forceinline__ void done(const Unit&) const {}
};
__device__ __forceinline__ unsigned cvt_pk_bf16(float lo, float hi) { unsigned r; asm volatile("v_cvt_pk_bf16_f32 %0, %1, %2" : "=v"(r) : "v"(lo), "v"(hi)); return r; }
struct EpiF32 {
    static constexpr bool PERM = false, AFTER_DRAIN = false;
    float* O; int ldc;
    __device__ __forceinline__ void operator()(const f32x4 (&acc)[2][2][4][2], const Unit& u, int wr, int wc, int fr, int fq) const {
        const int row0 = u.pm * BM + wr * 64 + fr, col0 = u.pn * BM + wc * 32 + 4 * fq;
#pragma unroll
        for (int ai = 0; ai < 2; ++ai)
#pragma unroll
            for (int m = 0; m < 4; ++m) { float* rowp = O + (size_t)(row0 + ai * HALF + m * 16) * ldc + col0;
#pragma unroll
                for (int bj = 0; bj < 2; ++bj)
#pragma unroll
                    for (int n = 0; n < 2; ++n) *(f32x4*)(rowp + bj * HALF + n * 16) = acc[ai][bj][m][n]; }
    }
    __device__ __forceinline__ void fused(f32x4 (&)[2][2][4][2], const Unit&, int, int, int, int, PG8_LAS unsigned char*, int, int) const {}
};
struct EpiRes {
    static constexpr bool PERM = false, AFTER_DRAIN = false;
    const float* res_l; const float* res_c; float* out_l; float* out_c; const float* gate_l; const float* gate_c;
    __device__ __forceinline__ void operator()(const f32x4 (&acc)[2][2][4][2], const Unit& u, int wr, int wc, int fr, int fq) const {
        const bool isc = u.pm >= 32;
        const float* res = isc ? res_c : res_l; float* out = isc ? out_c : out_l; const float* gate = isc ? gate_c : gate_l;
        const int row0 = (isc ? u.pm - 32 : u.pm) * BM + wr * 64 + fr, col0 = u.pn * BM + wc * 32 + 4 * fq;
        f32x4 gv[2][2];
#pragma unroll
        for (int bj = 0; bj < 2; ++bj)
#pragma unroll
            for (int n = 0; n < 2; ++n) gv[bj][n] = *(const f32x4*)(gate + col0 + bj * HALF + n * 16);
#pragma unroll
        for (int ai = 0; ai < 2; ++ai)
#pragma unroll
            for (int m = 0; m < 4; ++m) { const size_t off = (size_t)(row0 + ai * HALF + m * 16) * 2048 + col0;
#pragma unroll
                for (int bj = 0; bj < 2; ++bj)
#pragma unroll
                    for (int n = 0; n < 2; ++n) { const f32x4 r = *(const f32x4*)(res + off + bj * HALF + n * 16);
                        *(f32x4*)(out + off + bj * HALF + n * 16) = r + gv[bj][n] * acc[ai][bj][m][n]; } }
    }
    __device__ __forceinline__ void fused(f32x4 (&)[2][2][4][2], const Unit&, int, int, int, int, PG8_LAS unsigned char*, int, int) const {}
};
struct EpiRelu2 {
    static constexpr bool PERM = true, AFTER_DRAIN = false;
    bf16_t* O; int ldc;
    __device__ __forceinline__ void operator()(const f32x4 (&acc)[2][2][4][2], const Unit& u, int wr, int wc, int fr, int fq) const {
        const int row0 = u.pm * BM + wr * 64 + fr, col0 = u.pn * BM + wc * 32 + 8 * fq;
#pragma unroll
        for (int ai = 0; ai < 2; ++ai)
#pragma unroll
            for (int m = 0; m < 4; ++m) { bf16_t* rowp = O + (size_t)(row0 + ai * HALF + m * 16) * ldc + col0;
#pragma unroll
                for (int bj = 0; bj < 2; ++bj) { f32x4 v0 = acc[ai][bj][m][0], v1 = acc[ai][bj][m][1];
#pragma unroll
                    for (int e = 0; e < 4; ++e) { const float a = fmaxf(v0[e], 0.f), b = fmaxf(v1[e], 0.f); v0[e] = a * a; v1[e] = b * b; }
                    u32x4 w; w.x = cvt_pk_bf16(v0[0], v0[1]); w.y = cvt_pk_bf16(v0[2], v0[3]); w.z = cvt_pk_bf16(v1[0], v1[1]); w.w = cvt_pk_bf16(v1[2], v1[3]);
                    *(u32x4*)(rowp + bj * HALF) = w; } }
    }
    __device__ __forceinline__ void fused(f32x4 (&)[2][2][4][2], const Unit&, int, int, int, int, PG8_LAS unsigned char*, int, int) const {}
};
struct EpiAtomic {
    static constexpr bool PERM = false, AFTER_DRAIN = false;
    float* out; const float* gate;
    __device__ __forceinline__ void operator()(const f32x4 (&acc)[2][2][4][2], const Unit& u, int wr, int wc, int fr, int fq) const {
        const int row0 = wr * 64 + fr, col0 = u.pn * BM + wc * 32 + 4 * fq;
        f32x4 gv[2][2];
#pragma unroll
        for (int bj = 0; bj < 2; ++bj)
#pragma unroll
            for (int n = 0; n < 2; ++n) gv[bj][n] = *(const f32x4*)(gate + col0 + bj * HALF + n * 16);
        float* o = out + (size_t)row0 * 2048 + col0;
#pragma unroll
        for (int ai = 0; ai < 2; ++ai)
#pragma unroll
            for (int m = 0; m < 4; ++m) { float* orow = o + (size_t)(ai * HALF + m * 16) * 2048; asm volatile("" : "+v"(orow));
#pragma unroll
                for (int bj = 0; bj < 2; ++bj)
#pragma unroll
                    for (int n = 0; n < 2; ++n) { const f32x4 v = gv[bj][n] * acc[ai][bj][m][n]; float* q = orow + bj * HALF + n * 16;
                        unsafeAtomicAdd(q, v.x); unsafeAtomicAdd(q + 1, v.y); unsafeAtomicAdd(q + 2, v.z); unsafeAtomicAdd(q + 3, v.w); }
                asm volatile("" ::: "memory"); }
    }
    __device__ __forceinline__ void fused(f32x4 (&)[2][2][4][2], const Unit&, int, int, int, int, PG8_LAS unsigned char*, int, int) const {}
};
template <class Epi, class Sched, bool ALIGN_EPI = false, bool SP2 = false>
__device__ __forceinline__ void gemm_phase(PG8_LAS unsigned char* lds, const Gemm g, const Sched& S, const Epi& E) {
    const int tid = otid(), wid = __builtin_amdgcn_readfirstlane(tid >> 6), lane = tid & 63, wr = wid >> 2, wc = wid & 3, fr = lane & 15, fq = lane >> 4;
    const int K = g.ldk, nt = g.K / BK;
    unsigned voffA[2], voffB[2];
#pragma unroll
    for (int i = 0; i < 2; ++i) { int R, C; stage_rc(tid * 16 + i * 8192, R, C); const int Rb = Epi::PERM ? ((R & ~31) + perm32(R & 31)) : R;
        voffA[i] = (unsigned)(R * K + C) * 2u; voffB[i] = (unsigned)(Rb * K + C) * 2u; }
    const size_t kstep = (size_t)(BK * 2);
    const size_t hstep = (size_t)HALF * K * 2;
    const size_t tstep = 2 * hstep;
    const unsigned ldsw = (unsigned)wid * 1024u;
    const int aoff = lds_byte(wr * 64 + fr, fq * 8), boff = lds_byte(wc * 32 + fr, fq * 8);
#define PG8_SA(b, h) (((b) * 2 + (h)) * HTB)
#define PG8_SB(b, h) ((4 + (b) * 2 + (h)) * HTB)
#define PG8_STAGE(bufoff, gbase, voff) do { _Pragma("unroll") for (int _i = 0; _i < 2; ++_i) \
        __builtin_amdgcn_global_load_lds((const unsigned*)((const char*)(gbase) + (voff)[_i]), (PG8_LAS unsigned*)(lds + (bufoff) + ldsw + _i * 8192), 16, 0, 0); } while (0)
#define PG8_LDA(dst, b, h) do { _Pragma("unroll") for (int m = 0; m < 4; ++m) _Pragma("unroll") for (int k = 0; k < 2; ++k) dst[m][k] = *(const PG8_LAS bf16x8*)(lds + PG8_SA(b, h) + aoff + m * 2048 + k * 1024); } while (0)
#define PG8_LDB(dst, b, h) do { _Pragma("unroll") for (int n = 0; n < 2; ++n) _Pragma("unroll") for (int k = 0; k < 2; ++k) dst[n][k] = *(const PG8_LAS bf16x8*)(lds + PG8_SB(b, h) + boff + n * 2048 + k * 1024); } while (0)
#define PG8_MMA(ai, bj, At, Bt) do { __builtin_amdgcn_s_setprio(1); _Pragma("unroll") for (int m = 0; m < 4; ++m) _Pragma("unroll") for (int n = 0; n < 2; ++n) _Pragma("unroll") for (int k = 0; k < 2; ++k) \
        acc[ai][bj][m][n] = __builtin_amdgcn_mfma_f32_16x16x32_bf16(Bt[n][k], At[m][k], acc[ai][bj][m][n], 0, 0, 0); __builtin_amdgcn_s_setprio(0); } while (0)
#define PG8_WAIT_V(n) asm volatile("s_waitcnt vmcnt(" #n ")" ::: "memory")
#define PG8_WAIT_L(n) asm volatile("s_waitcnt lgkmcnt(" #n ")" ::: "memory")
#define PG8_BAR __builtin_amdgcn_s_barrier()
#define PG8_SCHED __builtin_amdgcn_sched_barrier(0)
    Unit cur, nxt; int ui = 0;
    if (!S.next(0, cur)) return;
    f32x4 acc[2][2][4][2];
#pragma unroll
    for (int a = 0; a < 2; ++a)
#pragma unroll
        for (int b = 0; b < 2; ++b)
#pragma unroll
            for (int m = 0; m < 4; ++m)
#pragma unroll
                for (int n = 0; n < 2; ++n) acc[a][b][m][n] = (f32x4){0.f, 0.f, 0.f, 0.f};
    bf16x8 At[4][2], B0[2][2], B1[2][2];
    const char* cA = (const char*)g.A + (size_t)cur.pm * tstep + (size_t)cur.ko * 2; const char* cB = (const char*)g.Bt + (size_t)cur.pn * tstep + (size_t)cur.ko * 2;
    S.a_ready(cur);
    if constexpr (SP2) {
        PG8_STAGE(PG8_SB(0, 0), cB, voffB); PG8_STAGE(PG8_SB(0, 1), cB + hstep, voffB); PG8_STAGE(PG8_SA(0, 0), cA, voffA); PG8_STAGE(PG8_SA(0, 1), cA + hstep, voffA);
        if (wr == 1) PG8_BAR;
        PG8_WAIT_V(2); PG8_BAR;
        PG8_STAGE(PG8_SB(1, 0), cB + kstep, voffB); PG8_STAGE(PG8_SA(1, 0), cA + kstep, voffA); PG8_STAGE(PG8_SB(1, 1), cB + hstep + kstep, voffB);
        PG8_WAIT_V(6); PG8_BAR;
    } else {
        PG8_STAGE(PG8_SB(0, 0), cB, voffB); PG8_STAGE(PG8_SA(0, 0), cA, voffA); PG8_STAGE(PG8_SB(0, 1), cB + hstep, voffB); PG8_STAGE(PG8_SA(0, 1), cA + hstep, voffA);
        if (wr == 1) PG8_BAR;
        PG8_WAIT_V(4); PG8_BAR;
        PG8_STAGE(PG8_SB(1, 0), cB + kstep, voffB); PG8_STAGE(PG8_SA(1, 0), cA + kstep, voffA); PG8_STAGE(PG8_SB(1, 1), cB + hstep + kstep, voffB);
        PG8_WAIT_V(6); PG8_BAR;
    }
    for (;;) {
        const bool has_next = S.next(ui + 1, nxt);
        const char* nA = has_next ? (const char*)g.A + (size_t)nxt.pm * tstep + (size_t)nxt.ko * 2 : cA; const char* nB = has_next ? (const char*)g.Bt + (size_t)nxt.pn * tstep + (size_t)nxt.ko * 2 : cB;
        for (int t = 0; t < nt; t += 2) {
            const bool last = (t == nt - 2);
            const char* a1 = cA + (size_t)(t + 1) * kstep;
            const char* a2 = last ? nA : cA + (size_t)(t + 2) * kstep; const char* b2 = last ? nB : cB + (size_t)(t + 2) * kstep;
            const char* a3 = a2 + kstep; const char* b3 = b2 + kstep;
            if (last && has_next) S.a_ready(nxt);
            if constexpr (SP2) {
            PG8_LDB(B0, 0, 0); PG8_LDB(B1, 0, 1); PG8_SCHED; PG8_LDA(At, 0, 0); PG8_STAGE(PG8_SA(1, 1), a1 + hstep, voffA);
            PG8_WAIT_V(8); PG8_WAIT_L(0); PG8_BAR; PG8_MMA(0, 0, At, B0); PG8_MMA(0, 1, At, B1); PG8_BAR; PG8_SCHED;
            PG8_LDA(At, 0, 1); PG8_STAGE(PG8_SB(0, 0), b2, voffB); PG8_STAGE(PG8_SB(0, 1), b2 + hstep, voffB); PG8_STAGE(PG8_SA(0, 0), a2, voffA);
            PG8_WAIT_V(8); PG8_WAIT_L(0); PG8_BAR; PG8_MMA(1, 0, At, B0); PG8_MMA(1, 1, At, B1); PG8_BAR; PG8_SCHED;
            PG8_LDB(B0, 1, 0); PG8_LDB(B1, 1, 1); PG8_SCHED; PG8_LDA(At, 1, 0); PG8_STAGE(PG8_SA(0, 1), a2 + hstep, voffA);
            PG8_WAIT_V(8); PG8_WAIT_L(0); PG8_BAR; PG8_MMA(0, 0, At, B0); PG8_MMA(0, 1, At, B1); PG8_BAR; PG8_SCHED;
            PG8_LDA(At, 1, 1); PG8_STAGE(PG8_SB(1, 0), b3, voffB); PG8_STAGE(PG8_SB(1, 1), b3 + hstep, voffB); PG8_STAGE(PG8_SA(1, 0), a3, voffA);
            PG8_WAIT_V(8); PG8_WAIT_L(0); PG8_BAR; PG8_MMA(1, 0, At, B0); PG8_MMA(1, 1, At, B1); PG8_BAR; PG8_SCHED;
            } else {
            PG8_LDB(B0, 0, 0); PG8_SCHED; PG8_LDA(At, 0, 0); PG8_STAGE(PG8_SA(1, 1), a1 + hstep, voffA);
            PG8_WAIT_L(8); PG8_BAR; PG8_WAIT_L(0); PG8_MMA(0, 0, At, B0); PG8_BAR; PG8_SCHED;
            PG8_LDB(B1, 0, 1); PG8_STAGE(PG8_SB(0, 0), b2, voffB);
            PG8_BAR; PG8_WAIT_L(0); PG8_MMA(0, 1, At, B1); PG8_BAR;
            PG8_LDA(At, 0, 1); PG8_STAGE(PG8_SA(0, 0), a2, voffA);
            PG8_BAR; PG8_WAIT_L(0); PG8_MMA(1, 0, At, B0); PG8_BAR; PG8_SCHED;
            PG8_STAGE(PG8_SB(0, 1), b2 + hstep, voffB);
            PG8_WAIT_V(6); PG8_BAR; PG8_MMA(1, 1, At, B1); PG8_BAR;
            PG8_LDB(B0, 1, 0); PG8_SCHED; PG8_LDA(At, 1, 0); PG8_STAGE(PG8_SA(0, 1), a2 + hstep, voffA);
            PG8_WAIT_L(8); PG8_BAR; PG8_WAIT_L(0); PG8_MMA(0, 0, At, B0); PG8_BAR; PG8_SCHED;
            PG8_LDB(B1, 1, 1); PG8_STAGE(PG8_SB(1, 0), b3, voffB);
            PG8_BAR; PG8_WAIT_L(0); PG8_MMA(0, 1, At, B1); PG8_BAR;
            PG8_LDA(At, 1, 1); PG8_STAGE(PG8_SA(1, 0), a3, voffA);
            PG8_BAR; PG8_WAIT_L(0); PG8_MMA(1, 0, At, B0); PG8_BAR; PG8_SCHED;
            PG8_STAGE(PG8_SB(1, 1), b3 + hstep, voffB);
            PG8_WAIT_V(6); PG8_BAR; PG8_MMA(1, 1, At, B1); PG8_BAR;
            }
        }
        if constexpr (ALIGN_EPI) { if (wr == 0) PG8_BAR; }
        if constexpr (!Epi::AFTER_DRAIN) { E(acc, cur, wr, wc, fr, fq); S.done(cur); }
        if (!has_next) break;
#pragma unroll
        for (int a = 0; a < 2; ++a)
#pragma unroll
            for (int b = 0; b < 2; ++b)
#pragma unroll
                for (int m = 0; m < 4; ++m)
#pragma unroll
                    for (int n = 0; n < 2; ++n) acc[a][b][m][n] = (f32x4){0.f, 0.f, 0.f, 0.f};
        cur = nxt; cA = nA; cB = nB; ++ui;
        if constexpr (ALIGN_EPI) { if (wr == 1) PG8_BAR; }
    }
    PG8_WAIT_V(0);
    if constexpr (!ALIGN_EPI) { if (wr == 0) PG8_BAR; }
    PG8_BAR;
    if constexpr (Epi::AFTER_DRAIN) { E.fused(acc, cur, wr, wc, fr, fq, lds, wid, lane); S.done(cur); }
#undef PG8_SA
#undef PG8_SB
#undef PG8_STAGE
#undef PG8_LDA
#undef PG8_LDB
#undef PG8_MMA
#undef PG8_WAIT_V
#undef PG8_WAIT_L
#undef PG8_BAR
#undef PG8_SCHED
}
}
#define LAS __attribute__((address_space(3)))
typedef unsigned short bf16;
typedef float f32x4 __attribute__((ext_vector_type(4)));
typedef float f32x2 __attribute__((ext_vector_type(2)));
typedef short bf16x8 __attribute__((ext_vector_type(8)));
typedef unsigned v4u __attribute__((ext_vector_type(4)));
typedef unsigned v2u __attribute__((ext_vector_type(2)));

constexpr int NTHR = 512;
constexpr int LDS_BYTES = 155648;
constexpr int DM = 2048, TLAT = 8192, TCTX = 256, TTOK = 8448, PINP = 7680, DFF = 8192;
constexpr size_t MiB = 1u << 20;
constexpr size_t WS_MOD = 0;
constexpr size_t WS_DL = 256 * 1024;
constexpr size_t WS_BONUS = 512 * 1024;
constexpr size_t WS_BAR = 1536 * 1024;
constexpr size_t WS_LATC = 2 * MiB;
constexpr size_t WS_WT_IN = 4 * MiB, WS_WT_OUT = 34 * MiB, WS_WT_1 = 42 * MiB, WS_WT_2 = 74 * MiB;
constexpr size_t WS_H = 106 * MiB;
constexpr size_t WS_SZ = 139 * MiB;
constexpr size_t WS_GATE = WS_SZ + (size_t)TTOK * 1024 * 2;
constexpr size_t WS_P = 172 * MiB;
constexpr size_t WS_GDN = 420 * MiB;
constexpr size_t WS_RWD = 569 * MiB;
constexpr size_t WS_RWS = WS_RWD + (size_t)2 * 16 * TTOK * 512;
constexpr size_t WS_WSM = 752 * MiB;
constexpr size_t WS_END = WS_WSM + (size_t)2 * 1024 * 416 * 2;
static_assert(WS_RWS + (size_t)16 * TTOK * 384 <= WS_WSM, "ws map");
static_assert(WS_GATE + (size_t)TTOK * 1024 * 2 <= WS_P && WS_P + (size_t)TTOK * PINP * 4 <= WS_GDN && WS_GDN + (size_t)2 * 8 * 132 * 36864 * 2 <= WS_RWD, "ws map");
static_assert(WS_END <= 768 * MiB, "ws size");

struct Params { const float* in[28]; float* out; unsigned char* ws; int ph_lo, ph_hi; };

__device__ __forceinline__ unsigned f2bf(float f) { unsigned u = __builtin_bit_cast(unsigned, f); return (u + 0x7fffu + ((u >> 16) & 1u)) >> 16; }
__device__ __forceinline__ unsigned pk2(float lo, float hi) { return f2bf(lo) | (f2bf(hi) << 16); }
__device__ __forceinline__ float bf2f(unsigned b) { return __builtin_bit_cast(float, b << 16); }
__device__ __forceinline__ float bflo(unsigned w) { return __builtin_bit_cast(float, w << 16); }
__device__ __forceinline__ float bfhi(unsigned w) { return __builtin_bit_cast(float, w & 0xffff0000u); }
__device__ __forceinline__ float wave_sum(float v) {
#pragma unroll
    for (int o = 1; o < 64; o <<= 1) v += __shfl_xor(v, o);
    return v;
}
__device__ __forceinline__ float sigmoidf_(float x) { return 1.f / (1.f + expf(-x)); }
__device__ __forceinline__ float siluf_(float x) { return x / (1.f + expf(-x)); }
__device__ __forceinline__ float softplusf_(float x) { return x > 20.f ? x : log1pf(expf(x)); }
#define LDS_WAIT() asm volatile("s_waitcnt lgkmcnt(0)" ::: "memory")

__device__ __forceinline__ void transpose_item(const float* W, int K, int N, bf16* WT, float* scr, int item, int lane) {
    const int nblk = N / 32, kb = item / nblk, nb = item % nblk, k0 = 64 * kb, n0 = 32 * nb;
#pragma unroll 8
    for (int i = 0; i < 32; ++i) { const int kk = 2 * i + (lane >> 5); scr[kk * 33 + (lane & 31)] = W[(size_t)(k0 + kk) * N + n0 + (lane & 31)]; }
    LDS_WAIT();
    const int c = lane & 7;
#pragma unroll
    for (int j = 0; j < 4; ++j) { const int n = (lane >> 3) + 8 * j; const float* s = scr + (8 * c) * 33 + n;
        v4u o; o.x = pk2(s[0 * 33], s[1 * 33]); o.y = pk2(s[2 * 33], s[3 * 33]); o.z = pk2(s[4 * 33], s[5 * 33]); o.w = pk2(s[6 * 33], s[7 * 33]);
        *(v4u*)(WT + (size_t)(n0 + n) * K + k0 + 8 * c) = o; }
    LDS_WAIT();
}
__device__ __forceinline__ void convert_weights(const Params& p, int l, int mask, int gw, int ngw, float* scr, int lane) {
    const float* w_in = p.in[8] + (size_t)l * 2048 * 7616; const float* w_out = p.in[24] + (size_t)l * 2048 * 2048;
    const float* w1 = p.in[25] + (size_t)l * 2048 * 8192; const float* w2 = p.in[26] + (size_t)l * 8192 * 2048;
    bf16* t_in = (bf16*)(p.ws + WS_WT_IN); bf16* t_out = (bf16*)(p.ws + WS_WT_OUT); bf16* t_1 = (bf16*)(p.ws + WS_WT_1); bf16* t_2 = (bf16*)(p.ws + WS_WT_2);
    const int n0 = (mask & 1) ? 7616 : 0, n1 = (mask & 2) ? 2048 : 0, n2 = (mask & 4) ? 8192 : 0, n3 = (mask & 8) ? 8192 : 0;
    for (int it = gw; it < n0 + n1 + n2 + n3; it += ngw) {
        int r = it;
        if (r < n0) { transpose_item(w_in, 2048, 7616, t_in, scr, r, lane); continue; } r -= n0;
        if (r < n1) { transpose_item(w_out, 2048, 2048, t_out, scr, r, lane); continue; } r -= n1;
        if (r < n2) { transpose_item(w1, 2048, 8192, t_1, scr, r, lane); continue; } r -= n2;
        transpose_item(w2, 8192, 2048, t_2, scr, r, lane);
    }
}
__device__ __forceinline__ void phase0(const Params& p, float* L) {
    const int tid = otid(), lane = tid & 63, wave = tid >> 6, G = gridDim.x, b = blockIdx.x;
    for (int i = b * NTHR + tid; i < TCTX * DM / 4; i += G * NTHR) ((f32x4*)(p.ws + WS_LATC))[i] = ((const f32x4*)p.in[2])[i];
    { v4u z = {0u, 0u, 0u, 0u}; v4u* dst = (v4u*)((bf16*)(p.ws + WS_WT_IN) + (size_t)7616 * 2048);
      for (int i = b * NTHR + tid; i < 64 * 2048 / 8; i += G * NTHR) dst[i] = z; }
    convert_weights(p, 0, 1, b * 8 + wave, G * 8, L + wave * 2112, lane);
    for (int t = b * NTHR + tid; t < 2 * 52 * 1024; t += G * NTHR) {
        const int n = t & 1023, kg = (t >> 10) % 52, l = t / (52 * 1024), k0 = kg * 8;
        const float* src; int kk0;
        if (k0 < 128) { src = p.in[15] + ((size_t)(l * 2 + (k0 >> 6)) * 64) * 1024; kk0 = k0 & 63; }
        else if (k0 < 256) { src = p.in[17] + ((size_t)(l * 2 + ((k0 - 128) >> 6)) * 64) * 1024; kk0 = k0 & 63; }
        else { src = p.in[18] + (size_t)l * 160 * 1024; kk0 = k0 - 256; }
        float v[8];
#pragma unroll
        for (int e = 0; e < 8; ++e) v[e] = src[(size_t)(kk0 + e) * 1024 + n];
        *(v4u*)((bf16*)(p.ws + WS_WSM) + ((size_t)l * 1024 + n) * 416 + k0) = (v4u){pk2(v[0], v[1]), pk2(v[2], v[3]), pk2(v[4], v[5]), pk2(v[6], v[7])};
    }
    __syncthreads();
    float* sl = L; float* sc = L + 2048;
    for (int k = tid; k < 2048; k += NTHR) { sl[k] = siluf_(p.in[1][k]); sc[k] = siluf_(p.in[3][k]); }
    __syncthreads();
    for (int it = b; it < 512; it += G) {
        const int l = it >> 8, cb = (it >> 5) & 7, kr = it & 31;
        if (tid < 384) {
            const float* W = p.in[4] + ((size_t)l * 2048 + kr * 64) * 12288 + cb * 1536 + tid * 4;
            f32x4 a0 = {0.f, 0.f, 0.f, 0.f}, a1 = {0.f, 0.f, 0.f, 0.f};
#pragma unroll 16
            for (int k = 0; k < 64; ++k) { const f32x4 w = *(const f32x4*)(W + (size_t)k * 12288); a0 += sl[kr * 64 + k] * w; a1 += sc[kr * 64 + k] * w; }
            if (kr == 0) { const f32x4 bv = *(const f32x4*)(p.in[5] + l * 12288 + cb * 1536 + tid * 4); a0 += bv; a1 += bv; }
            float* m0 = (float*)(p.ws + WS_MOD) + (l * 2) * 12288 + cb * 1536 + tid * 4; float* m1 = m0 + 12288;
            unsafeAtomicAdd(m0, a0.x); unsafeAtomicAdd(m0 + 1, a0.y); unsafeAtomicAdd(m0 + 2, a0.z); unsafeAtomicAdd(m0 + 3, a0.w);
            unsafeAtomicAdd(m1, a1.x); unsafeAtomicAdd(m1 + 1, a1.y); unsafeAtomicAdd(m1 + 2, a1.z); unsafeAtomicAdd(m1 + 3, a1.w);
        }
    }
}

__device__ __forceinline__ void norm_phase(const Params& p, int l, const float* xl, const float* xc, const float* g, int sh_idx, int sc_idx, int nrows) {
    const int tid = otid(), lane = tid & 63, gw = blockIdx.x * 8 + (tid >> 6), ngw = gridDim.x * 8;
    bf16* H = (bf16*)(p.ws + WS_H);
    const float* mod = (const float*)(p.ws + WS_MOD) + (size_t)l * 2 * 12288;
    for (int row = gw; row < nrows; row += ngw) {
        const bool isc = row >= TLAT;
        const float* xr = isc ? xc + (size_t)(row - TLAT) * DM : xl + (size_t)row * DM;
        const float* md = mod + (isc ? 12288 : 0);
        f32x4 v[8]; float ss = 0.f;
#pragma unroll
        for (int j = 0; j < 8; ++j) { v[j] = ((const f32x4*)xr)[lane + 64 * j]; ss += v[j].x * v[j].x + v[j].y * v[j].y + v[j].z * v[j].z + v[j].w * v[j].w; }
        const float rstd = rsqrtf(wave_sum(ss) * (1.f / DM) + 1e-6f);
#pragma unroll
        for (int j = 0; j < 8; ++j) { const int col = 4 * (lane + 64 * j);
            const f32x4 gg = *(const f32x4*)(g + col), s1 = *(const f32x4*)(md + sc_idx * DM + col), s0 = *(const f32x4*)(md + sh_idx * DM + col);
            const f32x4 y = v[j] * rstd * gg * (1.f + s1) + s0;
            v2u o; o.x = pk2(y.x, y.y); o.y = pk2(y.z, y.w);
            *(v2u*)(H + (size_t)row * DM + col) = o; }
    }
}
__device__ __forceinline__ void final_norm(const Params& p) {
    const int tid = otid(), lane = tid & 63, gw = blockIdx.x * 8 + (tid >> 6), ngw = gridDim.x * 8;
    const float* g = p.in[27];
    for (int row = gw; row < TLAT; row += ngw) {
        float* xr = p.out + (size_t)row * DM;
        f32x4 v[8]; float ss = 0.f;
#pragma unroll
        for (int j = 0; j < 8; ++j) { v[j] = ((const f32x4*)xr)[lane + 64 * j]; ss += v[j].x * v[j].x + v[j].y * v[j].y + v[j].z * v[j].z + v[j].w * v[j].w; }
        const float rstd = rsqrtf(wave_sum(ss) * (1.f / DM) + 1e-6f);
#pragma unroll
        for (int j = 0; j < 8; ++j) { const f32x4 gg = ((const f32x4*)g)[lane + 64 * j]; ((f32x4*)xr)[lane + 64 * j] = v[j] * rstd * gg; }
    }
}
typedef __attribute__((address_space(1))) unsigned gu32;
#define XB_TMO      128
#define XB_XCNT(j)  (256  + 64 * (j))
#define XB_XSUB(j)  (1280 + 64 * (j))
#define XB_XGEN(j)  (2304 + 64 * (j))
#define XB_TOP      3328
#define XB_TOPGEN   3392
#define XCD_BAR_WORDS 3456
#define XB_SPIN_CAP (1u << 18)

__device__ __forceinline__ unsigned xb_ld(unsigned* p)              { return __hip_atomic_load(p, __ATOMIC_RELAXED, __HIP_MEMORY_SCOPE_AGENT); }
__device__ __forceinline__ unsigned xb_add(unsigned* p, unsigned v) { return __hip_atomic_fetch_add(p, v, __ATOMIC_RELAXED, __HIP_MEMORY_SCOPE_AGENT); }
__device__ __forceinline__ unsigned xb_xcc_id() { return (unsigned)__builtin_amdgcn_s_getreg((3 << 11) | 20) & 0xFu; }
#define XB_SPIN(cond, bar) do { unsigned _sp = 0; while (cond) { __builtin_amdgcn_s_sleep(1); \
    if ((++_sp & 255u) == 0u) { if (xb_ld(&(bar)[XB_TMO])) break; if (_sp > XB_SPIN_CAP) { atomicAdd(&(bar)[XB_TMO], 1u); break; } } } } while (0)

struct XcdBarrier {
    unsigned* bar; unsigned x;
    volatile LAS unsigned* st;
};

__device__ __forceinline__ XcdBarrier xcd_barrier_post(unsigned* bar, volatile LAS unsigned* st) {
    XcdBarrier b; b.bar = bar; b.x = xb_xcc_id(); b.st = st;
    if (threadIdx.x == 0) (void)xb_add(&bar[XB_XCNT(b.x)], 1u);
    return b;
}
__device__ __forceinline__ void xcd_barrier_complete(unsigned* bar, unsigned x, unsigned& nloc, unsigned& nx) {
    const unsigned G = gridDim.x * gridDim.y * gridDim.z;
    unsigned sum, cnt, mine, sp = 0u;
    for (;;) {
        sum = 0u; cnt = 0u; mine = 0u;
#pragma unroll
        for (unsigned j = 0; j < 16; ++j) { const unsigned c = xb_ld(&bar[XB_XCNT(j)]); sum += c; cnt += (c > 0u) ? 1u : 0u; mine = (j == x) ? c : mine; }
        if (sum == G) break;
        __builtin_amdgcn_s_sleep(1);
        if ((++sp & 255u) == 0u) { if (xb_ld(&bar[XB_TMO])) break; if (sp > XB_SPIN_CAP) { atomicAdd(&bar[XB_TMO], 1u); break; } }
    }
    nloc = mine > 0u ? mine : 1u; nx = cnt > 0u ? cnt : 1u;
}

__device__ __forceinline__ void xcd_barrier(const XcdBarrier& b) {
    asm volatile("s_waitcnt vmcnt(0)" ::: "memory");
    __syncthreads();
    if (threadIdx.x == 0) {
        unsigned* bar = b.bar;
        __builtin_amdgcn_s_waitcnt(0);
        unsigned nloc = b.st[0], nx = b.st[1];
        if (nloc == 0u) { xcd_barrier_complete(bar, b.x, nloc, nx); b.st[0] = nloc; b.st[1] = nx; }
        const unsigned old = xb_add(&bar[XB_XSUB(b.x)], 1u);
        const unsigned gen = old / nloc;
        if (old + 1u == (gen + 1u) * nloc) {
            __builtin_amdgcn_fence(__ATOMIC_RELEASE, "agent");
            asm volatile("s_waitcnt vmcnt(0)" ::: "memory");
            const unsigned og = xb_add(&bar[XB_TOP], 1u);
            const unsigned tg = og / nx;
            if (og + 1u == (tg + 1u) * nx) xb_add(&bar[XB_TOPGEN], 1u);
            else XB_SPIN(xb_ld(&bar[XB_TOPGEN]) == tg, bar);
            __builtin_amdgcn_fence(__ATOMIC_ACQUIRE, "agent");
            xb_add(&bar[XB_XGEN(b.x)], 1u);
            asm volatile("s_waitcnt vmcnt(0)" ::: "memory");
        } else {
            XB_SPIN(xb_ld(&bar[XB_XGEN(b.x)]) == gen, bar);
            __builtin_amdgcn_fence(__ATOMIC_ACQUIRE, "agent");
            asm volatile("s_waitcnt vmcnt(0)" ::: "memory");
        }
    }
    __syncthreads();
}

__device__ __forceinline__ void gdn_prep_item(const Params& p, int l, int item, float* L) {
    const int tid = otid(), lane = tid & 63, wave = tid >> 6;
    const int h = item & 7, ch = item >> 3;
    const bool isctx = ch >= 128;
    const int seg0 = isctx ? TLAT : 0, seglen = isctx ? TCTX : TLAT, t0 = isctx ? (ch - 128) * 64 : ch * 64;
    const float* P = (const float*)(p.ws + WS_P);
    const float* cw = p.in[9] + (size_t)l * 3 * 3072;
    float* qs = L; float* ks = L + 8448; float* KKm = L + 16896; float* QKm = L + 21056; float* TI = L + 25216;
    float* Gs = L + 33920; float* BETA = Gs + 128; float* EG = Gs + 256; float* GL = Gs + 384;
    bf16* const gd0 = (bf16*)(p.ws + WS_GDN) + ((size_t)h * 132 + (isctx ? (ch - 128) : 4 + ch)) * 36864;
    bf16* const gd1 = (bf16*)(p.ws + WS_GDN) + ((size_t)(8 + h) * 132 + (isctx ? 3 - (ch - 128) : 4 + 127 - ch)) * 36864;
#define GDP(d) ((d) ? gd1 : gd0)
    {
        const int i = tid >> 3, c0 = (tid & 7) * 16, tk = t0 + i;
        const size_t prow = (size_t)(seg0 + tk) * PINP;
#pragma unroll
        for (int which = 0; which < 2; ++which) {
            const int col = which * 1024 + h * 128 + c0;
            f32x4 y[4]; float ss = 0.f;
#pragma unroll
            for (int jj = 0; jj < 4; ++jj) {
                const f32x4 x0 = *(const f32x4*)(P + prow + col + 4 * jj);
                f32x4 xm = {0.f, 0.f, 0.f, 0.f}, xp = {0.f, 0.f, 0.f, 0.f};
                if (tk > 0) xm = *(const f32x4*)(P + prow - PINP + col + 4 * jj);
                if (tk < seglen - 1) xp = *(const f32x4*)(P + prow + PINP + col + 4 * jj);
                const f32x4 w0 = *(const f32x4*)(cw + col + 4 * jj), w1 = *(const f32x4*)(cw + 3072 + col + 4 * jj), w2 = *(const f32x4*)(cw + 6144 + col + 4 * jj);
                f32x4 t = xm * w0 + x0 * w1 + xp * w2;
                t.x = siluf_(t.x); t.y = siluf_(t.y); t.z = siluf_(t.z); t.w = siluf_(t.w);
                y[jj] = t; ss += t.x * t.x + t.y * t.y + t.z * t.z + t.w * t.w;
            }
            ss += __shfl_xor(ss, 1); ss += __shfl_xor(ss, 2); ss += __shfl_xor(ss, 4);
            const float sc = rsqrtf(ss + 1e-6f) * (which == 0 ? 0.08838834764831845f : 1.f);
            float* dst = (which ? ks : qs) + i * 132 + c0;
#pragma unroll
            for (int jj = 0; jj < 4; ++jj) *(f32x4*)(dst + 4 * jj) = y[jj] * sc;
        }
        {
            const int col = 3072 + h * 128 + c0; unsigned o[8];
#pragma unroll
            for (int jj = 0; jj < 4; ++jj) { const f32x4 z = *(const f32x4*)(P + prow + col + 4 * jj);
                o[2 * jj] = pk2(siluf_(z.x), siluf_(z.y)); o[2 * jj + 1] = pk2(siluf_(z.z), siluf_(z.w)); }
            bf16* sz = (bf16*)(p.ws + WS_SZ) + (size_t)(seg0 + tk) * 1024 + h * 128 + c0;
            *(v4u*)sz = (v4u){o[0], o[1], o[2], o[3]}; *(v4u*)(sz + 8) = (v4u){o[4], o[5], o[6], o[7]};
        }
    }
    if (tid < 128) {
        const int d = tid >> 6, ip = tid & 63, i = d ? 63 - ip : ip;
        const size_t prow = (size_t)(seg0 + t0 + i) * PINP;
        const float bb = P[prow + 4096 + d * 8 + h], al = P[prow + 4112 + d * 8 + h];
        const float A = expf(p.in[10][l * 16 + d * 8 + h]);
        float g = -A * softplusf_(al + p.in[11][l * 16 + d * 8 + h]);
#pragma unroll
        for (int o = 1; o < 64; o <<= 1) { const float t = __shfl_up(g, o); if (ip >= o) g += t; }
        Gs[d * 64 + ip] = g; BETA[d * 64 + ip] = sigmoidf_(bb); EG[d * 64 + ip] = expf(g);
        if (ip == 63) { GL[d] = g;
            const int np = isctx ? (d ? 3 - (ch - 128) : (ch - 128)) : (d ? 4 + 127 - ch : 4 + ch);
            ((float*)(p.ws + WS_DL))[(d * 8 + h) * 132 + np] = expf(g); }
    }
    __syncthreads();
    {
        const int ia = tid >> 4, jb = tid & 15;
        float akk[2][4], aqk[2][4];
#pragma unroll
        for (int a = 0; a < 2; ++a)
#pragma unroll
            for (int bq = 0; bq < 4; ++bq) { akk[a][bq] = 0.f; aqk[a][bq] = 0.f; }
        for (int c = 0; c < 128; c += 4) {
            f32x4 ki[2], qi[2], kj[4];
#pragma unroll
            for (int a = 0; a < 2; ++a) { ki[a] = *(const f32x4*)(ks + (ia + 32 * a) * 132 + c); qi[a] = *(const f32x4*)(qs + (ia + 32 * a) * 132 + c); }
#pragma unroll
            for (int bq = 0; bq < 4; ++bq) kj[bq] = *(const f32x4*)(ks + (jb + 16 * bq) * 132 + c);
#pragma unroll
            for (int a = 0; a < 2; ++a)
#pragma unroll
                for (int bq = 0; bq < 4; ++bq) {
                    akk[a][bq] += ki[a].x * kj[bq].x + ki[a].y * kj[bq].y + ki[a].z * kj[bq].z + ki[a].w * kj[bq].w;
                    aqk[a][bq] += qi[a].x * kj[bq].x + qi[a].y * kj[bq].y + qi[a].z * kj[bq].z + qi[a].w * kj[bq].w; }
        }
#pragma unroll
        for (int a = 0; a < 2; ++a)
#pragma unroll
            for (int bq = 0; bq < 4; ++bq) { KKm[(ia + 32 * a) * 65 + jb + 16 * bq] = akk[a][bq]; QKm[(ia + 32 * a) * 65 + jb + 16 * bq] = aqk[a][bq]; }
    }
    __syncthreads();
#pragma unroll 4
    for (int e = 0; e < 16; ++e) { const int idx = tid + 512 * e, d = idx >> 12, ip = (idx >> 6) & 63, jp = idx & 63;
        const int ri = d ? 63 - ip : ip, rj = d ? 63 - jp : jp;
        float v = 0.f;
        if (jp < ip) v = BETA[d * 64 + ip] * KKm[ri * 65 + rj] * expf(Gs[d * 64 + ip] - Gs[d * 64 + jp]);
        TI[d * 4352 + ip * 68 + jp] = v; }
    __syncthreads();
    if (wave < 2) {
        const int d = wave; float X[64];
        const float* Lb = TI + d * 4352;
#pragma unroll
        for (int i = 0; i < 64; ++i) {
            float acc = (i == lane) ? 1.f : 0.f;
#pragma unroll
            for (int j4 = 0; j4 < i; j4 += 4) {
                const f32x4 lv = *(const f32x4*)(Lb + i * 68 + j4);
                acc -= lv.x * X[j4];
                if (j4 + 1 < i) acc -= lv.y * X[j4 + 1];
                if (j4 + 2 < i) acc -= lv.z * X[j4 + 2];
                if (j4 + 3 < i) acc -= lv.w * X[j4 + 3];
            }
            X[i] = acc;
        }
        LDS_WAIT();
#pragma unroll
        for (int i = 0; i < 64; ++i) TI[d * 4352 + i * 68 + lane] = X[i];
    } else {
        const int t2 = tid - 128;
        for (int idx = t2; idx < 2048; idx += 384) {
            const int d = idx >> 10, ip = (idx >> 4) & 63, c8 = idx & 15, ri = d ? 63 - ip : ip; const float e = EG[d * 64 + ip];
            const f32x4 a = *(const f32x4*)(qs + ri * 132 + c8 * 8), bq = *(const f32x4*)(qs + ri * 132 + c8 * 8 + 4);
            *(v4u*)(GDP(d) + 8192 + ip * 128 + c8 * 8) = (v4u){pk2(a.x * e, a.y * e), pk2(a.z * e, a.w * e), pk2(bq.x * e, bq.y * e), pk2(bq.z * e, bq.w * e)};
        }
        for (int idx = t2; idx < 2048; idx += 384) {
            const int d = idx >> 10, c = (idx >> 3) & 127, i8 = idx & 7; const float gl = GL[d]; float v[8];
#pragma unroll
            for (int e = 0; e < 8; ++e) { const int ip = i8 * 8 + e, ri = d ? 63 - ip : ip; v[e] = ks[ri * 132 + c] * expf(gl - Gs[d * 64 + ip]); }
            *(v4u*)(GDP(d) + 16384 + c * 64 + i8 * 8) = (v4u){pk2(v[0], v[1]), pk2(v[2], v[3]), pk2(v[4], v[5]), pk2(v[6], v[7])};
        }
        for (int idx = t2; idx < 1024; idx += 384) {
            const int d = idx >> 9, ip = (idx >> 3) & 63, j8 = idx & 7, ri = d ? 63 - ip : ip; const float gi = Gs[d * 64 + ip]; float v[8];
#pragma unroll
            for (int e = 0; e < 8; ++e) { const int jp = j8 * 8 + e, rj = d ? 63 - jp : jp; v[e] = (jp <= ip) ? QKm[ri * 65 + rj] * expf(gi - Gs[d * 64 + jp]) : 0.f; }
            *(v4u*)(GDP(d) + 24576 + ip * 64 + j8 * 8) = (v4u){pk2(v[0], v[1]), pk2(v[2], v[3]), pk2(v[4], v[5]), pk2(v[6], v[7])};
        }
    }
    __syncthreads();
    {
        const int i = tid >> 3, c0 = (tid & 7) * 16, tk = t0 + i; const size_t prow = (size_t)(seg0 + tk) * PINP; const int col = 2048 + h * 128 + c0;
#pragma unroll
        for (int jj = 0; jj < 4; ++jj) {
            const f32x4 x0 = *(const f32x4*)(P + prow + col + 4 * jj);
            f32x4 xm = {0.f, 0.f, 0.f, 0.f}, xp = {0.f, 0.f, 0.f, 0.f};
            if (tk > 0) xm = *(const f32x4*)(P + prow - PINP + col + 4 * jj);
            if (tk < seglen - 1) xp = *(const f32x4*)(P + prow + PINP + col + 4 * jj);
            const f32x4 w0 = *(const f32x4*)(cw + col + 4 * jj), w1 = *(const f32x4*)(cw + 3072 + col + 4 * jj), w2 = *(const f32x4*)(cw + 6144 + col + 4 * jj);
            f32x4 t = xm * w0 + x0 * w1 + xp * w2;
            t.x = siluf_(t.x); t.y = siluf_(t.y); t.z = siluf_(t.z); t.w = siluf_(t.w);
            *(f32x4*)(qs + i * 132 + c0 + 4 * jj) = t;
        }
    }
    const int d5 = tid >> 8, tt = tid & 255, ig = d5 ? 15 - (tt >> 4) : (tt >> 4), cg = tt & 15, jmax = ig * 4 + 3;
#pragma unroll
    for (int pass = 0; pass < 2; ++pass) {
        if (pass == 1) __syncthreads();
        const float* src = pass ? qs : ks;
        f32x4 acc[4][2];
#pragma unroll
        for (int ii = 0; ii < 4; ++ii) { acc[ii][0] = (f32x4){0.f, 0.f, 0.f, 0.f}; acc[ii][1] = (f32x4){0.f, 0.f, 0.f, 0.f}; }
        for (int j = 0; j <= jmax; ++j) {
            const int rj = d5 ? 63 - j : j;
            const float cf = pass ? BETA[d5 * 64 + j] : BETA[d5 * 64 + j] * EG[d5 * 64 + j];
            const f32x4 k0 = *(const f32x4*)(src + rj * 132 + cg * 4), k1 = *(const f32x4*)(src + rj * 132 + 64 + cg * 4);
#pragma unroll
            for (int ii = 0; ii < 4; ++ii) { const float t = TI[d5 * 4352 + (ig * 4 + ii) * 68 + j] * cf; acc[ii][0] += t * k0; acc[ii][1] += t * k1; }
        }
        bf16* dst = GDP(d5) + (pass ? 28672 : 0);
#pragma unroll
        for (int ii = 0; ii < 4; ++ii) {
            *(v2u*)(dst + (ig * 4 + ii) * 128 + cg * 4) = (v2u){pk2(acc[ii][0].x, acc[ii][0].y), pk2(acc[ii][0].z, acc[ii][0].w)};
            *(v2u*)(dst + (ig * 4 + ii) * 128 + 64 + cg * 4) = (v2u){pk2(acc[ii][1].x, acc[ii][1].y), pk2(acc[ii][1].z, acc[ii][1].w)};
        }
    }
    __syncthreads();
}

__device__ __forceinline__ void rw_tok(int sf, int& prow, int& up, int& dn) {
    if (sf < TCTX) { prow = TLAT + sf; up = sf > 0 ? prow - 1 : -1; dn = sf < TCTX - 1 ? prow + 1 : -1; }
    else { const int j = sf - TCTX, r = j & 127, cc = j >> 7; prow = r * 64 + cc; up = r > 0 ? prow - 64 : -1; dn = r < 127 ? prow + 64 : -1; }
}
__device__ __forceinline__ float rw_shift(const float* P, const float* mu, int prow, int up, int dn, int col) {
    const float x = P[(size_t)prow * PINP + 4128 + col];
    const float u = up >= 0 ? P[(size_t)up * PINP + 4128 + col] : 0.f;
    const float dv = dn >= 0 ? P[(size_t)dn * PINP + 4128 + col] : 0.f;
    return x + mu[col] * (0.5f * (u + dv) - x);
}
__device__ __forceinline__ float fexp(float x) { return __expf(x); }
__device__ __forceinline__ float fsig(float x) { return __frcp_rn(1.f + __expf(-x)); }
#ifndef TSEL
#define TSEL -1
#endif
#define PSTAMP(i) do { if (TSEL >= 50 && probe && tid == 0) ((unsigned long long*)(p.ws + WS_BAR + 32768))[50 + (i)] = __builtin_amdgcn_s_memrealtime(); } while (0)
__device__ __forceinline__ void rwkv_prep_item(const Params& p, int l, int item, float* L, bool probe = false) {
    const int tid = otid(), lane = tid & 63, wave = tid >> 6, r = lane & 15, q = lane >> 4;
    const float* P = (const float*)(p.ws + WS_P);
    const float* mu = p.in[13] + (size_t)l * 3488;
    bf16* actb = (bf16*)L;
    int* tinfo = (int*)(L + 3392);
    const int sf0 = item * 16;
    PSTAMP(0);
    if (tid < 16) { int prow, up, dn; rw_tok(sf0 + tid, prow, up, dn); tinfo[tid * 4] = prow; tinfo[tid * 4 + 1] = up; tinfo[tid * 4 + 2] = dn; }
    __syncthreads();
#pragma unroll
    for (int i = 0; i < 13; ++i) { const int e = tid + 512 * i, t = e / 416, cc = e - t * 416;
        const int prow = tinfo[t * 4], up = tinfo[t * 4 + 1], dn = tinfo[t * 4 + 2];
        float v = rw_shift(P, mu, prow, up, dn, 3072 + cc);
        if (cc < 128) v = 1.f - 2.f * __frcp_rn(__expf(2.f * v) + 1.f); else if (cc >= 256) v = fsig(v);
        actb[t * 424 + cc] = (bf16)f2bf(v); }
    __syncthreads();
    PSTAMP(1);
    const int prow = tinfo[r * 4], up = tinfo[r * 4 + 1], dn = tinfo[r * 4 + 2], sf = sf0 + r;
    const int s1 = sf < TCTX ? TCTX - 1 - sf : 8703 - sf;
    const float mup = up >= 0 ? 0.5f : 0.f, mdn = dn >= 0 ? 0.5f : 0.f;
    const float* Pr = P + (size_t)prow * PINP + 4128; const float* Pu = P + (size_t)(up >= 0 ? up : prow) * PINP + 4128; const float* Pd = P + (size_t)(dn >= 0 ? dn : prow) * PINP + 4128;
    const bf16* Wsm = (const bf16*)(p.ws + WS_WSM) + (size_t)l * 1024 * 416;
    const float* w0p = p.in[14] + (size_t)l * 2048; const float* a0p = p.in[16] + (size_t)l * 2048;
    const float* k_k = p.in[19] + (size_t)l * 1024; const float* k_a = p.in[20] + (size_t)l * 1024; const float* r_k = p.in[21] + (size_t)l * 1024;
#pragma unroll 1
    for (int hi = 0; hi < 2; ++hi) {
        const int hh = wave * 2 + hi;
        f32x4 acc[4][5];
#pragma unroll
        for (int ct = 0; ct < 4; ++ct)
#pragma unroll
            for (int m = 0; m < 5; ++m) acc[ct][m] = (f32x4){0.f, 0.f, 0.f, 0.f};
#pragma unroll
        for (int kk = 0; kk < 13; ++kk) {
            const bf16x8 bfr = *(const bf16x8*)(actb + r * 424 + kk * 32 + 8 * q);
            constexpr int MAT[13] = {0, 0, 1, 1, 2, 2, 3, 3, 4, 4, 4, 4, 4};
#pragma unroll
            for (int ct = 0; ct < 4; ++ct) {
                const bf16x8 afr = *(const bf16x8*)(Wsm + (size_t)(hh * 64 + ct * 16 + r) * 416 + kk * 32 + 8 * q);
                acc[ct][MAT[kk]] = __builtin_amdgcn_mfma_f32_16x16x32_bf16(afr, bfr, acc[ct][MAT[kk]], 0, 0, 0);
            }
            if ((kk & 3) == 3) asm volatile("" ::: "memory");
        }
        if (hi == 0) PSTAMP(2);
        f32x4 kv[4], rv[4], vv[4]; float ss = 0.f;
#pragma unroll
        for (int ct = 0; ct < 4; ++ct) { const int c = hh * 64 + ct * 16 + 4 * q;
#pragma unroll
            for (int ten = 0; ten < 3; ++ten) { const int cc = ten * 1024 + c;
                const f32x4 x = *(const f32x4*)(Pr + cc), u = *(const f32x4*)(Pu + cc), dv = *(const f32x4*)(Pd + cc), m = *(const f32x4*)(mu + cc);
                const f32x4 y = x + m * (u * mup + dv * mdn - x);
                if (ten == 0) rv[ct] = y; else if (ten == 1) kv[ct] = y; else vv[ct] = y; }
            const f32x4 kkr = kv[ct] * *(const f32x4*)(k_k + c);
            ss += kkr.x * kkr.x + kkr.y * kkr.y + kkr.z * kkr.z + kkr.w * kkr.w;
            if (ct & 1) asm volatile("" ::: "memory"); }
        ss += __shfl_xor(ss, 16); ss += __shfl_xor(ss, 32);
        if (hi == 0) PSTAMP(3);
        const float rn = rsqrtf(ss + 1e-6f);
        unsigned char* rd0 = p.ws + WS_RWD + ((size_t)hh * TTOK + sf) * 512; unsigned char* rd1 = p.ws + WS_RWD + ((size_t)(16 + hh) * TTOK + s1) * 512;
        unsigned char* rs = p.ws + WS_RWS + ((size_t)hh * TTOK + sf) * 384;
        bf16* gt = (bf16*)(p.ws + WS_GATE) + (size_t)prow * 1024;
        float bon = 0.f;
#pragma unroll
        for (int ct = 0; ct < 4; ++ct) { const int c = hh * 64 + ct * 16 + 4 * q, co = ct * 16 + 4 * q;
            const f32x4 kkv = kv[ct] * *(const f32x4*)(k_k + c) * rn, ka = *(const f32x4*)(k_a + c), rk = *(const f32x4*)(r_k + c);
            f32x4 ksum = {0.f, 0.f, 0.f, 0.f};
#pragma unroll
            for (int d = 0; d < 2; ++d) {
                const f32x4 xw = *(const f32x4*)(w0p + d * 1024 + c) + acc[ct][d], xa = *(const f32x4*)(a0p + d * 1024 + c) + acc[ct][2 + d];
                f32x4 dec, kd, nk;
#pragma unroll
                for (int j = 0; j < 4; ++j) { const float y = -xw[j]; const float sp = y > 20.f ? y : __logf(1.f + __expf(y));
                    dec[j] = __expf(-__expf(-sp - 0.5f));
                    const float a = fsig(xa[j]); kd[j] = kv[ct][j] * (1.f + (a - 1.f) * ka[j]); nk[j] = -(kkv[j] * a); }
                ksum += kd;
                unsigned char* rd = d ? rd1 : rd0;
                *(f32x4*)(rd + co * 4) = dec;
                *(v2u*)(rd + 256 + co * 2) = (v2u){pk2(kd.x, kd.y), pk2(kd.z, kd.w)};
                *(v2u*)(rd + 384 + co * 2) = (v2u){pk2(nk.x, nk.y), pk2(nk.z, nk.w)};
            }
            const f32x4 bt = rv[ct] * ksum * rk; bon += (bt.x + bt.y) + (bt.z + bt.w);
            *(v2u*)(rs + co * 2) = (v2u){pk2(rv[ct].x, rv[ct].y), pk2(rv[ct].z, rv[ct].w)};
            *(v2u*)(rs + 128 + co * 2) = (v2u){pk2(kkv.x, kkv.y), pk2(kkv.z, kkv.w)};
            *(v2u*)(rs + 256 + co * 2) = (v2u){pk2(vv[ct].x, vv[ct].y), pk2(vv[ct].z, vv[ct].w)};
            *(v2u*)(gt + c) = (v2u){pk2(acc[ct][4].x, acc[ct][4].y), pk2(acc[ct][4].z, acc[ct][4].w)};
            asm volatile("" ::: "memory");
        }
        bon += __shfl_xor(bon, 16); bon += __shfl_xor(bon, 32);
        if (q == 0) ((float*)(p.ws + WS_BONUS))[prow * 16 + hh] = bon;
        if (hi == 0) PSTAMP(4);
    }
    PSTAMP(5);
    __syncthreads();
    PSTAMP(6);
}
#define LDS_BARRIER() do { asm volatile("s_waitcnt lgkmcnt(0)" ::: "memory"); __builtin_amdgcn_s_barrier(); asm volatile("" ::: "memory"); } while (0)
__device__ __forceinline__ f32x4 mfma16(bf16x8 a, bf16x8 b, f32x4 c) { return __builtin_amdgcn_mfma_f32_16x16x32_bf16(a, b, c, 0, 0, 0); }
__device__ __forceinline__ void gdn_scan(const Params& p, int b, unsigned char* lds) {
    const int tid = otid(), lane = tid & 63, wave = tid >> 6, r = lane & 15, q = lane >> 4;
    const int s = b & 3, h = (b >> 2) & 7, d = b >> 5;
    bf16* Wb = (bf16*)lds; bf16* Qb = Wb + 2 * 8704; bf16* KTb = Qb + 2 * 8704; bf16* Ab = KTb + 2 * 9216; bf16* Ub = Ab + 2 * 4608; bf16* ST = Ub + 2 * 2560; bf16* VT = ST + 4352;
    const bf16* G = (const bf16*)(p.ws + WS_GDN) + (size_t)((d * 8 + h) * 132) * 36864;
    const float* DLp = (const float*)(p.ws + WS_DL) + (d * 8 + h) * 132;
    float* O = (float*)(p.ws + WS_P) + (size_t)d * TTOK * 1024 + h * 128 + s * 32;
    for (int e = tid; e < 4352; e += NTHR) ST[e] = 0;
    f32x4 S0 = {0.f, 0.f, 0.f, 0.f}, S1 = {0.f, 0.f, 0.f, 0.f};
    v4u pw0, pw1, pq0, pq1, pk0, pk1, pa, pu;
    pu = (v4u){0u, 0u, 0u, 0u};
#define GDN_LOAD(n) do { const bf16* g_ = G + (size_t)(n) * 36864; \
        pw0 = *(const v4u*)(g_ + tid * 8); pw1 = *(const v4u*)(g_ + (tid + 512) * 8); \
        pq0 = *(const v4u*)(g_ + 8192 + tid * 8); pq1 = *(const v4u*)(g_ + 8192 + (tid + 512) * 8); \
        pk0 = *(const v4u*)(g_ + 16384 + tid * 8); pk1 = *(const v4u*)(g_ + 16384 + (tid + 512) * 8); \
        pa = *(const v4u*)(g_ + 24576 + tid * 8); \
        if (tid < 256) pu = *(const v4u*)(g_ + 28672 + (tid >> 2) * 128 + s * 32 + (tid & 3) * 8); } while (0)
#define GDN_STORE(bf) do { \
        *(v4u*)(Wb + (bf) * 8704 + (tid >> 4) * 136 + (tid & 15) * 8) = pw0; *(v4u*)(Wb + (bf) * 8704 + ((tid + 512) >> 4) * 136 + (tid & 15) * 8) = pw1; \
        *(v4u*)(Qb + (bf) * 8704 + (tid >> 4) * 136 + (tid & 15) * 8) = pq0; *(v4u*)(Qb + (bf) * 8704 + ((tid + 512) >> 4) * 136 + (tid & 15) * 8) = pq1; \
        *(v4u*)(KTb + (bf) * 9216 + (tid >> 3) * 72 + (tid & 7) * 8) = pk0; *(v4u*)(KTb + (bf) * 9216 + ((tid + 512) >> 3) * 72 + (tid & 7) * 8) = pk1; \
        *(v4u*)(Ab + (bf) * 4608 + (tid >> 3) * 72 + (tid & 7) * 8) = pa; \
        if (tid < 256) *(v4u*)(Ub + (bf) * 2560 + (tid >> 2) * 40 + (tid & 3) * 8) = pu; } while (0)
    GDN_LOAD(0); GDN_STORE(0);
    __syncthreads();
    const int mi = wave >> 1, nv = wave & 1;
    for (int n = 0; n < 132; ++n) {
        const int bf = n & 1;
        if (n + 1 < 132) GDN_LOAD(n + 1);
        const float dl = DLp[n];
        f32x4 co = {0.f, 0.f, 0.f, 0.f}, cv = {0.f, 0.f, 0.f, 0.f};
#pragma unroll
        for (int kk = 0; kk < 4; ++kk) {
            const bf16x8 sa = *(const bf16x8*)(ST + (16 * nv + r) * 136 + kk * 32 + 8 * q);
            const bf16x8 qa = *(const bf16x8*)(Qb + bf * 8704 + (16 * mi + r) * 136 + kk * 32 + 8 * q);
            const bf16x8 wb = *(const bf16x8*)(Wb + bf * 8704 + (16 * mi + r) * 136 + kk * 32 + 8 * q);
            co = mfma16(qa, sa, co);
            cv = mfma16(sa, wb, cv);
        }
        {
            const v2u uu = *(const v2u*)(Ub + bf * 2560 + (16 * mi + r) * 40 + 16 * nv + 4 * q);
            const float v0 = bflo(uu.x) - cv.x, v1 = bfhi(uu.x) - cv.y, v2 = bflo(uu.y) - cv.z, v3 = bfhi(uu.y) - cv.w;
            bf16* vt = VT + (16 * nv + 4 * q) * 72 + 16 * mi + r;
            vt[0] = (bf16)f2bf(v0); vt[72] = (bf16)f2bf(v1); vt[144] = (bf16)f2bf(v2); vt[216] = (bf16)f2bf(v3);
        }
        LDS_BARRIER();
#pragma unroll
        for (int kk = 0; kk < 2; ++kk) {
            const bf16x8 aa = *(const bf16x8*)(Ab + bf * 4608 + (16 * mi + r) * 72 + kk * 32 + 8 * q);
            const bf16x8 vb = *(const bf16x8*)(VT + (16 * nv + r) * 72 + kk * 32 + 8 * q);
            co = mfma16(aa, vb, co);
        }
        {
            const bool cx = n < 4;
#pragma unroll
            for (int j = 0; j < 4; ++j) { const int ip = 16 * mi + 4 * q + j;
                const int tok = d == 0 ? (cx ? TLAT + n * 64 + ip : (n - 4) * 64 + ip) : (cx ? TLAT + (3 - n) * 64 + 63 - ip : (131 - n) * 64 + 63 - ip);
                O[(size_t)tok * 1024 + 16 * nv + r] = co[j]; }
        }
#pragma unroll
        for (int e = 0; e < 2; ++e) {
            f32x4 Sv = (e ? S1 : S0) * dl; const int nk = 2 * mi + e;
#pragma unroll
            for (int kk = 0; kk < 2; ++kk) {
                const bf16x8 va = *(const bf16x8*)(VT + (16 * nv + r) * 72 + kk * 32 + 8 * q);
                const bf16x8 kb = *(const bf16x8*)(KTb + bf * 9216 + (16 * nk + r) * 72 + kk * 32 + 8 * q);
                Sv = mfma16(va, kb, Sv);
            }
            if (e) S1 = Sv; else S0 = Sv;
            bf16* st = ST + (16 * nv + 4 * q) * 136 + 16 * nk + r;
            st[0] = (bf16)f2bf(Sv.x); st[136] = (bf16)f2bf(Sv.y); st[272] = (bf16)f2bf(Sv.z); st[408] = (bf16)f2bf(Sv.w);
        }
        if (n + 1 < 132) GDN_STORE(bf ^ 1);
        LDS_BARRIER();
    }
}
__device__ __forceinline__ float red16(float x) {
    x += __builtin_bit_cast(float, __builtin_amdgcn_update_dpp(0, __builtin_bit_cast(int, x), 0x128, 0xf, 0xf, false));
    x += __builtin_bit_cast(float, __builtin_amdgcn_update_dpp(0, __builtin_bit_cast(int, x), 0x124, 0xf, 0xf, false));
    x += __builtin_bit_cast(float, __builtin_amdgcn_update_dpp(0, __builtin_bit_cast(int, x), 0x122, 0xf, 0xf, false));
    x += __builtin_bit_cast(float, __builtin_amdgcn_update_dpp(0, __builtin_bit_cast(int, x), 0x121, 0xf, 0xf, false));
    return x;
}
__device__ __forceinline__ void rwkv_compute_chunk(const float* buf, float* opb, int rl, int kg, f32x4& S) {
    constexpr int TB = 32, SF = 336;
    const float* sp = buf + 4 * kg; const float* vp = buf + 320 + rl; float* op = opb + rl * 16 + kg;
    f32x4 w = *(const f32x4*)sp, kd = *(const f32x4*)(sp + 64), nk = *(const f32x4*)(sp + 128), rr = *(const f32x4*)(sp + 192), kk = *(const f32x4*)(sp + 256);
    float v = vp[0];
#pragma unroll 4
    for (int st = 0; st < TB; ++st) {
        const int sn = st < TB - 1 ? st + 1 : st;
        const f32x4 w_n = *(const f32x4*)(sp + sn * SF), kd_n = *(const f32x4*)(sp + sn * SF + 64), nk_n = *(const f32x4*)(sp + sn * SF + 128),
                    rr_n = *(const f32x4*)(sp + sn * SF + 192), kk_n = *(const f32x4*)(sp + sn * SF + 256);
        const float v_n = vp[sn * SF];
        f32x2 d2 = (f32x2){S.x, S.y} * (f32x2){kk.x, kk.y};
        d2 = (f32x2){S.z, S.w} * (f32x2){kk.z, kk.w} + d2;
        const float dot = red16(d2.x + d2.y);
        S = S * w + v * kd + dot * nk;
        f32x2 o2 = (f32x2){S.x, S.y} * (f32x2){rr.x, rr.y};
        o2 = (f32x2){S.z, S.w} * (f32x2){rr.z, rr.w} + o2;
        op[st * 256] = o2.x + o2.y;
        w = w_n; kd = kd_n; nk = nk_n; rr = rr_n; kk = kk_n; v = v_n;
    }
}
__device__ __forceinline__ void rwkv_scan(const Params& p, int b, float* L) {
    const int tid = otid(), lane = tid & 63, wave = tid >> 6;
    const int pair = b >> 2, qt = b & 3, d = pair >> 4, h = pair & 15;
    const unsigned char* RD = p.ws + WS_RWD + (size_t)(d * 16 + h) * TTOK * 512;
    const unsigned char* RS = p.ws + WS_RWS + (size_t)h * TTOK * 384;
    float* O = (float*)(p.ws + WS_P) + (size_t)(2 + d) * TTOK * 1024 + h * 64 + qt * 16;
    constexpr int TB = 32, SF = 336, NCH = TTOK / TB;
    float* OP = L + 2 * TB * SF;
    const int rl = (wave & 3) * 4 + (lane >> 4), kg = lane & 15;
    const int lt = tid - 256;
    float* const dummy = L + 2 * TB * SF + 2 * TB * 256;
    int so[7], dofA[7], dofB[7]; bool isd[7];
#pragma unroll
    for (int i = 0; i < 7; ++i) { const int u = lt + 256 * i, st = u / 50, x = u % 50, sg = d ? -st : st; const bool valid = u < TB * 50;
        so[i] = !valid ? 0 : (x < 32 ? st * 512 + x * 16 : (x < 48 ? sg * 384 + (x - 32) * 16 : sg * 384 + 256 + qt * 32 + (x - 48) * 16));
        isd[i] = !valid || x < 32;
        const int base = st * SF + (x < 16 ? x * 4 : (x < 32 ? 64 + (x - 16) * 8 : (x < 48 ? 192 + (x - 32) * 8 : 320 + (x - 48) * 8)));
        dofA[i] = valid ? base : -1;
        dofB[i] = (valid && x >= 16) ? base + 4 : -1; }
    v4u ldA[7], ldB[7];
#define RW_LOADSET(ld, cc_) do { const int c_ = (cc_) < NCH ? (cc_) : NCH - 1; const unsigned char* rdb = RD + (size_t)c_ * (TB * 512); \
        const int sfb = d == 0 ? c_ * TB : (c_ < 8 ? TCTX - 1 - c_ * TB : 8703 - c_ * TB); const unsigned char* rsb = RS + (size_t)sfb * 384; \
        _Pragma("unroll") for (int i = 0; i < 7; ++i) ld[i] = *(const v4u*)((isd[i] ? rdb : rsb) + so[i]); } while (0)
#define RW_STORESET(ld, cc_) do { const bool live = (cc_) < NCH; float* buf = L + ((cc_) & 1) * (TB * SF); \
        _Pragma("unroll") for (int i = 0; i < 7; ++i) { const v4u v = ld[i]; const bool f32u = dofB[i] < 0; \
            float* d0 = (live && dofA[i] >= 0) ? buf + dofA[i] : dummy; float* d1 = (live && dofB[i] >= 0) ? buf + dofB[i] : dummy; \
            const f32x4 lo = {bflo(v.x), bfhi(v.x), bflo(v.y), bfhi(v.y)}, hi = {bflo(v.z), bfhi(v.z), bflo(v.w), bfhi(v.w)}; \
            *(f32x4*)d0 = f32u ? __builtin_bit_cast(f32x4, v) : lo; *(f32x4*)d1 = hi; } } while (0)
#define RW_ITER(c, LSET, SSET) do { \
        if (wave >= 4) { \
            RW_LOADSET(LSET, (c) + 2); \
            {     \
                const int cm = (c) >= 1 ? (c) - 1 : 0; const float* op = OP + (cm & 1) * (TB * 256); \
                const int st = lt >> 3, r2 = (lt & 7) * 2, s = cm * TB + st; float o[2]; \
                _Pragma("unroll") for (int e = 0; e < 2; ++e) { const float* q = op + st * 256 + (r2 + e) * 16; \
                    const f32x4 a = *(const f32x4*)q, bq = *(const f32x4*)(q + 4), cq = *(const f32x4*)(q + 8), dq = *(const f32x4*)(q + 12); \
                    o[e] = ((a.x + a.y) + (a.z + a.w)) + ((bq.x + bq.y) + (bq.z + bq.w)) + ((cq.x + cq.y) + (cq.z + cq.w)) + ((dq.x + dq.y) + (dq.z + dq.w)); } \
                const int j = s < TCTX ? 0 : (d ? 8447 - s : s - TCTX); \
                const int tok = s < TCTX ? TLAT + (d ? TCTX - 1 - s : s) : (j & 127) * 64 + (j >> 7); \
                *(f32x2*)(O + (size_t)tok * 1024 + r2) = (f32x2){o[0], o[1]}; } \
            RW_STORESET(SSET, (c) + 1); \
        } else if ((c) >= 0 && (c) < NCH) { rwkv_compute_chunk(L + ((c) & 1) * (TB * SF), OP + ((c) & 1) * (TB * 256), rl, kg, S); } \
        LDS_BARRIER(); } while (0)
    f32x4 S = {0.f, 0.f, 0.f, 0.f};
    if (wave >= 4) RW_LOADSET(ldA, 0);
    for (int c = -1; c <= NCH; c += 2) { RW_ITER(c, ldB, ldA); RW_ITER(c + 1, ldA, ldB); }
    __syncthreads();
}

#define DPP_ADD(x, CTRL) ((x) + __builtin_bit_cast(float, __builtin_amdgcn_update_dpp(0, __builtin_bit_cast(int, (x)), (CTRL), 0xf, 0xf, false)))
__device__ __forceinline__ void combine_phase(const Params& p, int l, int ntok) {
    const int tid = otid(), lane = tid & 63, gw = blockIdx.x * 8 + (tid >> 6), ngw = gridDim.x * 8;
    const float* OG = (const float*)(p.ws + WS_P); const float* OR = OG + (size_t)2 * TTOK * 1024;
    const bf16* SZ = (const bf16*)(p.ws + WS_SZ); const bf16* GT = (const bf16*)(p.ws + WS_GATE);
    const float* BON = (const float*)(p.ws + WS_BONUS);
    bf16* Y = (bf16*)(p.ws + WS_H);
    const int c0 = lane * 16, hr = lane >> 2;
    f32x4 ng[4], lg[4], lb[4];
#pragma unroll
    for (int e = 0; e < 4; ++e) { ng[e] = *(const f32x4*)(p.in[12] + (size_t)l * 128 + (lane & 7) * 16 + 4 * e);
        lg[e] = *(const f32x4*)(p.in[22] + (size_t)l * 1024 + c0 + 4 * e); lb[e] = *(const f32x4*)(p.in[23] + (size_t)l * 1024 + c0 + 4 * e); }
    for (int tok = gw; tok < ntok; tok += ngw) {
        const int sf = tok >= TLAT ? tok - TLAT : TCTX + (tok & 63) * 128 + (tok >> 6);
        const float* of = OG + (size_t)tok * 1024 + c0; const float* ob = of + (size_t)TTOK * 1024;
        const float* rf = OR + (size_t)tok * 1024 + c0; const float* rb = rf + (size_t)TTOK * 1024;
        f32x4 a[4], o[4];
#pragma unroll
        for (int e = 0; e < 4; ++e) { a[e] = *(const f32x4*)(of + 4 * e) + *(const f32x4*)(ob + 4 * e); o[e] = *(const f32x4*)(rf + 4 * e) + *(const f32x4*)(rb + 4 * e); }
        const v4u sz0 = *(const v4u*)(SZ + (size_t)tok * 1024 + c0), sz1 = *(const v4u*)(SZ + (size_t)tok * 1024 + c0 + 8);
        const v4u gt0 = *(const v4u*)(GT + (size_t)tok * 1024 + c0), gt1 = *(const v4u*)(GT + (size_t)tok * 1024 + c0 + 8);
        const unsigned char* vrec = p.ws + WS_RWS + ((size_t)hr * TTOK + sf) * 384 + 256 + (lane & 3) * 32;
        const v4u vv0 = *(const v4u*)vrec, vv1 = *(const v4u*)(vrec + 16);
        const float bonus = BON[tok * 16 + hr];
        float ss = 0.f;
#pragma unroll
        for (int e = 0; e < 4; ++e) ss += a[e].x * a[e].x + a[e].y * a[e].y + a[e].z * a[e].z + a[e].w * a[e].w;
        ss = DPP_ADD(ss, 0xB1); ss = DPP_ADD(ss, 0x4E); ss = DPP_ADD(ss, 0x141);
        const float rstd = rsqrtf(ss * (1.f / 128.f) + 1e-6f);
        const unsigned szw[8] = {sz0.x, sz0.y, sz0.z, sz0.w, sz1.x, sz1.y, sz1.z, sz1.w};
        unsigned yo[8];
#pragma unroll
        for (int e = 0; e < 4; ++e) { const f32x4 y = a[e] * rstd * ng[e];
            yo[2 * e] = pk2(y.x * bflo(szw[2 * e]), y.y * bfhi(szw[2 * e])); yo[2 * e + 1] = pk2(y.z * bflo(szw[2 * e + 1]), y.w * bfhi(szw[2 * e + 1])); }
        *(v4u*)(Y + (size_t)tok * 2048 + c0) = (v4u){yo[0], yo[1], yo[2], yo[3]}; *(v4u*)(Y + (size_t)tok * 2048 + c0 + 8) = (v4u){yo[4], yo[5], yo[6], yo[7]};
        float sm = 0.f;
#pragma unroll
        for (int e = 0; e < 4; ++e) sm += (o[e].x + o[e].y) + (o[e].z + o[e].w);
        sm = DPP_ADD(sm, 0xB1); sm = DPP_ADD(sm, 0x4E);
        const float mean = sm * (1.f / 64.f); float sv = 0.f;
#pragma unroll
        for (int e = 0; e < 4; ++e) { o[e] = o[e] - mean; sv += o[e].x * o[e].x + o[e].y * o[e].y + o[e].z * o[e].z + o[e].w * o[e].w; }
        sv = DPP_ADD(sv, 0xB1); sv = DPP_ADD(sv, 0x4E);
        const float rs2 = rsqrtf(sv * (1.f / 64.f) + 64e-5f);
        const unsigned vw[8] = {vv0.x, vv0.y, vv0.z, vv0.w, vv1.x, vv1.y, vv1.z, vv1.w}, gw8[8] = {gt0.x, gt0.y, gt0.z, gt0.w, gt1.x, gt1.y, gt1.z, gt1.w};
#pragma unroll
        for (int e = 0; e < 4; ++e) { const f32x4 y = o[e] * rs2 * lg[e] + lb[e];
            yo[2 * e] = pk2((y.x + bonus * bflo(vw[2 * e])) * bflo(gw8[2 * e]), (y.y + bonus * bfhi(vw[2 * e])) * bfhi(gw8[2 * e]));
            yo[2 * e + 1] = pk2((y.z + bonus * bflo(vw[2 * e + 1])) * bflo(gw8[2 * e + 1]), (y.w + bonus * bfhi(vw[2 * e + 1])) * bfhi(gw8[2 * e + 1])); }
        *(v4u*)(Y + (size_t)tok * 2048 + 1024 + c0) = (v4u){yo[0], yo[1], yo[2], yo[3]}; *(v4u*)(Y + (size_t)tok * 2048 + 1024 + c0 + 8) = (v4u){yo[4], yo[5], yo[6], yo[7]};
    }
}
#ifndef ONE_LAUNCH
#define ONE_LAUNCH 1
#endif
constexpr int N_PHASES = 20;
#if ONE_LAUNCH
#define PH(k) (true)
#ifndef TSEL
#define TSEL -1
#endif
#ifndef TSCALE
#define TSCALE 0.0003f
#endif
#define STAMP(k) do { if (TSEL >= 0 && blockIdx.x == 0 && threadIdx.x == 0) ((unsigned long long*)(p.ws + WS_BAR + 32768))[(k)] = __builtin_amdgcn_s_memrealtime(); } while (0)
#define SEAM(k) do { xcd_barrier(gbar); STAMP((k) + 1); } while (0)
#else
#define PH(k) (p.ph_lo == (k))
#define SEAM(k) do {} while (0)
#endif
#define PHON(k) ((PHMASK >> (k)) & 1)
#ifndef DUPMASK
#define DUPMASK 0
#endif
#define REP(k) for (int rep_ = 0; rep_ <= ((DUPMASK >> (k)) & 1); ++rep_) if (rep_ == 0 || (cg::this_grid().sync(), true))
template <int PHMASK, int l> __device__ __forceinline__ void layer_phases(const Params& p, unsigned char* lds, const XcdBarrier& gbar) {
    float* L = (float*)lds;
    const int b = blockIdx.x, G = gridDim.x;
    float* lat_c = (float*)(p.ws + WS_LATC);
    const float* mod = (const float*)(p.ws + WS_MOD);
    constexpr int M = l == 0 ? TTOK : TLAT;
    constexpr int B0 = 1 + 9 * l;
    const float* res_l = l == 0 ? p.in[0] : p.out; const float* res_c = l == 0 ? p.in[2] : lat_c;
    const float* mod_l = mod + (size_t)(l * 2) * 12288; const float* mod_c = mod_l + 12288;
    REP(0) if (PH(B0 + 0) && PHON(0)) {
        norm_phase(p, l, res_l, res_c, p.in[6] + (size_t)l * DM, 0, 1, TTOK);
    }
    SEAM(B0 + 0);
    REP(1) if (PH(B0 + 1) && PHON(1)) {
        pg8::Gemm g{(const pg8::bf16_t*)(p.ws + WS_H), (const pg8::bf16_t*)(p.ws + WS_WT_IN), TTOK, PINP, DM, DM}; pg8::StaticOrder S; S.init(TTOK, PINP, G, b);
        pg8::EpiF32 E{(float*)(p.ws + WS_P), PINP};
        pg8::gemm_phase<pg8::EpiF32, pg8::StaticOrder, true, true>((PG8_LAS unsigned char*)lds, g, S, E);
    }
    SEAM(B0 + 1);
    REP(2) if (PH(B0 + 2)) {
#if ONE_LAUNCH
        {
            unsigned* qctr = (unsigned*)(p.ws + WS_BAR + 16384) + l * 64;
            volatile LAS unsigned* qslot = (volatile LAS unsigned*)((LAS unsigned char*)lds + LDS_BYTES - 8);
            bool rwfirst_ = true;
            for (;;) {
                if (threadIdx.x == 0) *qslot = atomicAdd(qctr, 1u);
                __syncthreads();
                const unsigned it = *qslot;
                __syncthreads();
                if (it >= 1584u) break;
                unsigned long long t0_ = 0; if (TSEL >= 44) t0_ = __builtin_amdgcn_s_memrealtime();
                if (it < 528u) rwkv_prep_item(p, l, (int)it, L, TSEL >= 50 && l == 0 && blockIdx.x == 0 && rwfirst_); else gdn_prep_item(p, l, (int)it - 528, L);
                if (it < 528u) rwfirst_ = false;
                if (TSEL >= 44 && l == 0 && blockIdx.x == 0 && threadIdx.x == 0) { unsigned long long* ts = (unsigned long long*)(p.ws + WS_BAR + 32768); const int sl_ = it < 528u ? 44 : 45;
                    if (ts[sl_ + 4] != 0x5151ull) { ts[sl_ + 4] = 0x5151ull; ts[sl_] = __builtin_amdgcn_s_memrealtime() - t0_; } }
            }
        }
#else
        if (PHON(2)) for (int it = b; it < 528; it += G) rwkv_prep_item(p, l, it, L);
        if (PHON(11)) for (int it = b; it < 1056; it += G) gdn_prep_item(p, l, it, L);
#endif
    }
    SEAM(B0 + 2);
    REP(3) if (PH(B0 + 3) && PHON(3)) {
        if (b < 64) for (int r2_ = 0; r2_ <= ((DUPMASK >> 12) & 1); ++r2_) { if (r2_) __syncthreads(); gdn_scan(p, b, lds); }
        if (b >= 64 && b < 192) for (int r2_ = 0; r2_ <= ((DUPMASK >> 13) & 1); ++r2_) rwkv_scan(p, b - 64, L);
        if (b >= 192) { const int tid = otid(), gw = (b - 192) * 8 + (tid >> 6), ngw = (G - 192) * 8;
            if (l == 0) { convert_weights(p, 0, 14, gw, ngw, L + (tid >> 6) * 2112, tid & 63); convert_weights(p, 1, 1, gw, ngw, L + (tid >> 6) * 2112, tid & 63); }
            else convert_weights(p, 1, 14, gw, ngw, L + (tid >> 6) * 2112, tid & 63); }
    }
    if (l == 0 && (b == 0 || b == 64 || b == 192)) { __syncthreads(); if (TSEL >= 0 && threadIdx.x == 0) ((unsigned long long*)(p.ws + WS_BAR + 32768))[40 + (b >> 6)] = __builtin_amdgcn_s_memrealtime(); }
    SEAM(B0 + 3);
    REP(4) if (PH(B0 + 4) && PHON(4)) combine_phase(p, l, M);
    SEAM(B0 + 4);
    REP(5) if (PH(B0 + 5) && PHON(5)) {
        pg8::Gemm g{(const pg8::bf16_t*)(p.ws + WS_H), (const pg8::bf16_t*)(p.ws + WS_WT_OUT), TLAT, DM, DM, DM}; pg8::StaticOrder S; S.init(TLAT, DM, G, b);
        pg8::EpiRes E{res_l, res_c, p.out, lat_c, mod_l + 2 * DM, mod_c + 2 * DM};
        pg8::gemm_phase<pg8::EpiRes, pg8::StaticOrder, true, true>((PG8_LAS unsigned char*)lds, g, S, E);
        if (l == 0) {
            pg8::Gemm gc{(const pg8::bf16_t*)(p.ws + WS_H) + (size_t)TLAT * DM, (const pg8::bf16_t*)(p.ws + WS_WT_OUT), TCTX, DM, 1024, DM}; pg8::SplitKOrder Sc; Sc.init(DM, 2, 1024, G, b, 0);
            pg8::EpiAtomic Ec{lat_c, mod_c + 2 * DM};
            pg8::gemm_phase<pg8::EpiAtomic, pg8::SplitKOrder, true, true>((PG8_LAS unsigned char*)lds, gc, Sc, Ec); }
    }
    SEAM(B0 + 5);
    REP(6) if (PH(B0 + 6) && PHON(6)) norm_phase(p, l, p.out, lat_c, p.in[7] + (size_t)l * DM, 3, 4, M);
    SEAM(B0 + 6);
    REP(7) if (PH(B0 + 7) && PHON(7)) {
        pg8::Gemm g{(const pg8::bf16_t*)(p.ws + WS_H), (const pg8::bf16_t*)(p.ws + WS_WT_1), M, DFF, DM, DM}; pg8::StaticOrder S; S.init(M, DFF, G, b);
        pg8::EpiRelu2 E{(pg8::bf16_t*)(p.ws + WS_P), DFF};
        pg8::gemm_phase<pg8::EpiRelu2, pg8::StaticOrder, true, true>((PG8_LAS unsigned char*)lds, g, S, E);
    }
    SEAM(B0 + 7);
    REP(8) if (PH(B0 + 8) && PHON(8)) {
        pg8::Gemm g{(const pg8::bf16_t*)(p.ws + WS_P), (const pg8::bf16_t*)(p.ws + WS_WT_2), TLAT, DM, DFF, DFF}; pg8::StaticOrder S; S.init(TLAT, DM, G, b);
        pg8::EpiRes E{p.out, lat_c, p.out, lat_c, mod_l + 5 * DM, mod_c + 5 * DM};
        pg8::gemm_phase<pg8::EpiRes, pg8::StaticOrder, true, true>((PG8_LAS unsigned char*)lds, g, S, E);
        if (l == 0) {
            pg8::Gemm gc{(const pg8::bf16_t*)(p.ws + WS_P) + (size_t)TLAT * DFF, (const pg8::bf16_t*)(p.ws + WS_WT_2), TCTX, DM, 2048, DFF}; pg8::SplitKOrder Sc; Sc.init(DM, 4, 2048, G, b, 0);
            pg8::EpiAtomic Ec{lat_c, mod_c + 5 * DM};
            pg8::gemm_phase<pg8::EpiAtomic, pg8::SplitKOrder, true, true>((PG8_LAS unsigned char*)lds, gc, Sc, Ec); }
    }
    SEAM(B0 + 8);
}
template <int PHMASK> __global__ void __launch_bounds__(NTHR) fwd_megakernel(Params p) {
    extern __shared__ __attribute__((aligned(16))) unsigned char lds[];
    volatile LAS unsigned* bst = (volatile LAS unsigned*)((LAS unsigned char*)lds + LDS_BYTES - 16);
    if (threadIdx.x < 4) bst[threadIdx.x] = 0u;
    __syncthreads();
    XcdBarrier gbar; gbar.bar = (unsigned*)(p.ws + WS_BAR); gbar.x = 0; gbar.st = bst;
#if ONE_LAUNCH
    gbar = xcd_barrier_post((unsigned*)(p.ws + WS_BAR), bst);
#endif
    STAMP(0);
    REP(9) if (PH(0) && PHON(9)) phase0(p, (float*)lds);
#if ONE_LAUNCH
    cg::this_grid().sync(); STAMP(1);
#endif
    layer_phases<PHMASK, 0>(p, lds, gbar);
    layer_phases<PHMASK, 1>(p, lds, gbar);
    if (PH(19) && PHON(10)) final_norm(p);
    if (TSEL >= 0) { STAMP(20); if (blockIdx.x == 0 && threadIdx.x == 0) { const unsigned long long* ts = (const unsigned long long*)(p.ws + WS_BAR + 32768); __threadfence(); p.out[0] = (float)(TSEL >= 50 ? ts[TSEL] - ts[50] : TSEL >= 44 ? ts[TSEL] : (TSEL >= 40 ? ts[TSEL] - ts[4] : ts[TSEL + 1] - ts[TSEL])) * TSCALE; } }
}

extern "C" void kernel_launch(void* const* d_in, const int* in_sizes, int n_in, void* d_out, int out_size, void* d_ws, size_t ws_size, hipStream_t stream) {
    static int grid = 0;
    if (grid == 0) {
        if (n_in != 28 || ws_size < WS_END) { fprintf(stderr, "kernel_launch: need 28 inputs and %zu bytes of workspace (got %d, %zu)\n", (size_t)WS_END, n_in, ws_size); grid = -1; return; }
        int dev = 0, cus = 0, per_cu = 0;
        (void)hipGetDevice(&dev); (void)hipDeviceGetAttribute(&cus, hipDeviceAttributeMultiprocessorCount, dev);
#if ONE_LAUNCH
        (void)hipFuncSetAttribute((const void*)fwd_megakernel<0xFFFF>, hipFuncAttributeMaxDynamicSharedMemorySize, LDS_BYTES);
        (void)hipOccupancyMaxActiveBlocksPerMultiprocessor(&per_cu, (const void*)fwd_megakernel<0xFFFF>, NTHR, LDS_BYTES);
#else
#define SETATTR(K) (void)hipFuncSetAttribute((const void*)fwd_megakernel<(1 << K)>, hipFuncAttributeMaxDynamicSharedMemorySize, LDS_BYTES)
        SETATTR(0); SETATTR(1); SETATTR(2); SETATTR(3); SETATTR(4); SETATTR(5); SETATTR(6); SETATTR(7); SETATTR(8); SETATTR(9); SETATTR(10); SETATTR(11);
        per_cu = 1;
#endif
        if (per_cu < 1) { fprintf(stderr, "kernel_launch: occupancy query says %d blocks per CU\n", per_cu); grid = -1; return; }
        grid = cus;
        (void)hipGetLastError();
    }
    if (grid < 0) return;
    (void)hipMemsetAsync((char*)d_ws + WS_MOD, 0, 4 * 12288 * 4, stream);
    (void)hipMemsetAsync((char*)d_ws + WS_BAR, 0, 16384 + 1024, stream);
    Params p{};
    for (int i = 0; i < 28; ++i) p.in[i] = (const float*)d_in[i];
    p.out = (float*)d_out; p.ws = (unsigned char*)d_ws;
#if ONE_LAUNCH
    p.ph_lo = 0; p.ph_hi = N_PHASES;
    void* args[] = {&p};
    hipError_t e = hipLaunchCooperativeKernel((const void*)fwd_megakernel<0xFFFF>, dim3(grid), dim3(NTHR), args, LDS_BYTES, stream);
    if (e != hipSuccess) fprintf(stderr, "cooperative launch failed: %s (grid %d)\n", hipGetErrorString(e), grid);
#else
#define LAUNCH1(K) hipLaunchKernelGGL(fwd_megakernel<(1 << K)>, dim3(grid), dim3(NTHR), LDS_BYTES, stream, p)
    for (int ph = 0; ph < N_PHASES; ++ph) { p.ph_lo = ph; p.ph_hi = ph + 1;
        if (ph == 0) { LAUNCH1(9); continue; }
        if (ph == 19) { LAUNCH1(10); continue; }
        switch ((ph - 1) % 9) {
        case 0: LAUNCH1(0); break; case 1: LAUNCH1(1); break; case 2: LAUNCH1(2); LAUNCH1(11); break; case 3: LAUNCH1(3); break; case 4: LAUNCH1(4); break;
        case 5: LAUNCH1(5); break; case 6: LAUNCH1(6); break; case 7: LAUNCH1(7); break; case 8: LAUNCH1(8); break; }
    }
#endif
}
```

```cpp
#include <hip/hip_runtime.h>
#include <hip/hip_cooperative_groups.h>
#include <cstdio>
#include <cstdint>
namespace cg = cooperative_groups;
__device__ __forceinline__ int otid() { int t = threadIdx.x; asm volatile("" : "+v"(t)); return t; }
namespace pg8 {
#define PG8_LAS __attribute__((address_space(3)))
typedef unsigned short bf16_t;
typedef short bf16x8 __attribute__((ext_vector_type(8)));
typedef float f32x4 __attribute__((ext_vector_type(4)));
typedef unsigned u32x4 __attribute__((ext_vector_type(4)));
constexpr int BM = 256, BK = 64, HALF = 128, HTB = HALF * BK * 2  , STAGE_BYTES = 8 * HTB, NXCD = 8, WGM = 8;

__host__ __device__ __forceinline__ int lds_byte(int r, int c) { const int st = (r >> 4) * 2 + (c >> 5), rr = r & 15, cc = c & 31, ob = rr * 64 + cc * 2; return st * 1024 + (ob ^ (((ob >> 9) & 1) << 5)); }
__host__ __device__ __forceinline__ void stage_rc(int b, int& R, int& C) { const int st = b / 1024, sb = b % 1024, swz = sb ^ (((sb >> 9) & 1) << 5); R = (st >> 1) * 16 + swz / 64; C = (st & 1) * 32 + (swz % 64) / 2; }
__host__ __device__ __forceinline__ int perm32(int rho) { const int n = rho >> 4, i = rho & 15; return 8 * (i >> 2) + 4 * n + (i & 3); }

struct Unit { int pm, pn, ko; };
struct Gemm { const bf16_t* A; const bf16_t* Bt; int M, N, K, ldk; };

struct StaticOrder {
    int nM, nN, nwg, G, c;
    __host__ __device__ void init(int M, int N, int G_, int c_) { nM = M / BM; nN = N / BM; nwg = nM * nN; G = G_; c = c_; }
    __host__ __device__ bool next(int i, Unit& u) const {
        const long L = (long)i * G + c; if (L >= nwg) return false;
        int wgid = (int)L; { const int q = nwg / NXCD, r = nwg % NXCD, xcd = wgid % NXCD, off = wgid / NXCD; wgid = (xcd < r ? xcd * (q + 1) : r * (q + 1) + (xcd - r) * q) + off; }
        const int nig = WGM * nN, gid = wgid / nig, fm = gid * WGM, gsz = (nM - fm) < WGM ? (nM - fm) : WGM;
        u.pm = fm + ((wgid % nig) % gsz); u.pn = (wgid % nig) / gsz; u.ko = 0; return true;
    }
    __device__ __forceinline__ void a_ready(const Unit&) const {}
    __device__ __forceinline__ void done(const Unit&) const {}
};


struct SplitKOrder {
    int nN, S, Kc, G, c, pm;
    __host__ __device__ void init(int N, int S_, int Kc_, int G_, int c_, int pm_) { nN = N / BM; S = S_; Kc = Kc_; G = G_; c = c_; pm = pm_; }
    __host__ __device__ bool next(int i, Unit& u) const { const long L = (long)i * G + c; if (L >= (long)nN * S) return false; u.pm = pm; u.pn = (int)L / S; u.ko = ((int)L % S) * Kc; return true; }
    __device__ __forceinline__ void a_ready(const Unit&) const {}
    __device__ __forceinline__ void done(const Unit&) const {}
};
__device__ __forceinline__ unsigned cvt_pk_bf16(float lo, float hi) { unsigned r; asm volatile("v_cvt_pk_bf16_f32 %0, %1, %2" : "=v"(r) : "v"(lo), "v"(hi)); return r; }
struct EpiF32 {
    static constexpr bool PERM = false, AFTER_DRAIN = false;
    float* O; int ldc;
    __device__ __forceinline__ void operator()(const f32x4 (&acc)[2][2][4][2], const Unit& u, int wr, int wc, int fr, int fq) const {
        const int row0 = u.pm * BM + wr * 64 + fr, col0 = u.pn * BM + wc * 32 + 4 * fq;
#pragma unroll
        for (int ai = 0; ai < 2; ++ai)
#pragma unroll
            for (int m = 0; m < 4; ++m) { float* rowp = O + (size_t)(row0 + ai * HALF + m * 16) * ldc + col0;
#pragma unroll
                for (int bj = 0; bj < 2; ++bj)
#pragma unroll
                    for (int n = 0; n < 2; ++n) *(f32x4*)(rowp + bj * HALF + n * 16) = acc[ai][bj][m][n]; }
    }
    __device__ __forceinline__ void fused(f32x4 (&)[2][2][4][2], const Unit&, int, int, int, int, PG8_LAS unsigned char*, int, int) const {}
};
struct EpiRes {
    static constexpr bool PERM = false, AFTER_DRAIN = false;
    const float* res_l; const float* res_c; float* out_l; float* out_c; const float* gate_l; const float* gate_c;
    __device__ __forceinline__ void operator()(const f32x4 (&acc)[2][2][4][2], const Unit& u, int wr, int wc, int fr, int fq) const {
        const bool isc = u.pm >= 32;
        const float* res = isc ? res_c : res_l; float* out = isc ? out_c : out_l; const float* gate = isc ? gate_c : gate_l;
        const int row0 = (isc ? u.pm - 32 : u.pm) * BM + wr * 64 + fr, col0 = u.pn * BM + wc * 32 + 4 * fq;
        f32x4 gv[2][2];
#pragma unroll
        for (int bj = 0; bj < 2; ++bj)
#pragma unroll
            for (int n = 0; n < 2; ++n) gv[bj][n] = *(const f32x4*)(gate + col0 + bj * HALF + n * 16);
#pragma unroll
        for (int ai = 0; ai < 2; ++ai)
#pragma unroll
            for (int m = 0; m < 4; ++m) { const size_t off = (size_t)(row0 + ai * HALF + m * 16) * 2048 + col0;
#pragma unroll
                for (int bj = 0; bj < 2; ++bj)
#pragma unroll
                    for (int n = 0; n < 2; ++n) { const f32x4 r = *(const f32x4*)(res + off + bj * HALF + n * 16);
                        *(f32x4*)(out + off + bj * HALF + n * 16) = r + gv[bj][n] * acc[ai][bj][m][n]; } }
    }
    __device__ __forceinline__ void fused(f32x4 (&)[2][2][4][2], const Unit&, int, int, int, int, PG8_LAS unsigned char*, int, int) const {}
};
struct EpiRelu2 {
    static constexpr bool PERM = true, AFTER_DRAIN = false;
    bf16_t* O; int ldc;
    __device__ __forceinline__ void operator()(const f32x4 (&acc)[2][2][4][2], const Unit& u, int wr, int wc, int fr, int fq) const {
        const int row0 = u.pm * BM + wr * 64 + fr, col0 = u.pn * BM + wc * 32 + 8 * fq;
#pragma unroll
        for (int ai = 0; ai < 2; ++ai)
#pragma unroll
            for (int m = 0; m < 4; ++m) { bf16_t* rowp = O + (size_t)(row0 + ai * HALF + m * 16) * ldc + col0;
#pragma unroll
                for (int bj = 0; bj < 2; ++bj) { f32x4 v0 = acc[ai][bj][m][0], v1 = acc[ai][bj][m][1];
#pragma unroll
                    for (int e = 0; e < 4; ++e) { const float a = fmaxf(v0[e], 0.f), b = fmaxf(v1[e], 0.f); v0[e] = a * a; v1[e] = b * b; }
                    u32x4 w; w.x = cvt_pk_bf16(v0[0], v0[1]); w.y = cvt_pk_bf16(v0[2], v0[3]); w.z = cvt_pk_bf16(v1[0], v1[1]); w.w = cvt_pk_bf16(v1[2], v1[3]);
                    *(u32x4*)(rowp + bj * HALF) = w; } }
    }
    __device__ __forceinline__ void fused(f32x4 (&)[2][2][4][2], const Unit&, int, int, int, int, PG8_LAS unsigned char*, int, int) const {}
};
struct EpiAtomic {
    static constexpr bool PERM = false, AFTER_DRAIN = false;
    float* out; const float* gate;
    __device__ __forceinline__ void operator()(const f32x4 (&acc)[2][2][4][2], const Unit& u, int wr, int wc, int fr, int fq) const {
        const int row0 = wr * 64 + fr, col0 = u.pn * BM + wc * 32 + 4 * fq;
        f32x4 gv[2][2];
#pragma unroll
        for (int bj = 0; bj < 2; ++bj)
#pragma unroll
            for (int n = 0; n < 2; ++n) gv[bj][n] = *(const f32x4*)(gate + col0 + bj * HALF + n * 16);
        float* o = out + (size_t)row0 * 2048 + col0;
#pragma unroll
        for (int ai = 0; ai < 2; ++ai)
#pragma unroll
            for (int m = 0; m < 4; ++m) { float* orow = o + (size_t)(ai * HALF + m * 16) * 2048; asm volatile("" : "+v"(orow));
#pragma unroll
                for (int bj = 0; bj < 2; ++bj)
#pragma unroll
                    for (int n = 0; n < 2; ++n) { const f32x4 v = gv[bj][n] * acc[ai][bj][m][n]; float* q = orow + bj * HALF + n * 16;
                        unsafeAtomicAdd(q, v.x); unsafeAtomicAdd(q + 1, v.y); unsafeAtomicAdd(q + 2, v.z); unsafeAtomicAdd(q + 3, v.w); }
                asm volatile("" ::: "memory"); }
    }
    __device__ __forceinline__ void fused(f32x4 (&)[2][2][4][2], const Unit&, int, int, int, int, PG8_LAS unsigned char*, int, int) const {}
};
template <class Epi, class Sched, bool ALIGN_EPI = false, bool SP2 = false>
__device__ __forceinline__ void gemm_phase(PG8_LAS unsigned char* lds, const Gemm g, const Sched& S, const Epi& E) {
    const int tid = otid(), wid = __builtin_amdgcn_readfirstlane(tid >> 6), lane = tid & 63, wr = wid >> 2, wc = wid & 3, fr = lane & 15, fq = lane >> 4;
    const int K = g.ldk, nt = g.K / BK;
    unsigned voffA[2], voffB[2];
#pragma unroll
    for (int i = 0; i < 2; ++i) { int R, C; stage_rc(tid * 16 + i * 8192, R, C); const int Rb = Epi::PERM ? ((R & ~31) + perm32(R & 31)) : R;
        voffA[i] = (unsigned)(R * K + C) * 2u; voffB[i] = (unsigned)(Rb * K + C) * 2u; }
    const size_t kstep = (size_t)(BK * 2);
    const size_t hstep = (size_t)HALF * K * 2;
    const size_t tstep = 2 * hstep;
    const unsigned ldsw = (unsigned)wid * 1024u;
    const int aoff = lds_byte(wr * 64 + fr, fq * 8), boff = lds_byte(wc * 32 + fr, fq * 8);
#define PG8_SA(b, h) (((b) * 2 + (h)) * HTB)
#define PG8_SB(b, h) ((4 + (b) * 2 + (h)) * HTB)
#define PG8_STAGE(bufoff, gbase, voff) do { _Pragma("unroll") for (int _i = 0; _i < 2; ++_i) \
        __builtin_amdgcn_global_load_lds((const unsigned*)((const char*)(gbase) + (voff)[_i]), (PG8_LAS unsigned*)(lds + (bufoff) + ldsw + _i * 8192), 16, 0, 0); } while (0)
#define PG8_LDA(dst, b, h) do { _Pragma("unroll") for (int m = 0; m < 4; ++m) _Pragma("unroll") for (int k = 0; k < 2; ++k) dst[m][k] = *(const PG8_LAS bf16x8*)(lds + PG8_SA(b, h) + aoff + m * 2048 + k * 1024); } while (0)
#define PG8_LDB(dst, b, h) do { _Pragma("unroll") for (int n = 0; n < 2; ++n) _Pragma("unroll") for (int k = 0; k < 2; ++k) dst[n][k] = *(const PG8_LAS bf16x8*)(lds + PG8_SB(b, h) + boff + n * 2048 + k * 1024); } while (0)
#define PG8_MMA(ai, bj, At, Bt) do { __builtin_amdgcn_s_setprio(1); _Pragma("unroll") for (int m = 0; m < 4; ++m) _Pragma("unroll") for (int n = 0; n < 2; ++n) _Pragma("unroll") for (int k = 0; k < 2; ++k) \
        acc[ai][bj][m][n] = __builtin_amdgcn_mfma_f32_16x16x32_bf16(Bt[n][k], At[m][k], acc[ai][bj][m][n], 0, 0, 0); __builtin_amdgcn_s_setprio(0); } while (0)
#define PG8_WAIT_V(n) asm volatile("s_waitcnt vmcnt(" #n ")" ::: "memory")
#define PG8_WAIT_L(n) asm volatile("s_waitcnt lgkmcnt(" #n ")" ::: "memory")
#define PG8_BAR __builtin_amdgcn_s_barrier()
#define PG8_SCHED __builtin_amdgcn_sched_barrier(0)
    Unit cur, nxt; int ui = 0;
    if (!S.next(0, cur)) return;
    f32x4 acc[2][2][4][2];
#pragma unroll
    for (int a = 0; a < 2; ++a)
#pragma unroll
        for (int b = 0; b < 2; ++b)
#pragma unroll
            for (int m = 0; m < 4; ++m)
#pragma unroll
                for (int n = 0; n < 2; ++n) acc[a][b][m][n] = (f32x4){0.f, 0.f, 0.f, 0.f};
    bf16x8 At[4][2], B0[2][2], B1[2][2];
    const char* cA = (const char*)g.A + (size_t)cur.pm * tstep + (size_t)cur.ko * 2; const char* cB = (const char*)g.Bt + (size_t)cur.pn * tstep + (size_t)cur.ko * 2;
    S.a_ready(cur);
    if constexpr (SP2) {
        PG8_STAGE(PG8_SB(0, 0), cB, voffB); PG8_STAGE(PG8_SB(0, 1), cB + hstep, voffB); PG8_STAGE(PG8_SA(0, 0), cA, voffA); PG8_STAGE(PG8_SA(0, 1), cA + hstep, voffA);
        if (wr == 1) PG8_BAR;
        PG8_WAIT_V(2); PG8_BAR;
        PG8_STAGE(PG8_SB(1, 0), cB + kstep, voffB); PG8_STAGE(PG8_SA(1, 0), cA + kstep, voffA); PG8_STAGE(PG8_SB(1, 1), cB + hstep + kstep, voffB);
        PG8_WAIT_V(6); PG8_BAR;
    } else {
        PG8_STAGE(PG8_SB(0, 0), cB, voffB); PG8_STAGE(PG8_SA(0, 0), cA, voffA); PG8_STAGE(PG8_SB(0, 1), cB + hstep, voffB); PG8_STAGE(PG8_SA(0, 1), cA + hstep, voffA);
        if (wr == 1) PG8_BAR;
        PG8_WAIT_V(4); PG8_BAR;
        PG8_STAGE(PG8_SB(1, 0), cB + kstep, voffB); PG8_STAGE(PG8_SA(1, 0), cA + kstep, voffA); PG8_STAGE(PG8_SB(1, 1), cB + hstep + kstep, voffB);
        PG8_WAIT_V(6); PG8_BAR;
    }
    for (;;) {
        const bool has_next = S.next(ui + 1, nxt);
        const char* nA = has_next ? (const char*)g.A + (size_t)nxt.pm * tstep + (size_t)nxt.ko * 2 : cA; const char* nB = has_next ? (const char*)g.Bt + (size_t)nxt.pn * tstep + (size_t)nxt.ko * 2 : cB;
        for (int t = 0; t < nt; t += 2) {
            const bool last = (t == nt - 2);
            const char* a1 = cA + (size_t)(t + 1) * kstep;
            const char* a2 = last ? nA : cA + (size_t)(t + 2) * kstep; const char* b2 = last ? nB : cB + (size_t)(t + 2) * kstep;
            const char* a3 = a2 + kstep; const char* b3 = b2 + kstep;
            if (last && has_next) S.a_ready(nxt);
            if constexpr (SP2) {
            PG8_LDB(B0, 0, 0); PG8_LDB(B1, 0, 1); PG8_SCHED; PG8_LDA(At, 0, 0); PG8_STAGE(PG8_SA(1, 1), a1 + hstep, voffA);
            PG8_WAIT_V(8); PG8_WAIT_L(0); PG8_BAR; PG8_MMA(0, 0, At, B0); PG8_MMA(0, 1, At, B1); PG8_BAR; PG8_SCHED;
            PG8_LDA(At, 0, 1); PG8_STAGE(PG8_SB(0, 0), b2, voffB); PG8_STAGE(PG8_SB(0, 1), b2 + hstep, voffB); PG8_STAGE(PG8_SA(0, 0), a2, voffA);
            PG8_WAIT_V(8); PG8_WAIT_L(0); PG8_BAR; PG8_MMA(1, 0, At, B0); PG8_MMA(1, 1, At, B1); PG8_BAR; PG8_SCHED;
            PG8_LDB(B0, 1, 0); PG8_LDB(B1, 1, 1); PG8_SCHED; PG8_LDA(At, 1, 0); PG8_STAGE(PG8_SA(0, 1), a2 + hstep, voffA);
            PG8_WAIT_V(8); PG8_WAIT_L(0); PG8_BAR; PG8_MMA(0, 0, At, B0); PG8_MMA(0, 1, At, B1); PG8_BAR; PG8_SCHED;
            PG8_LDA(At, 1, 1); PG8_STAGE(PG8_SB(1, 0), b3, voffB); PG8_STAGE(PG8_SB(1, 1), b3 + hstep, voffB); PG8_STAGE(PG8_SA(1, 0), a3, voffA);
            PG8_WAIT_V(8); PG8_WAIT_L(0); PG8_BAR; PG8_MMA(1, 0, At, B0); PG8_MMA(1, 1, At, B1); PG8_BAR; PG8_SCHED;
            } else {
            PG8_LDB(B0, 0, 0); PG8_SCHED; PG8_LDA(At, 0, 0); PG8_STAGE(PG8_SA(1, 1), a1 + hstep, voffA);
            PG8_WAIT_L(8); PG8_BAR; PG8_WAIT_L(0); PG8_MMA(0, 0, At, B0); PG8_BAR; PG8_SCHED;
            PG8_LDB(B1, 0, 1); PG8_STAGE(PG8_SB(0, 0), b2, voffB);
            PG8_BAR; PG8_WAIT_L(0); PG8_MMA(0, 1, At, B1); PG8_BAR;
            PG8_LDA(At, 0, 1); PG8_STAGE(PG8_SA(0, 0), a2, voffA);
            PG8_BAR; PG8_WAIT_L(0); PG8_MMA(1, 0, At, B0); PG8_BAR; PG8_SCHED;
            PG8_STAGE(PG8_SB(0, 1), b2 + hstep, voffB);
            PG8_WAIT_V(6); PG8_BAR; PG8_MMA(1, 1, At, B1); PG8_BAR;
            PG8_LDB(B0, 1, 0); PG8_SCHED; PG8_LDA(At, 1, 0); PG8_STAGE(PG8_SA(0, 1), a2 + hstep, voffA);
            PG8_WAIT_L(8); PG8_BAR; PG8_WAIT_L(0); PG8_MMA(0, 0, At, B0); PG8_BAR; PG8_SCHED;
            PG8_LDB(B1, 1, 1); PG8_STAGE(PG8_SB(1, 0), b3, voffB);
            PG8_BAR; PG8_WAIT_L(0); PG8_MMA(0, 1, At, B1); PG8_BAR;
            PG8_LDA(At, 1, 1); PG8_STAGE(PG8_SA(1, 0), a3, voffA);
            PG8_BAR; PG8_WAIT_L(0); PG8_MMA(1, 0, At, B0); PG8_BAR; PG8_SCHED;
            PG8_STAGE(PG8_SB(1, 1), b3 + hstep, voffB);
            PG8_WAIT_V(6); PG8_BAR; PG8_MMA(1, 1, At, B1); PG8_BAR;
            }
        }
        if constexpr (ALIGN_EPI) { if (wr == 0) PG8_BAR; }
        if constexpr (!Epi::AFTER_DRAIN) { E(acc, cur, wr, wc, fr, fq); S.done(cur); }
        if (!has_next) break;
#pragma unroll
        for (int a = 0; a < 2; ++a)
#pragma unroll
            for (int b = 0; b < 2; ++b)
#pragma unroll
                for (int m = 0; m < 4; ++m)
#pragma unroll
                    for (int n = 0; n < 2; ++n) acc[a][b][m][n] = (f32x4){0.f, 0.f, 0.f, 0.f};
        cur = nxt; cA = nA; cB = nB; ++ui;
        if constexpr (ALIGN_EPI) { if (wr == 1) PG8_BAR; }
    }
    PG8_WAIT_V(0);
    if constexpr (!ALIGN_EPI) { if (wr == 0) PG8_BAR; }
    PG8_BAR;
    if constexpr (Epi::AFTER_DRAIN) { E.fused(acc, cur, wr, wc, fr, fq, lds, wid, lane); S.done(cur); }
#undef PG8_SA
#undef PG8_SB
#undef PG8_STAGE
#undef PG8_LDA
#undef PG8_LDB
#undef PG8_MMA
#undef PG8_WAIT_V
#undef PG8_WAIT_L
#undef PG8_BAR
#undef PG8_SCHED
}
}
#define LAS __attribute__((address_space(3)))
typedef unsigned short bf16;
typedef float f32x4 __attribute__((ext_vector_type(4)));
typedef float f32x2 __attribute__((ext_vector_type(2)));
typedef short bf16x8 __attribute__((ext_vector_type(8)));
typedef unsigned v4u __attribute__((ext_vector_type(4)));
typedef unsigned v2u __attribute__((ext_vector_type(2)));

constexpr int NTHR = 512;
constexpr int LDS_BYTES = 155648;
constexpr int DM = 2048, TLAT = 8192, TCTX = 256, TTOK = 8448, PINP = 7680, DFF = 8192;
constexpr size_t MiB = 1u << 20;
constexpr size_t WS_MOD = 0;
constexpr size_t WS_DL = 256 * 1024;
constexpr size_t WS_BONUS = 512 * 1024;
constexpr size_t WS_BAR = 1536 * 1024;
constexpr size_t WS_LATC = 2 * MiB;
constexpr size_t WS_WT_IN = 4 * MiB, WS_WT_OUT = 34 * MiB, WS_WT_1 = 42 * MiB, WS_WT_2 = 74 * MiB;
constexpr size_t WS_H = 106 * MiB;
constexpr size_t WS_SZ = 139 * MiB;
constexpr size_t WS_GATE = WS_SZ + (size_t)TTOK * 1024 * 2;
constexpr size_t WS_P = 172 * MiB;
constexpr size_t WS_GDN = 420 * MiB;
constexpr size_t WS_RWD = 569 * MiB;
constexpr size_t WS_RWS = WS_RWD + (size_t)2 * 16 * TTOK * 512;
constexpr size_t WS_WSM = 752 * MiB;
constexpr size_t WS_END = WS_WSM + (size_t)2 * 1024 * 416 * 2;
static_assert(WS_RWS + (size_t)16 * TTOK * 384 <= WS_WSM, "ws map");
static_assert(WS_GATE + (size_t)TTOK * 1024 * 2 <= WS_P && WS_P + (size_t)TTOK * PINP * 4 <= WS_GDN && WS_GDN + (size_t)2 * 8 * 132 * 36864 * 2 <= WS_RWD, "ws map");
static_assert(WS_END <= 768 * MiB, "ws size");

struct Params { const float* in[28]; float* out; unsigned char* ws; int ph_lo, ph_hi; };

__device__ __forceinline__ unsigned f2bf(float f) { unsigned u = __builtin_bit_cast(unsigned, f); return (u + 0x7fffu + ((u >> 16) & 1u)) >> 16; }
__device__ __forceinline__ unsigned pk2(float lo, float hi) { return f2bf(lo) | (f2bf(hi) << 16); }
__device__ __forceinline__ float bf2f(unsigned b) { return __builtin_bit_cast(float, b << 16); }
__device__ __forceinline__ float bflo(unsigned w) { return __builtin_bit_cast(float, w << 16); }
__device__ __forceinline__ float bfhi(unsigned w) { return __builtin_bit_cast(float, w & 0xffff0000u); }
__device__ __forceinline__ float wave_sum(float v) {
#pragma unroll
    for (int o = 1; o < 64; o <<= 1) v += __shfl_xor(v, o);
    return v;
}
__device__ __forceinline__ float sigmoidf_(float x) { return 1.f / (1.f + expf(-x)); }
__device__ __forceinline__ float siluf_(float x) { return x / (1.f + expf(-x)); }
__device__ __forceinline__ float softplusf_(float x) { return x > 20.f ? x : log1pf(expf(x)); }
#define LDS_WAIT() asm volatile("s_waitcnt lgkmcnt(0)" ::: "memory")

__device__ __forceinline__ void transpose_item(const float* W, int K, int N, bf16* WT, float* scr, int item, int lane) {
    const int nblk = N / 32, kb = item / nblk, nb = item % nblk, k0 = 64 * kb, n0 = 32 * nb;
#pragma unroll 8
    for (int i = 0; i < 32; ++i) { const int kk = 2 * i + (lane >> 5); scr[kk * 33 + (lane & 31)] = W[(size_t)(k0 + kk) * N + n0 + (lane & 31)]; }
    LDS_WAIT();
    const int c = lane & 7;
#pragma unroll
    for (int j = 0; j < 4; ++j) { const int n = (lane >> 3) + 8 * j; const float* s = scr + (8 * c) * 33 + n;
        v4u o; o.x = pk2(s[0 * 33], s[1 * 33]); o.y = pk2(s[2 * 33], s[3 * 33]); o.z = pk2(s[4 * 33], s[5 * 33]); o.w = pk2(s[6 * 33], s[7 * 33]);
        *(v4u*)(WT + (size_t)(n0 + n) * K + k0 + 8 * c) = o; }
    LDS_WAIT();
}
__device__ __forceinline__ void convert_weights(const Params& p, int l, int mask, int gw, int ngw, float* scr, int lane) {
    const float* w_in = p.in[8] + (size_t)l * 2048 * 7616; const float* w_out = p.in[24] + (size_t)l * 2048 * 2048;
    const float* w1 = p.in[25] + (size_t)l * 2048 * 8192; const float* w2 = p.in[26] + (size_t)l * 8192 * 2048;
    bf16* t_in = (bf16*)(p.ws + WS_WT_IN); bf16* t_out = (bf16*)(p.ws + WS_WT_OUT); bf16* t_1 = (bf16*)(p.ws + WS_WT_1); bf16* t_2 = (bf16*)(p.ws + WS_WT_2);
    const int n0 = (mask & 1) ? 7616 : 0, n1 = (mask & 2) ? 2048 : 0, n2 = (mask & 4) ? 8192 : 0, n3 = (mask & 8) ? 8192 : 0;
    for (int it = gw; it < n0 + n1 + n2 + n3; it += ngw) {
        int r = it;
        if (r < n0) { transpose_item(w_in, 2048, 7616, t_in, scr, r, lane); continue; } r -= n0;
        if (r < n1) { transpose_item(w_out, 2048, 2048, t_out, scr, r, lane); continue; } r -= n1;
        if (r < n2) { transpose_item(w1, 2048, 8192, t_1, scr, r, lane); continue; } r -= n2;
        transpose_item(w2, 8192, 2048, t_2, scr, r, lane);
    }
}
__device__ __forceinline__ void phase0(const Params& p, float* L) {
    const int tid = otid(), lane = tid & 63, wave = tid >> 6, G = gridDim.x, b = blockIdx.x;
    for (int i = b * NTHR + tid; i < TCTX * DM / 4; i += G * NTHR) ((f32x4*)(p.ws + WS_LATC))[i] = ((const f32x4*)p.in[2])[i];
    { v4u z = {0u, 0u, 0u, 0u}; v4u* dst = (v4u*)((bf16*)(p.ws + WS_WT_IN) + (size_t)7616 * 2048);
      for (int i = b * NTHR + tid; i < 64 * 2048 / 8; i += G * NTHR) dst[i] = z; }
    convert_weights(p, 0, 1, b * 8 + wave, G * 8, L + wave * 2112, lane);
    for (int t = b * NTHR + tid; t < 2 * 52 * 1024; t += G * NTHR) {
        const int n = t & 1023, kg = (t >> 10) % 52, l = t / (52 * 1024), k0 = kg * 8;
        const float* src; int kk0;
        if (k0 < 128) { src = p.in[15] + ((size_t)(l * 2 + (k0 >> 6)) * 64) * 1024; kk0 = k0 & 63; }
        else if (k0 < 256) { src = p.in[17] + ((size_t)(l * 2 + ((k0 - 128) >> 6)) * 64) * 1024; kk0 = k0 & 63; }
        else { src = p.in[18] + (size_t)l * 160 * 1024; kk0 = k0 - 256; }
        float v[8];
#pragma unroll
        for (int e = 0; e < 8; ++e) v[e] = src[(size_t)(kk0 + e) * 1024 + n];
        *(v4u*)((bf16*)(p.ws + WS_WSM) + ((size_t)l * 1024 + n) * 416 + k0) = (v4u){pk2(v[0], v[1]), pk2(v[2], v[3]), pk2(v[4], v[5]), pk2(v[6], v[7])};
    }
    __syncthreads();
    float* sl = L; float* sc = L + 2048;
    for (int k = tid; k < 2048; k += NTHR) { sl[k] = siluf_(p.in[1][k]); sc[k] = siluf_(p.in[3][k]); }
    __syncthreads();
    for (int it = b; it < 512; it += G) {
        const int l = it >> 8, cb = (it >> 5) & 7, kr = it & 31;
        if (tid < 384) {
            const float* W = p.in[4] + ((size_t)l * 2048 + kr * 64) * 12288 + cb * 1536 + tid * 4;
            f32x4 a0 = {0.f, 0.f, 0.f, 0.f}, a1 = {0.f, 0.f, 0.f, 0.f};
#pragma unroll 16
            for (int k = 0; k < 64; ++k) { const f32x4 w = *(const f32x4*)(W + (size_t)k * 12288); a0 += sl[kr * 64 + k] * w; a1 += sc[kr * 64 + k] * w; }
            if (kr == 0) { const f32x4 bv = *(const f32x4*)(p.in[5] + l * 12288 + cb * 1536 + tid * 4); a0 += bv; a1 += bv; }
            float* m0 = (float*)(p.ws + WS_MOD) + (l * 2) * 12288 + cb * 1536 + tid * 4; float* m1 = m0 + 12288;
            unsafeAtomicAdd(m0, a0.x); unsafeAtomicAdd(m0 + 1, a0.y); unsafeAtomicAdd(m0 + 2, a0.z); unsafeAtomicAdd(m0 + 3, a0.w);
            unsafeAtomicAdd(m1, a1.x); unsafeAtomicAdd(m1 + 1, a1.y); unsafeAtomicAdd(m1 + 2, a1.z); unsafeAtomicAdd(m1 + 3, a1.w);
        }
    }
}

__device__ __forceinline__ void norm_phase(const Params& p, int l, const float* xl, const float* xc, const float* g, int sh_idx, int sc_idx, int nrows) {
    const int tid = otid(), lane = tid & 63, gw = blockIdx.x * 8 + (tid >> 6), ngw = gridDim.x * 8;
    bf16* H = (bf16*)(p.ws + WS_H);
    const float* mod = (const float*)(p.ws + WS_MOD) + (size_t)l * 2 * 12288;
    for (int row = gw; row < nrows; row += ngw) {
        const bool isc = row >= TLAT;
        const float* xr = isc ? xc + (size_t)(row - TLAT) * DM : xl + (size_t)row * DM;
        const float* md = mod + (isc ? 12288 : 0);
        f32x4 v[8]; float ss = 0.f;
#pragma unroll
        for (int j = 0; j < 8; ++j) { v[j] = ((const f32x4*)xr)[lane + 64 * j]; ss += v[j].x * v[j].x + v[j].y * v[j].y + v[j].z * v[j].z + v[j].w * v[j].w; }
        const float rstd = rsqrtf(wave_sum(ss) * (1.f / DM) + 1e-6f);
#pragma unroll
        for (int j = 0; j < 8; ++j) { const int col = 4 * (lane + 64 * j);
            const f32x4 gg = *(const f32x4*)(g + col), s1 = *(const f32x4*)(md + sc_idx * DM + col), s0 = *(const f32x4*)(md + sh_idx * DM + col);
            const f32x4 y = v[j] * rstd * gg * (1.f + s1) + s0;
            v2u o; o.x = pk2(y.x, y.y); o.y = pk2(y.z, y.w);
            *(v2u*)(H + (size_t)row * DM + col) = o; }
    }
}
__device__ __forceinline__ void final_norm(const Params& p) {
    const int tid = otid(), lane = tid & 63, gw = blockIdx.x * 8 + (tid >> 6), ngw = gridDim.x * 8;
    const float* g = p.in[27];
    for (int row = gw; row < TLAT; row += ngw) {
        float* xr = p.out + (size_t)row * DM;
        f32x4 v[8]; float ss = 0.f;
#pragma unroll
        for (int j = 0; j < 8; ++j) { v[j] = ((const f32x4*)xr)[lane + 64 * j]; ss += v[j].x * v[j].x + v[j].y * v[j].y + v[j].z * v[j].z + v[j].w * v[j].w; }
        const float rstd = rsqrtf(wave_sum(ss) * (1.f / DM) + 1e-6f);
#pragma unroll
        for (int j = 0; j < 8; ++j) { const f32x4 gg = ((const f32x4*)g)[lane + 64 * j]; ((f32x4*)xr)[lane + 64 * j] = v[j] * rstd * gg; }
    }
}
typedef __attribute__((address_space(1))) unsigned gu32;
#define XB_TMO      128
#define XB_XCNT(j)  (256  + 64 * (j))
#define XB_XSUB(j)  (1280 + 64 * (j))
#define XB_XGEN(j)  (2304 + 64 * (j))
#define XB_TOP      3328
#define XB_TOPGEN   3392
#define XCD_BAR_WORDS 3456
#define XB_SPIN_CAP (1u << 18)

__device__ __forceinline__ unsigned xb_ld(unsigned* p)              { return __hip_atomic_load(p, __ATOMIC_RELAXED, __HIP_MEMORY_SCOPE_AGENT); }
__device__ __forceinline__ unsigned xb_add(unsigned* p, unsigned v) { return __hip_atomic_fetch_add(p, v, __ATOMIC_RELAXED, __HIP_MEMORY_SCOPE_AGENT); }
__device__ __forceinline__ unsigned xb_xcc_id() { return (unsigned)__builtin_amdgcn_s_getreg((3 << 11) | 20) & 0xFu; }
#define XB_SPIN(cond, bar) do { unsigned _sp = 0; while (cond) { __builtin_amdgcn_s_sleep(1); \
    if ((++_sp & 255u) == 0u) { if (xb_ld(&(bar)[XB_TMO])) break; if (_sp > XB_SPIN_CAP) { atomicAdd(&(bar)[XB_TMO], 1u); break; } } } } while (0)

struct XcdBarrier {
    unsigned* bar; unsigned x;
    volatile LAS unsigned* st;
};

__device__ __forceinline__ XcdBarrier xcd_barrier_post(unsigned* bar, volatile LAS unsigned* st) {
    XcdBarrier b; b.bar = bar; b.x = xb_xcc_id(); b.st = st;
    if (threadIdx.x == 0) (void)xb_add(&bar[XB_XCNT(b.x)], 1u);
    return b;
}
__device__ __forceinline__ void xcd_barrier_complete(unsigned* bar, unsigned x, unsigned& nloc, unsigned& nx) {
    const unsigned G = gridDim.x * gridDim.y * gridDim.z;
    unsigned sum, cnt, mine, sp = 0u;
    for (;;) {
        sum = 0u; cnt = 0u; mine = 0u;
#pragma unroll
        for (unsigned j = 0; j < 16; ++j) { const unsigned c = xb_ld(&bar[XB_XCNT(j)]); sum += c; cnt += (c > 0u) ? 1u : 0u; mine = (j == x) ? c : mine; }
        if (sum == G) break;
        __builtin_amdgcn_s_sleep(1);
        if ((++sp & 255u) == 0u) { if (xb_ld(&bar[XB_TMO])) break; if (sp > XB_SPIN_CAP) { atomicAdd(&bar[XB_TMO], 1u); break; } }
    }
    nloc = mine > 0u ? mine : 1u; nx = cnt > 0u ? cnt : 1u;
}

__device__ __forceinline__ void xcd_barrier(const XcdBarrier& b) {
    asm volatile("s_waitcnt vmcnt(0)" ::: "memory");
    __syncthreads();
    if (threadIdx.x == 0) {
        unsigned* bar = b.bar;
        __builtin_amdgcn_s_waitcnt(0);
        unsigned nloc = b.st[0], nx = b.st[1];
        if (nloc == 0u) { xcd_barrier_complete(bar, b.x, nloc, nx); b.st[0] = nloc; b.st[1] = nx; }
        const unsigned old = xb_add(&bar[XB_XSUB(b.x)], 1u);
        const unsigned gen = old / nloc;
        if (old + 1u == (gen + 1u) * nloc) {
            __builtin_amdgcn_fence(__ATOMIC_RELEASE, "agent");
            asm volatile("s_waitcnt vmcnt(0)" ::: "memory");
            const unsigned og = xb_add(&bar[XB_TOP], 1u);
            const unsigned tg = og / nx;
            if (og + 1u == (tg + 1u) * nx) xb_add(&bar[XB_TOPGEN], 1u);
            else XB_SPIN(xb_ld(&bar[XB_TOPGEN]) == tg, bar);
            __builtin_amdgcn_fence(__ATOMIC_ACQUIRE, "agent");
            xb_add(&bar[XB_XGEN(b.x)], 1u);
            asm volatile("s_waitcnt vmcnt(0)" ::: "memory");
        } else {
            XB_SPIN(xb_ld(&bar[XB_XGEN(b.x)]) == gen, bar);
            __builtin_amdgcn_fence(__ATOMIC_ACQUIRE, "agent");
            asm volatile("s_waitcnt vmcnt(0)" ::: "memory");
        }
    }
    __syncthreads();
}

__device__ __forceinline__ void gdn_prep_item(const Params& p, int l, int item, float* L) {
    const int tid = otid(), lane = tid & 63, wave = tid >> 6;
    const int h = item & 7, ch = item >> 3;
    const bool isctx = ch >= 128;
    const int seg0 = isctx ? TLAT : 0, seglen = isctx ? TCTX : TLAT, t0 = isctx ? (ch - 128) * 64 : ch * 64;
    const float* P = (const float*)(p.ws + WS_P);
    const float* cw = p.in[9] + (size_t)l * 3 * 3072;
    float* qs = L; float* ks = L + 8448; float* KKm = L + 16896; float* QKm = L + 21056; float* TI = L + 25216;
    float* Gs = L + 33920; float* BETA = Gs + 128; float* EG = Gs + 256; float* GL = Gs + 384;
    bf16* const gd0 = (bf16*)(p.ws + WS_GDN) + ((size_t)h * 132 + (isctx ? (ch - 128) : 4 + ch)) * 36864;
    bf16* const gd1 = (bf16*)(p.ws + WS_GDN) + ((size_t)(8 + h) * 132 + (isctx ? 3 - (ch - 128) : 4 + 127 - ch)) * 36864;
#define GDP(d) ((d) ? gd1 : gd0)
    {
        const int i = tid >> 3, c0 = (tid & 7) * 16, tk = t0 + i;
        const size_t prow = (size_t)(seg0 + tk) * PINP;
#pragma unroll
        for (int which = 0; which < 2; ++which) {
            const int col = which * 1024 + h * 128 + c0;
            f32x4 y[4]; float ss = 0.f;
#pragma unroll
            for (int jj = 0; jj < 4; ++jj) {
                const f32x4 x0 = *(const f32x4*)(P + prow + col + 4 * jj);
                f32x4 xm = {0.f, 0.f, 0.f, 0.f}, xp = {0.f, 0.f, 0.f, 0.f};
                if (tk > 0) xm = *(const f32x4*)(P + prow - PINP + col + 4 * jj);
                if (tk < seglen - 1) xp = *(const f32x4*)(P + prow + PINP + col + 4 * jj);
                const f32x4 w0 = *(const f32x4*)(cw + col + 4 * jj), w1 = *(const f32x4*)(cw + 3072 + col + 4 * jj), w2 = *(const f32x4*)(cw + 6144 + col + 4 * jj);
                f32x4 t = xm * w0 + x0 * w1 + xp * w2;
                t.x = siluf_(t.x); t.y = siluf_(t.y); t.z = siluf_(t.z); t.w = siluf_(t.w);
                y[jj] = t; ss += t.x * t.x + t.y * t.y + t.z * t.z + t.w * t.w;
            }
            ss += __shfl_xor(ss, 1); ss += __shfl_xor(ss, 2); ss += __shfl_xor(ss, 4);
            const float sc = rsqrtf(ss + 1e-6f) * (which == 0 ? 0.08838834764831845f : 1.f);
            float* dst = (which ? ks : qs) + i * 132 + c0;
#pragma unroll
            for (int jj = 0; jj < 4; ++jj) *(f32x4*)(dst + 4 * jj) = y[jj] * sc;
        }
        {
            const int col = 3072 + h * 128 + c0; unsigned o[8];
#pragma unroll
            for (int jj = 0; jj < 4; ++jj) { const f32x4 z = *(const f32x4*)(P + prow + col + 4 * jj);
                o[2 * jj] = pk2(siluf_(z.x), siluf_(z.y)); o[2 * jj + 1] = pk2(siluf_(z.z), siluf_(z.w)); }
            bf16* sz = (bf16*)(p.ws + WS_SZ) + (size_t)(seg0 + tk) * 1024 + h * 128 + c0;
            *(v4u*)sz = (v4u){o[0], o[1], o[2], o[3]}; *(v4u*)(sz + 8) = (v4u){o[4], o[5], o[6], o[7]};
        }
    }
    if (tid < 128) {
        const int d = tid >> 6, ip = tid & 63, i = d ? 63 - ip : ip;
        const size_t prow = (size_t)(seg0 + t0 + i) * PINP;
        const float bb = P[prow + 4096 + d * 8 + h], al = P[prow + 4112 + d * 8 + h];
        const float A = expf(p.in[10][l * 16 + d * 8 + h]);
        float g = -A * softplusf_(al + p.in[11][l * 16 + d * 8 + h]);
#pragma unroll
        for (int o = 1; o < 64; o <<= 1) { const float t = __shfl_up(g, o); if (ip >= o) g += t; }
        Gs[d * 64 + ip] = g; BETA[d * 64 + ip] = sigmoidf_(bb); EG[d * 64 + ip] = expf(g);
        if (ip == 63) { GL[d] = g;
            const int np = isctx ? (d ? 3 - (ch - 128) : (ch - 128)) : (d ? 4 + 127 - ch : 4 + ch);
            ((float*)(p.ws + WS_DL))[(d * 8 + h) * 132 + np] = expf(g); }
    }
    __syncthreads();
    {
        const int ia = tid >> 4, jb = tid & 15;
        float akk[2][4], aqk[2][4];
#pragma unroll
        for (int a = 0; a < 2; ++a)
#pragma unroll
            for (int bq = 0; bq < 4; ++bq) { akk[a][bq] = 0.f; aqk[a][bq] = 0.f; }
        for (int c = 0; c < 128; c += 4) {
            f32x4 ki[2], qi[2], kj[4];
#pragma unroll
            for (int a = 0; a < 2; ++a) { ki[a] = *(const f32x4*)(ks + (ia + 32 * a) * 132 + c); qi[a] = *(const f32x4*)(qs + (ia + 32 * a) * 132 + c); }
#pragma unroll
            for (int bq = 0; bq < 4; ++bq) kj[bq] = *(const f32x4*)(ks + (jb + 16 * bq) * 132 + c);
#pragma unroll
            for (int a = 0; a < 2; ++a)
#pragma unroll
                for (int bq = 0; bq < 4; ++bq) {
                    akk[a][bq] += ki[a].x * kj[bq].x + ki[a].y * kj[bq].y + ki[a].z * kj[bq].z + ki[a].w * kj[bq].w;
                    aqk[a][bq] += qi[a].x * kj[bq].x + qi[a].y * kj[bq].y + qi[a].z * kj[bq].z + qi[a].w * kj[bq].w; }
        }
#pragma unroll
        for (int a = 0; a < 2; ++a)
#pragma unroll
            for (int bq = 0; bq < 4; ++bq) { KKm[(ia + 32 * a) * 65 + jb + 16 * bq] = akk[a][bq]; QKm[(ia + 32 * a) * 65 + jb + 16 * bq] = aqk[a][bq]; }
    }
    __syncthreads();
#pragma unroll 4
    for (int e = 0; e < 16; ++e) { const int idx = tid + 512 * e, d = idx >> 12, ip = (idx >> 6) & 63, jp = idx & 63;
        const int ri = d ? 63 - ip : ip, rj = d ? 63 - jp : jp;
        float v = 0.f;
        if (jp < ip) v = BETA[d * 64 + ip] * KKm[ri * 65 + rj] * expf(Gs[d * 64 + ip] - Gs[d * 64 + jp]);
        TI[d * 4352 + ip * 68 + jp] = v; }
    __syncthreads();
    if (wave < 2) {
        const int d = wave; float X[64];
        const float* Lb = TI + d * 4352;
#pragma unroll
        for (int i = 0; i < 64; ++i) {
            float acc = (i == lane) ? 1.f : 0.f;
#pragma unroll
            for (int j4 = 0; j4 < i; j4 += 4) {
                const f32x4 lv = *(const f32x4*)(Lb + i * 68 + j4);
                acc -= lv.x * X[j4];
                if (j4 + 1 < i) acc -= lv.y * X[j4 + 1];
                if (j4 + 2 < i) acc -= lv.z * X[j4 + 2];
                if (j4 + 3 < i) acc -= lv.w * X[j4 + 3];
            }
            X[i] = acc;
        }
        LDS_WAIT();
#pragma unroll
        for (int i = 0; i < 64; ++i) TI[d * 4352 + i * 68 + lane] = X[i];
    } else {
        const int t2 = tid - 128;
        for (int idx = t2; idx < 2048; idx += 384) {
            const int d = idx >> 10, ip = (idx >> 4) & 63, c8 = idx & 15, ri = d ? 63 - ip : ip; const float e = EG[d * 64 + ip];
            const f32x4 a = *(const f32x4*)(qs + ri * 132 + c8 * 8), bq = *(const f32x4*)(qs + ri * 132 + c8 * 8 + 4);
            *(v4u*)(GDP(d) + 8192 + ip * 128 + c8 * 8) = (v4u){pk2(a.x * e, a.y * e), pk2(a.z * e, a.w * e), pk2(bq.x * e, bq.y * e), pk2(bq.z * e, bq.w * e)};
        }
        for (int idx = t2; idx < 2048; idx += 384) {
            const int d = idx >> 10, c = (idx >> 3) & 127, i8 = idx & 7; const float gl = GL[d]; float v[8];
#pragma unroll
            for (int e = 0; e < 8; ++e) { const int ip = i8 * 8 + e, ri = d ? 63 - ip : ip; v[e] = ks[ri * 132 + c] * expf(gl - Gs[d * 64 + ip]); }
            *(v4u*)(GDP(d) + 16384 + c * 64 + i8 * 8) = (v4u){pk2(v[0], v[1]), pk2(v[2], v[3]), pk2(v[4], v[5]), pk2(v[6], v[7])};
        }
        for (int idx = t2; idx < 1024; idx += 384) {
            const int d = idx >> 9, ip = (idx >> 3) & 63, j8 = idx & 7, ri = d ? 63 - ip : ip; const float gi = Gs[d * 64 + ip]; float v[8];
#pragma unroll
            for (int e = 0; e < 8; ++e) { const int jp = j8 * 8 + e, rj = d ? 63 - jp : jp; v[e] = (jp <= ip) ? QKm[ri * 65 + rj] * expf(gi - Gs[d * 64 + jp]) : 0.f; }
            *(v4u*)(GDP(d) + 24576 + ip * 64 + j8 * 8) = (v4u){pk2(v[0], v[1]), pk2(v[2], v[3]), pk2(v[4], v[5]), pk2(v[6], v[7])};
        }
    }
    __syncthreads();
    {
        const int i = tid >> 3, c0 = (tid & 7) * 16, tk = t0 + i; const size_t prow = (size_t)(seg0 + tk) * PINP; const int col = 2048 + h * 128 + c0;
#pragma unroll
        for (int jj = 0; jj < 4; ++jj) {
            const f32x4 x0 = *(const f32x4*)(P + prow + col + 4 * jj);
            f32x4 xm = {0.f, 0.f, 0.f, 0.f}, xp = {0.f, 0.f, 0.f, 0.f};
            if (tk > 0) xm = *(const f32x4*)(P + prow - PINP + col + 4 * jj);
            if (tk < seglen - 1) xp = *(const f32x4*)(P + prow + PINP + col + 4 * jj);
            const f32x4 w0 = *(const f32x4*)(cw + col + 4 * jj), w1 = *(const f32x4*)(cw + 3072 + col + 4 * jj), w2 = *(const f32x4*)(cw + 6144 + col + 4 * jj);
            f32x4 t = xm * w0 + x0 * w1 + xp * w2;
            t.x = siluf_(t.x); t.y = siluf_(t.y); t.z = siluf_(t.z); t.w = siluf_(t.w);
            *(f32x4*)(qs + i * 132 + c0 + 4 * jj) = t;
        }
    }
    const int d5 = tid >> 8, tt = tid & 255, ig = d5 ? 15 - (tt >> 4) : (tt >> 4), cg = tt & 15, jmax = ig * 4 + 3;
#pragma unroll
    for (int pass = 0; pass < 2; ++pass) {
        if (pass == 1) __syncthreads();
        const float* src = pass ? qs : ks;
        f32x4 acc[4][2];
#pragma unroll
        for (int ii = 0; ii < 4; ++ii) { acc[ii][0] = (f32x4){0.f, 0.f, 0.f, 0.f}; acc[ii][1] = (f32x4){0.f, 0.f, 0.f, 0.f}; }
        for (int j = 0; j <= jmax; ++j) {
            const int rj = d5 ? 63 - j : j;
            const float cf = pass ? BETA[d5 * 64 + j] : BETA[d5 * 64 + j] * EG[d5 * 64 + j];
            const f32x4 k0 = *(const f32x4*)(src + rj * 132 + cg * 4), k1 = *(const f32x4*)(src + rj * 132 + 64 + cg * 4);
#pragma unroll
            for (int ii = 0; ii < 4; ++ii) { const float t = TI[d5 * 4352 + (ig * 4 + ii) * 68 + j] * cf; acc[ii][0] += t * k0; acc[ii][1] += t * k1; }
        }
        bf16* dst = GDP(d5) + (pass ? 28672 : 0);
#pragma unroll
        for (int ii = 0; ii < 4; ++ii) {
            *(v2u*)(dst + (ig * 4 + ii) * 128 + cg * 4) = (v2u){pk2(acc[ii][0].x, acc[ii][0].y), pk2(acc[ii][0].z, acc[ii][0].w)};
            *(v2u*)(dst + (ig * 4 + ii) * 128 + 64 + cg * 4) = (v2u){pk2(acc[ii][1].x, acc[ii][1].y), pk2(acc[ii][1].z, acc[ii][1].w)};
        }
    }
    __syncthreads();
}

__device__ __forceinline__ void rw_tok(int sf, int& prow, int& up, int& dn) {
    if (sf < TCTX) { prow = TLAT + sf; up = sf > 0 ? prow - 1 : -1; dn = sf < TCTX - 1 ? prow + 1 : -1; }
    else { const int j = sf - TCTX, r = j & 127, cc = j >> 7; prow = r * 64 + cc; up = r > 0 ? prow - 64 : -1; dn = r < 127 ? prow + 64 : -1; }
}
__device__ __forceinline__ float rw_shift(const float* P, const float* mu, int prow, int up, int dn, int col) {
    const float x = P[(size_t)prow * PINP + 4128 + col];
    const float u = up >= 0 ? P[(size_t)up * PINP + 4128 + col] : 0.f;
    const float dv = dn >= 0 ? P[(size_t)dn * PINP + 4128 + col] : 0.f;
    return x + mu[col] * (0.5f * (u + dv) - x);
}
__device__ __forceinline__ float fexp(float x) { return __expf(x); }
__device__ __forceinline__ float fsig(float x) { return __frcp_rn(1.f + __expf(-x)); }
#ifndef TSEL
#define TSEL -1
#endif
#define PSTAMP(i) do { if (TSEL >= 50 && probe && tid == 0) ((unsigned long long*)(p.ws + WS_BAR + 32768))[50 + (i)] = __builtin_amdgcn_s_memrealtime(); } while (0)
__device__ __forceinline__ void rwkv_prep_item(const Params& p, int l, int item, float* L, bool probe = false) {
    const int tid = otid(), lane = tid & 63, wave = tid >> 6, r = lane & 15, q = lane >> 4;
    const float* P = (const float*)(p.ws + WS_P);
    const float* mu = p.in[13] + (size_t)l * 3488;
    bf16* actb = (bf16*)L;
    int* tinfo = (int*)(L + 3392);
    const int sf0 = item * 16;
    PSTAMP(0);
    if (tid < 16) { int prow, up, dn; rw_tok(sf0 + tid, prow, up, dn); tinfo[tid * 4] = prow; tinfo[tid * 4 + 1] = up; tinfo[tid * 4 + 2] = dn; }
    __syncthreads();
#pragma unroll
    for (int i = 0; i < 13; ++i) { const int e = tid + 512 * i, t = e / 416, cc = e - t * 416;
        const int prow = tinfo[t * 4], up = tinfo[t * 4 + 1], dn = tinfo[t * 4 + 2];
        float v = rw_shift(P, mu, prow, up, dn, 3072 + cc);
        if (cc < 128) v = 1.f - 2.f * __frcp_rn(__expf(2.f * v) + 1.f); else if (cc >= 256) v = fsig(v);
        actb[t * 424 + cc] = (bf16)f2bf(v); }
    __syncthreads();
    PSTAMP(1);
    const int prow = tinfo[r * 4], up = tinfo[r * 4 + 1], dn = tinfo[r * 4 + 2], sf = sf0 + r;
    const int s1 = sf < TCTX ? TCTX - 1 - sf : 8703 - sf;
    const float mup = up >= 0 ? 0.5f : 0.f, mdn = dn >= 0 ? 0.5f : 0.f;
    const float* Pr = P + (size_t)prow * PINP + 4128; const float* Pu = P + (size_t)(up >= 0 ? up : prow) * PINP + 4128; const float* Pd = P + (size_t)(dn >= 0 ? dn : prow) * PINP + 4128;
    const bf16* Wsm = (const bf16*)(p.ws + WS_WSM) + (size_t)l * 1024 * 416;
    const float* w0p = p.in[14] + (size_t)l * 2048; const float* a0p = p.in[16] + (size_t)l * 2048;
    const float* k_k = p.in[19] + (size_t)l * 1024; const float* k_a = p.in[20] + (size_t)l * 1024; const float* r_k = p.in[21] + (size_t)l * 1024;
#pragma unroll 1
    for (int hi = 0; hi < 2; ++hi) {
        const int hh = wave * 2 + hi;
        f32x4 acc[4][5];
#pragma unroll
        for (int ct = 0; ct < 4; ++ct)
#pragma unroll
            for (int m = 0; m < 5; ++m) acc[ct][m] = (f32x4){0.f, 0.f, 0.f, 0.f};
#pragma unroll
        for (int kk = 0; kk < 13; ++kk) {
            const bf16x8 bfr = *(const bf16x8*)(actb + r * 424 + kk * 32 + 8 * q);
            constexpr int MAT[13] = {0, 0, 1, 1, 2, 2, 3, 3, 4, 4, 4, 4, 4};
#pragma unroll
            for (int ct = 0; ct < 4; ++ct) {
                const bf16x8 afr = *(const bf16x8*)(Wsm + (size_t)(hh * 64 + ct * 16 + r) * 416 + kk * 32 + 8 * q);
                acc[ct][MAT[kk]] = __builtin_amdgcn_mfma_f32_16x16x32_bf16(afr, bfr, acc[ct][MAT[kk]], 0, 0, 0);
            }
            if ((kk & 3) == 3) asm volatile("" ::: "memory");
        }
        if (hi == 0) PSTAMP(2);
        f32x4 kv[4], rv[4], vv[4]; float ss = 0.f;
#pragma unroll
        for (int ct = 0; ct < 4; ++ct) { const int c = hh * 64 + ct * 16 + 4 * q;
#pragma unroll
            for (int ten = 0; ten < 3; ++ten) { const int cc = ten * 1024 + c;
                const f32x4 x = *(const f32x4*)(Pr + cc), u = *(const f32x4*)(Pu + cc), dv = *(const f32x4*)(Pd + cc), m = *(const f32x4*)(mu + cc);
                const f32x4 y = x + m * (u * mup + dv * mdn - x);
                if (ten == 0) rv[ct] = y; else if (ten == 1) kv[ct] = y; else vv[ct] = y; }
            const f32x4 kkr = kv[ct] * *(const f32x4*)(k_k + c);
            ss += kkr.x * kkr.x + kkr.y * kkr.y + kkr.z * kkr.z + kkr.w * kkr.w;
            if (ct & 1) asm volatile("" ::: "memory"); }
        ss += __shfl_xor(ss, 16); ss += __shfl_xor(ss, 32);
        if (hi == 0) PSTAMP(3);
        const float rn = rsqrtf(ss + 1e-6f);
        unsigned char* rd0 = p.ws + WS_RWD + ((size_t)hh * TTOK + sf) * 512; unsigned char* rd1 = p.ws + WS_RWD + ((size_t)(16 + hh) * TTOK + s1) * 512;
        unsigned char* rs = p.ws + WS_RWS + ((size_t)hh * TTOK + sf) * 384;
        bf16* gt = (bf16*)(p.ws + WS_GATE) + (size_t)prow * 1024;
        float bon = 0.f;
#pragma unroll
        for (int ct = 0; ct < 4; ++ct) { const int c = hh * 64 + ct * 16 + 4 * q, co = ct * 16 + 4 * q;
            const f32x4 kkv = kv[ct] * *(const f32x4*)(k_k + c) * rn, ka = *(const f32x4*)(k_a + c), rk = *(const f32x4*)(r_k + c);
            f32x4 ksum = {0.f, 0.f, 0.f, 0.f};
#pragma unroll
            for (int d = 0; d < 2; ++d) {
                const f32x4 xw = *(const f32x4*)(w0p + d * 1024 + c) + acc[ct][d], xa = *(const f32x4*)(a0p + d * 1024 + c) + acc[ct][2 + d];
                f32x4 dec, kd, nk;
#pragma unroll
                for (int j = 0; j < 4; ++j) { const float y = -xw[j]; const float sp = y > 20.f ? y : __logf(1.f + __expf(y));
                    dec[j] = __expf(-__expf(-sp - 0.5f));
                    const float a = fsig(xa[j]); kd[j] = kv[ct][j] * (1.f + (a - 1.f) * ka[j]); nk[j] = -(kkv[j] * a); }
                ksum += kd;
                unsigned char* rd = d ? rd1 : rd0;
                *(f32x4*)(rd + co * 4) = dec;
                *(v2u*)(rd + 256 + co * 2) = (v2u){pk2(kd.x, kd.y), pk2(kd.z, kd.w)};
                *(v2u*)(rd + 384 + co * 2) = (v2u){pk2(nk.x, nk.y), pk2(nk.z, nk.w)};
            }
            const f32x4 bt = rv[ct] * ksum * rk; bon += (bt.x + bt.y) + (bt.z + bt.w);
            *(v2u*)(rs + co * 2) = (v2u){pk2(rv[ct].x, rv[ct].y), pk2(rv[ct].z, rv[ct].w)};
            *(v2u*)(rs + 128 + co * 2) = (v2u){pk2(kkv.x, kkv.y), pk2(kkv.z, kkv.w)};
            *(v2u*)(rs + 256 + co * 2) = (v2u){pk2(vv[ct].x, vv[ct].y), pk2(vv[ct].z, vv[ct].w)};
            *(v2u*)(gt + c) = (v2u){pk2(acc[ct][4].x, acc[ct][4].y), pk2(acc[ct][4].z, acc[ct][4].w)};
            asm volatile("" ::: "memory");
        }
        bon += __shfl_xor(bon, 16); bon += __shfl_xor(bon, 32);
        if (q == 0) ((float*)(p.ws + WS_BONUS))[prow * 16 + hh] = bon;
        if (hi == 0) PSTAMP(4);
    }
    PSTAMP(5);
    __syncthreads();
    PSTAMP(6);
}
#define LDS_BARRIER() do { asm volatile("s_waitcnt lgkmcnt(0)" ::: "memory"); __builtin_amdgcn_s_barrier(); asm volatile("" ::: "memory"); } while (0)
__device__ __forceinline__ f32x4 mfma16(bf16x8 a, bf16x8 b, f32x4 c) { return __builtin_amdgcn_mfma_f32_16x16x32_bf16(a, b, c, 0, 0, 0); }
__device__ __forceinline__ void gdn_scan(const Params& p, int b, unsigned char* lds) {
    const int tid = otid(), lane = tid & 63, wave = tid >> 6, r = lane & 15, q = lane >> 4;
    const int s = b & 3, h = (b >> 2) & 7, d = b >> 5;
    bf16* Wb = (bf16*)lds; bf16* Qb = Wb + 2 * 8704; bf16* KTb = Qb + 2 * 8704; bf16* Ab = KTb + 2 * 9216; bf16* Ub = Ab + 2 * 4608; bf16* ST = Ub + 2 * 2560; bf16* VT = ST + 4352;
    const bf16* G = (const bf16*)(p.ws + WS_GDN) + (size_t)((d * 8 + h) * 132) * 36864;
    const float* DLp = (const float*)(p.ws + WS_DL) + (d * 8 + h) * 132;
    float* O = (float*)(p.ws + WS_P) + (size_t)d * TTOK * 1024 + h * 128 + s * 32;
    for (int e = tid; e < 4352; e += NTHR) ST[e] = 0;
    f32x4 S0 = {0.f, 0.f, 0.f, 0.f}, S1 = {0.f, 0.f, 0.f, 0.f};
    v4u pw0, pw1, pq0, pq1, pk0, pk1, pa, pu;
    pu = (v4u){0u, 0u, 0u, 0u};
#define GDN_LOAD(n) do { const bf16* g_ = G + (size_t)(n) * 36864; \
        pw0 = *(const v4u*)(g_ + tid * 8); pw1 = *(const v4u*)(g_ + (tid + 512) * 8); \
        pq0 = *(const v4u*)(g_ + 8192 + tid * 8); pq1 = *(const v4u*)(g_ + 8192 + (tid + 512) * 8); \
        pk0 = *(const v4u*)(g_ + 16384 + tid * 8); pk1 = *(const v4u*)(g_ + 16384 + (tid + 512) * 8); \
        pa = *(const v4u*)(g_ + 24576 + tid * 8); \
        if (tid < 256) pu = *(const v4u*)(g_ + 28672 + (tid >> 2) * 128 + s * 32 + (tid & 3) * 8); } while (0)
#define GDN_STORE(bf) do { \
        *(v4u*)(Wb + (bf) * 8704 + (tid >> 4) * 136 + (tid & 15) * 8) = pw0; *(v4u*)(Wb + (bf) * 8704 + ((tid + 512) >> 4) * 136 + (tid & 15) * 8) = pw1; \
        *(v4u*)(Qb + (bf) * 8704 + (tid >> 4) * 136 + (tid & 15) * 8) = pq0; *(v4u*)(Qb + (bf) * 8704 + ((tid + 512) >> 4) * 136 + (tid & 15) * 8) = pq1; \
        *(v4u*)(KTb + (bf) * 9216 + (tid >> 3) * 72 + (tid & 7) * 8) = pk0; *(v4u*)(KTb + (bf) * 9216 + ((tid + 512) >> 3) * 72 + (tid & 7) * 8) = pk1; \
        *(v4u*)(Ab + (bf) * 4608 + (tid >> 3) * 72 + (tid & 7) * 8) = pa; \
        if (tid < 256) *(v4u*)(Ub + (bf) * 2560 + (tid >> 2) * 40 + (tid & 3) * 8) = pu; } while (0)
    GDN_LOAD(0); GDN_STORE(0);
    __syncthreads();
    const int mi = wave >> 1, nv = wave & 1;
    for (int n = 0; n < 132; ++n) {
        const int bf = n & 1;
        if (n + 1 < 132) GDN_LOAD(n + 1);
        const float dl = DLp[n];
        f32x4 co = {0.f, 0.f, 0.f, 0.f}, cv = {0.f, 0.f, 0.f, 0.f};
#pragma unroll
        for (int kk = 0; kk < 4; ++kk) {
            const bf16x8 sa = *(const bf16x8*)(ST + (16 * nv + r) * 136 + kk * 32 + 8 * q);
            const bf16x8 qa = *(const bf16x8*)(Qb + bf * 8704 + (16 * mi + r) * 136 + kk * 32 + 8 * q);
            const bf16x8 wb = *(const bf16x8*)(Wb + bf * 8704 + (16 * mi + r) * 136 + kk * 32 + 8 * q);
            co = mfma16(qa, sa, co);
            cv = mfma16(sa, wb, cv);
        }
        {
            const v2u uu = *(const v2u*)(Ub + bf * 2560 + (16 * mi + r) * 40 + 16 * nv + 4 * q);
            const float v0 = bflo(uu.x) - cv.x, v1 = bfhi(uu.x) - cv.y, v2 = bflo(uu.y) - cv.z, v3 = bfhi(uu.y) - cv.w;
            bf16* vt = VT + (16 * nv + 4 * q) * 72 + 16 * mi + r;
            vt[0] = (bf16)f2bf(v0); vt[72] = (bf16)f2bf(v1); vt[144] = (bf16)f2bf(v2); vt[216] = (bf16)f2bf(v3);
        }
        LDS_BARRIER();
#pragma unroll
        for (int kk = 0; kk < 2; ++kk) {
            const bf16x8 aa = *(const bf16x8*)(Ab + bf * 4608 + (16 * mi + r) * 72 + kk * 32 + 8 * q);
            const bf16x8 vb = *(const bf16x8*)(VT + (16 * nv + r) * 72 + kk * 32 + 8 * q);
            co = mfma16(aa, vb, co);
        }
        {
            const bool cx = n < 4;
#pragma unroll
            for (int j = 0; j < 4; ++j) { const int ip = 16 * mi + 4 * q + j;
                const int tok = d == 0 ? (cx ? TLAT + n * 64 + ip : (n - 4) * 64 + ip) : (cx ? TLAT + (3 - n) * 64 + 63 - ip : (131 - n) * 64 + 63 - ip);
                O[(size_t)tok * 1024 + 16 * nv + r] = co[j]; }
        }
#pragma unroll
        for (int e = 0; e < 2; ++e) {
            f32x4 Sv = (e ? S1 : S0) * dl; const int nk = 2 * mi + e;
#pragma unroll
            for (int kk = 0; kk < 2; ++kk) {
                const bf16x8 va = *(const bf16x8*)(VT + (16 * nv + r) * 72 + kk * 32 + 8 * q);
                const bf16x8 kb = *(const bf16x8*)(KTb + bf * 9216 + (16 * nk + r) * 72 + kk * 32 + 8 * q);
                Sv = mfma16(va, kb, Sv);
            }
            if (e) S1 = Sv; else S0 = Sv;
            bf16* st = ST + (16 * nv + 4 * q) * 136 + 16 * nk + r;
            st[0] = (bf16)f2bf(Sv.x); st[136] = (bf16)f2bf(Sv.y); st[272] = (bf16)f2bf(Sv.z); st[408] = (bf16)f2bf(Sv.w);
        }
        if (n + 1 < 132) GDN_STORE(bf ^ 1);
        LDS_BARRIER();
    }
}
__device__ __forceinline__ float red16(float x) {
    x += __builtin_bit_cast(float, __builtin_amdgcn_update_dpp(0, __builtin_bit_cast(int, x), 0x128, 0xf, 0xf, false));
    x += __builtin_bit_cast(float, __builtin_amdgcn_update_dpp(0, __builtin_bit_cast(int, x), 0x124, 0xf, 0xf, false));
    x += __builtin_bit_cast(float, __builtin_amdgcn_update_dpp(0, __builtin_bit_cast(int, x), 0x122, 0xf, 0xf, false));
    x += __builtin_bit_cast(float, __builtin_amdgcn_update_dpp(0, __builtin_bit_cast(int, x), 0x121, 0xf, 0xf, false));
    return x;
}
__device__ __forceinline__ void rwkv_compute_chunk(const float* buf, float* opb, int rl, int kg, f32x4& S) {
    constexpr int TB = 32, SF = 336;
    const float* sp = buf + 4 * kg; const float* vp = buf + 320 + rl; float* op = opb + rl * 16 + kg;
    f32x4 w = *(const f32x4*)sp, kd = *(const f32x4*)(sp + 64), nk = *(const f32x4*)(sp + 128), rr = *(const f32x4*)(sp + 192), kk = *(const f32x4*)(sp + 256);
    float v = vp[0];
#pragma unroll
    for (int st = 0; st < TB; ++st) {
        const int sn = st < TB - 1 ? st + 1 : st;
        const f32x4 w_n = *(const f32x4*)(sp + sn * SF), kd_n = *(const f32x4*)(sp + sn * SF + 64), nk_n = *(const f32x4*)(sp + sn * SF + 128),
                    rr_n = *(const f32x4*)(sp + sn * SF + 192), kk_n = *(const f32x4*)(sp + sn * SF + 256);
        const float v_n = vp[sn * SF];
        f32x2 d2 = (f32x2){S.x, S.y} * (f32x2){kk.x, kk.y};
        d2 = (f32x2){S.z, S.w} * (f32x2){kk.z, kk.w} + d2;
        const float dot = red16(d2.x + d2.y);
        S = S * w + v * kd + dot * nk;
        f32x2 o2 = (f32x2){S.x, S.y} * (f32x2){rr.x, rr.y};
        o2 = (f32x2){S.z, S.w} * (f32x2){rr.z, rr.w} + o2;
        op[st * 256] = o2.x + o2.y;
        w = w_n; kd = kd_n; nk = nk_n; rr = rr_n; kk = kk_n; v = v_n;
    }
}
__device__ __forceinline__ void rwkv_scan(const Params& p, int b, float* L) {
    const int tid = otid(), lane = tid & 63, wave = tid >> 6;
    const int pair = b >> 2, qt = b & 3, d = pair >> 4, h = pair & 15;
    const unsigned char* RD = p.ws + WS_RWD + (size_t)(d * 16 + h) * TTOK * 512;
    const unsigned char* RS = p.ws + WS_RWS + (size_t)h * TTOK * 384;
    float* O = (float*)(p.ws + WS_P) + (size_t)(2 + d) * TTOK * 1024 + h * 64 + qt * 16;
    constexpr int TB = 32, SF = 336, NCH = TTOK / TB;
    float* OP = L + 2 * TB * SF;
    const int rl = (wave & 3) * 4 + (lane >> 4), kg = lane & 15;
    const int lt = tid - 256;
    float* const dummy = L + 2 * TB * SF + 2 * TB * 256;
    int so[7], dofA[7], dofB[7]; bool isd[7];
#pragma unroll
    for (int i = 0; i < 7; ++i) { const int u = lt + 256 * i, st = u / 50, x = u % 50, sg = d ? -st : st; const bool valid = u < TB * 50;
        so[i] = !valid ? 0 : (x < 32 ? st * 512 + x * 16 : (x < 48 ? sg * 384 + (x - 32) * 16 : sg * 384 + 256 + qt * 32 + (x - 48) * 16));
        isd[i] = !valid || x < 32;
        const int base = st * SF + (x < 16 ? x * 4 : (x < 32 ? 64 + (x - 16) * 8 : (x < 48 ? 192 + (x - 32) * 8 : 320 + (x - 48) * 8)));
        dofA[i] = valid ? base : -1;
        dofB[i] = (valid && x >= 16) ? base + 4 : -1; }
    v4u ldA[7], ldB[7];
#define RW_LOADSET(ld, cc_) do { const int c_ = (cc_) < NCH ? (cc_) : NCH - 1; const unsigned char* rdb = RD + (size_t)c_ * (TB * 512); \
        const int sfb = d == 0 ? c_ * TB : (c_ < 8 ? TCTX - 1 - c_ * TB : 8703 - c_ * TB); const unsigned char* rsb = RS + (size_t)sfb * 384; \
        _Pragma("unroll") for (int i = 0; i < 7; ++i) ld[i] = *(const v4u*)((isd[i] ? rdb : rsb) + so[i]); } while (0)
#define RW_STORESET(ld, cc_) do { const bool live = (cc_) < NCH; float* buf = L + ((cc_) & 1) * (TB * SF); \
        _Pragma("unroll") for (int i = 0; i < 7; ++i) { const v4u v = ld[i]; const bool f32u = dofB[i] < 0; \
            float* d0 = (live && dofA[i] >= 0) ? buf + dofA[i] : dummy; float* d1 = (live && dofB[i] >= 0) ? buf + dofB[i] : dummy; \
            const f32x4 lo = {bflo(v.x), bfhi(v.x), bflo(v.y), bfhi(v.y)}, hi = {bflo(v.z), bfhi(v.z), bflo(v.w), bfhi(v.w)}; \
            *(f32x4*)d0 = f32u ? __builtin_bit_cast(f32x4, v) : lo; *(f32x4*)d1 = hi; } } while (0)
#define RW_ITER(c, LSET, SSET) do { \
        if (wave >= 4) { \
            RW_LOADSET(LSET, (c) + 2); \
            {     \
                const int cm = (c) >= 1 ? (c) - 1 : 0; const float* op = OP + (cm & 1) * (TB * 256); \
                const int st = lt >> 3, r2 = (lt & 7) * 2, s = cm * TB + st; float o[2]; \
                _Pragma("unroll") for (int e = 0; e < 2; ++e) { const float* q = op + st * 256 + (r2 + e) * 16; \
                    const f32x4 a = *(const f32x4*)q, bq = *(const f32x4*)(q + 4), cq = *(const f32x4*)(q + 8), dq = *(const f32x4*)(q + 12); \
                    o[e] = ((a.x + a.y) + (a.z + a.w)) + ((bq.x + bq.y) + (bq.z + bq.w)) + ((cq.x + cq.y) + (cq.z + cq.w)) + ((dq.x + dq.y) + (dq.z + dq.w)); } \
                const int j = s < TCTX ? 0 : (d ? 8447 - s : s - TCTX); \
                const int tok = s < TCTX ? TLAT + (d ? TCTX - 1 - s : s) : (j & 127) * 64 + (j >> 7); \
                *(f32x2*)(O + (size_t)tok * 1024 + r2) = (f32x2){o[0], o[1]}; } \
            RW_STORESET(SSET, (c) + 1); \
        } else if ((c) >= 0 && (c) < NCH) { rwkv_compute_chunk(L + ((c) & 1) * (TB * SF), OP + ((c) & 1) * (TB * 256), rl, kg, S); } \
        LDS_BARRIER(); } while (0)
    f32x4 S = {0.f, 0.f, 0.f, 0.f};
    if (wave >= 4) RW_LOADSET(ldA, 0);
    for (int c = -1; c <= NCH; c += 2) { RW_ITER(c, ldB, ldA); RW_ITER(c + 1, ldA, ldB); }
    __syncthreads();
}

#define DPP_ADD(x, CTRL) ((x) + __builtin_bit_cast(float, __builtin_amdgcn_update_dpp(0, __builtin_bit_cast(int, (x)), (CTRL), 0xf, 0xf, false)))
__device__ __forceinline__ void combine_phase(const Params& p, int l, int ntok) {
    const int tid = otid(), lane = tid & 63, gw = blockIdx.x * 8 + (tid >> 6), ngw = gridDim.x * 8;
    const float* OG = (const float*)(p.ws + WS_P); const float* OR = OG + (size_t)2 * TTOK * 1024;
    const bf16* SZ = (const bf16*)(p.ws + WS_SZ); const bf16* GT = (const bf16*)(p.ws + WS_GATE);
    const float* BON = (const float*)(p.ws + WS_BONUS);
    bf16* Y = (bf16*)(p.ws + WS_H);
    const int c0 = lane * 16, hr = lane >> 2;
    f32x4 ng[4], lg[4], lb[4];
#pragma unroll
    for (int e = 0; e < 4; ++e) { ng[e] = *(const f32x4*)(p.in[12] + (size_t)l * 128 + (lane & 7) * 16 + 4 * e);
        lg[e] = *(const f32x4*)(p.in[22] + (size_t)l * 1024 + c0 + 4 * e); lb[e] = *(const f32x4*)(p.in[23] + (size_t)l * 1024 + c0 + 4 * e); }
    for (int tok = gw; tok < ntok; tok += ngw) {
        const int sf = tok >= TLAT ? tok - TLAT : TCTX + (tok & 63) * 128 + (tok >> 6);
        const float* of = OG + (size_t)tok * 1024 + c0; const float* ob = of + (size_t)TTOK * 1024;
        const float* rf = OR + (size_t)tok * 1024 + c0; const float* rb = rf + (size_t)TTOK * 1024;
        f32x4 a[4], o[4];
#pragma unroll
        for (int e = 0; e < 4; ++e) { a[e] = *(const f32x4*)(of + 4 * e) + *(const f32x4*)(ob + 4 * e); o[e] = *(const f32x4*)(rf + 4 * e) + *(const f32x4*)(rb + 4 * e); }
        const v4u sz0 = *(const v4u*)(SZ + (size_t)tok * 1024 + c0), sz1 = *(const v4u*)(SZ + (size_t)tok * 1024 + c0 + 8);
        const v4u gt0 = *(const v4u*)(GT + (size_t)tok * 1024 + c0), gt1 = *(const v4u*)(GT + (size_t)tok * 1024 + c0 + 8);
        const unsigned char* vrec = p.ws + WS_RWS + ((size_t)hr * TTOK + sf) * 384 + 256 + (lane & 3) * 32;
        const v4u vv0 = *(const v4u*)vrec, vv1 = *(const v4u*)(vrec + 16);
        const float bonus = BON[tok * 16 + hr];
        float ss = 0.f;
#pragma unroll
        for (int e = 0; e < 4; ++e) ss += a[e].x * a[e].x + a[e].y * a[e].y + a[e].z * a[e].z + a[e].w * a[e].w;
        ss = DPP_ADD(ss, 0xB1); ss = DPP_ADD(ss, 0x4E); ss = DPP_ADD(ss, 0x141);
        const float rstd = rsqrtf(ss * (1.f / 128.f) + 1e-6f);
        const unsigned szw[8] = {sz0.x, sz0.y, sz0.z, sz0.w, sz1.x, sz1.y, sz1.z, sz1.w};
        unsigned yo[8];
#pragma unroll
        for (int e = 0; e < 4; ++e) { const f32x4 y = a[e] * rstd * ng[e];
            yo[2 * e] = pk2(y.x * bflo(szw[2 * e]), y.y * bfhi(szw[2 * e])); yo[2 * e + 1] = pk2(y.z * bflo(szw[2 * e + 1]), y.w * bfhi(szw[2 * e + 1])); }
        *(v4u*)(Y + (size_t)tok * 2048 + c0) = (v4u){yo[0], yo[1], yo[2], yo[3]}; *(v4u*)(Y + (size_t)tok * 2048 + c0 + 8) = (v4u){yo[4], yo[5], yo[6], yo[7]};
        float sm = 0.f;
#pragma unroll
        for (int e = 0; e < 4; ++e) sm += (o[e].x + o[e].y) + (o[e].z + o[e].w);
        sm = DPP_ADD(sm, 0xB1); sm = DPP_ADD(sm, 0x4E);
        const float mean = sm * (1.f / 64.f); float sv = 0.f;
#pragma unroll
        for (int e = 0; e < 4; ++e) { o[e] = o[e] - mean; sv += o[e].x * o[e].x + o[e].y * o[e].y + o[e].z * o[e].z + o[e].w * o[e].w; }
        sv = DPP_ADD(sv, 0xB1); sv = DPP_ADD(sv, 0x4E);
        const float rs2 = rsqrtf(sv * (1.f / 64.f) + 64e-5f);
        const unsigned vw[8] = {vv0.x, vv0.y, vv0.z, vv0.w, vv1.x, vv1.y, vv1.z, vv1.w}, gw8[8] = {gt0.x, gt0.y, gt0.z, gt0.w, gt1.x, gt1.y, gt1.z, gt1.w};
#pragma unroll
        for (int e = 0; e < 4; ++e) { const f32x4 y = o[e] * rs2 * lg[e] + lb[e];
            yo[2 * e] = pk2((y.x + bonus * bflo(vw[2 * e])) * bflo(gw8[2 * e]), (y.y + bonus * bfhi(vw[2 * e])) * bfhi(gw8[2 * e]));
            yo[2 * e + 1] = pk2((y.z + bonus * bflo(vw[2 * e + 1])) * bflo(gw8[2 * e + 1]), (y.w + bonus * bfhi(vw[2 * e + 1])) * bfhi(gw8[2 * e + 1])); }
        *(v4u*)(Y + (size_t)tok * 2048 + 1024 + c0) = (v4u){yo[0], yo[1], yo[2], yo[3]}; *(v4u*)(Y + (size_t)tok * 2048 + 1024 + c0 + 8) = (v4u){yo[4], yo[5], yo[6], yo[7]};
    }
}
#ifndef ONE_LAUNCH
#define ONE_LAUNCH 1
#endif
constexpr int N_PHASES = 20;
#if ONE_LAUNCH
#define PH(k) (true)
#ifndef TSEL
#define TSEL -1
#endif
#ifndef TSCALE
#define TSCALE 0.0003f
#endif
#define STAMP(k) do { if (TSEL >= 0 && blockIdx.x == 0 && threadIdx.x == 0) ((unsigned long long*)(p.ws + WS_BAR + 32768))[(k)] = __builtin_amdgcn_s_memrealtime(); } while (0)
#define SEAM(k) do { xcd_barrier(gbar); STAMP((k) + 1); } while (0)
#else
#define PH(k) (p.ph_lo == (k))
#define SEAM(k) do {} while (0)
#endif
#define PHON(k) ((PHMASK >> (k)) & 1)
#ifndef DUPMASK
#define DUPMASK 0
#endif
#define REP(k) for (int rep_ = 0; rep_ <= ((DUPMASK >> (k)) & 1); ++rep_) if (rep_ == 0 || (cg::this_grid().sync(), true))
template <int PHMASK, int l> __device__ __forceinline__ void layer_phases(const Params& p, unsigned char* lds, const XcdBarrier& gbar) {
    float* L = (float*)lds;
    const int b = blockIdx.x, G = gridDim.x;
    float* lat_c = (float*)(p.ws + WS_LATC);
    const float* mod = (const float*)(p.ws + WS_MOD);
    constexpr int M = l == 0 ? TTOK : TLAT;
    constexpr int B0 = 1 + 9 * l;
    const float* res_l = l == 0 ? p.in[0] : p.out; const float* res_c = l == 0 ? p.in[2] : lat_c;
    const float* mod_l = mod + (size_t)(l * 2) * 12288; const float* mod_c = mod_l + 12288;
    REP(0) if (PH(B0 + 0) && PHON(0)) {
        norm_phase(p, l, res_l, res_c, p.in[6] + (size_t)l * DM, 0, 1, TTOK);
    }
    SEAM(B0 + 0);
    REP(1) if (PH(B0 + 1) && PHON(1)) {
        pg8::Gemm g{(const pg8::bf16_t*)(p.ws + WS_H), (const pg8::bf16_t*)(p.ws + WS_WT_IN), TTOK, PINP, DM, DM}; pg8::StaticOrder S; S.init(TTOK, PINP, G, b);
        pg8::EpiF32 E{(float*)(p.ws + WS_P), PINP};
        pg8::gemm_phase<pg8::EpiF32, pg8::StaticOrder, true, true>((PG8_LAS unsigned char*)lds, g, S, E);
    }
    SEAM(B0 + 1);
    REP(2) if (PH(B0 + 2)) {
#if ONE_LAUNCH
        {
            unsigned* qctr = (unsigned*)(p.ws + WS_BAR + 16384) + l * 64;
            volatile LAS unsigned* qslot = (volatile LAS unsigned*)((LAS unsigned char*)lds + LDS_BYTES - 8);
            bool rwfirst_ = true;
            for (;;) {
                if (threadIdx.x == 0) *qslot = atomicAdd(qctr, 1u);
                __syncthreads();
                const unsigned it = *qslot;
                __syncthreads();
                if (it >= 1584u) break;
                unsigned long long t0_ = 0; if (TSEL >= 44) t0_ = __builtin_amdgcn_s_memrealtime();
                if (it < 528u) rwkv_prep_item(p, l, (int)it, L, TSEL >= 50 && l == 0 && blockIdx.x == 0 && rwfirst_); else gdn_prep_item(p, l, (int)it - 528, L);
                if (it < 528u) rwfirst_ = false;
                if (TSEL >= 44 && l == 0 && blockIdx.x == 0 && threadIdx.x == 0) { unsigned long long* ts = (unsigned long long*)(p.ws + WS_BAR + 32768); const int sl_ = it < 528u ? 44 : 45;
                    if (ts[sl_ + 4] != 0x5151ull) { ts[sl_ + 4] = 0x5151ull; ts[sl_] = __builtin_amdgcn_s_memrealtime() - t0_; } }
            }
        }
#else
        if (PHON(2)) for (int it = b; it < 528; it += G) rwkv_prep_item(p, l, it, L);
        if (PHON(11)) for (int it = b; it < 1056; it += G) gdn_prep_item(p, l, it, L);
#endif
    }
    SEAM(B0 + 2);
    REP(3) if (PH(B0 + 3) && PHON(3)) {
        if (b < 64) for (int r2_ = 0; r2_ <= ((DUPMASK >> 12) & 1); ++r2_) { if (r2_) __syncthreads(); gdn_scan(p, b, lds); }
        if (b >= 64 && b < 192) for (int r2_ = 0; r2_ <= ((DUPMASK >> 13) & 1); ++r2_) rwkv_scan(p, b - 64, L);
        if (b >= 192) { const int tid = otid(), gw = (b - 192) * 8 + (tid >> 6), ngw = (G - 192) * 8;
            if (l == 0) { convert_weights(p, 0, 14, gw, ngw, L + (tid >> 6) * 2112, tid & 63); convert_weights(p, 1, 1, gw, ngw, L + (tid >> 6) * 2112, tid & 63); }
            else convert_weights(p, 1, 14, gw, ngw, L + (tid >> 6) * 2112, tid & 63); }
    }
    if (l == 0 && (b == 0 || b == 64 || b == 192)) { __syncthreads(); if (TSEL >= 0 && threadIdx.x == 0) ((unsigned long long*)(p.ws + WS_BAR + 32768))[40 + (b >> 6)] = __builtin_amdgcn_s_memrealtime(); }
    SEAM(B0 + 3);
    REP(4) if (PH(B0 + 4) && PHON(4)) combine_phase(p, l, M);
    SEAM(B0 + 4);
    REP(5) if (PH(B0 + 5) && PHON(5)) {
        pg8::Gemm g{(const pg8::bf16_t*)(p.ws + WS_H), (const pg8::bf16_t*)(p.ws + WS_WT_OUT), TLAT, DM, DM, DM}; pg8::StaticOrder S; S.init(TLAT, DM, G, b);
        pg8::EpiRes E{res_l, res_c, p.out, lat_c, mod_l + 2 * DM, mod_c + 2 * DM};
        pg8::gemm_phase<pg8::EpiRes, pg8::StaticOrder, true, true>((PG8_LAS unsigned char*)lds, g, S, E);
        if (l == 0) {
            pg8::Gemm gc{(const pg8::bf16_t*)(p.ws + WS_H) + (size_t)TLAT * DM, (const pg8::bf16_t*)(p.ws + WS_WT_OUT), TCTX, DM, 1024, DM}; pg8::SplitKOrder Sc; Sc.init(DM, 2, 1024, G, b, 0);
            pg8::EpiAtomic Ec{lat_c, mod_c + 2 * DM};
            pg8::gemm_phase<pg8::EpiAtomic, pg8::SplitKOrder, true, true>((PG8_LAS unsigned char*)lds, gc, Sc, Ec); }
    }
    SEAM(B0 + 5);
    REP(6) if (PH(B0 + 6) && PHON(6)) norm_phase(p, l, p.out, lat_c, p.in[7] + (size_t)l * DM, 3, 4, M);
    SEAM(B0 + 6);
    REP(7) if (PH(B0 + 7) && PHON(7)) {
        pg8::Gemm g{(const pg8::bf16_t*)(p.ws + WS_H), (const pg8::bf16_t*)(p.ws + WS_WT_1), M, DFF, DM, DM}; pg8::StaticOrder S; S.init(M, DFF, G, b);
        pg8::EpiRelu2 E{(pg8::bf16_t*)(p.ws + WS_P), DFF};
        pg8::gemm_phase<pg8::EpiRelu2, pg8::StaticOrder, true, true>((PG8_LAS unsigned char*)lds, g, S, E);
    }
    SEAM(B0 + 7);
    REP(8) if (PH(B0 + 8) && PHON(8)) {
        pg8::Gemm g{(const pg8::bf16_t*)(p.ws + WS_P), (const pg8::bf16_t*)(p.ws + WS_WT_2), TLAT, DM, DFF, DFF}; pg8::StaticOrder S; S.init(TLAT, DM, G, b);
        pg8::EpiRes E{p.out, lat_c, p.out, lat_c, mod_l + 5 * DM, mod_c + 5 * DM};
        pg8::gemm_phase<pg8::EpiRes, pg8::StaticOrder, true, true>((PG8_LAS unsigned char*)lds, g, S, E);
        if (l == 0) {
            pg8::Gemm gc{(const pg8::bf16_t*)(p.ws + WS_P) + (size_t)TLAT * DFF, (const pg8::bf16_t*)(p.ws + WS_WT_2), TCTX, DM, 2048, DFF}; pg8::SplitKOrder Sc; Sc.init(DM, 4, 2048, G, b, 0);
            pg8::EpiAtomic Ec{lat_c, mod_c + 5 * DM};
            pg8::gemm_phase<pg8::EpiAtomic, pg8::SplitKOrder, true, true>((PG8_LAS unsigned char*)lds, gc, Sc, Ec); }
    }
    SEAM(B0 + 8);
}
template <int PHMASK> __global__ void __launch_bounds__(NTHR) fwd_megakernel(Params p) {
    extern __shared__ __attribute__((aligned(16))) unsigned char lds[];
    volatile LAS unsigned* bst = (volatile LAS unsigned*)((LAS unsigned char*)lds + LDS_BYTES - 16);
    if (threadIdx.x < 4) bst[threadIdx.x] = 0u;
    __syncthreads();
    XcdBarrier gbar; gbar.bar = (unsigned*)(p.ws + WS_BAR); gbar.x = 0; gbar.st = bst;
#if ONE_LAUNCH
    gbar = xcd_barrier_post((unsigned*)(p.ws + WS_BAR), bst);
#endif
    STAMP(0);
    REP(9) if (PH(0) && PHON(9)) phase0(p, (float*)lds);
#if ONE_LAUNCH
    cg::this_grid().sync(); STAMP(1);
#endif
    layer_phases<PHMASK, 0>(p, lds, gbar);
    layer_phases<PHMASK, 1>(p, lds, gbar);
    if (PH(19) && PHON(10)) final_norm(p);
    if (TSEL >= 0) { STAMP(20); if (blockIdx.x == 0 && threadIdx.x == 0) { const unsigned long long* ts = (const unsigned long long*)(p.ws + WS_BAR + 32768); __threadfence(); p.out[0] = (float)(TSEL >= 50 ? ts[TSEL] - ts[50] : TSEL >= 44 ? ts[TSEL] : (TSEL >= 40 ? ts[TSEL] - ts[4] : ts[TSEL + 1] - ts[TSEL])) * TSCALE; } }
}

extern "C" void kernel_launch(void* const* d_in, const int* in_sizes, int n_in, void* d_out, int out_size, void* d_ws, size_t ws_size, hipStream_t stream) {
    static int grid = 0;
    if (grid == 0) {
        if (n_in != 28 || ws_size < WS_END) { fprintf(stderr, "kernel_launch: need 28 inputs and %zu bytes of workspace (got %d, %zu)\n", (size_t)WS_END, n_in, ws_size); grid = -1; return; }
        int dev = 0, cus = 0, per_cu = 0;
        (void)hipGetDevice(&dev); (void)hipDeviceGetAttribute(&cus, hipDeviceAttributeMultiprocessorCount, dev);
#if ONE_LAUNCH
        (void)hipFuncSetAttribute((const void*)fwd_megakernel<0xFFFF>, hipFuncAttributeMaxDynamicSharedMemorySize, LDS_BYTES);
        (void)hipOccupancyMaxActiveBlocksPerMultiprocessor(&per_cu, (const void*)fwd_megakernel<0xFFFF>, NTHR, LDS_BYTES);
#else
#define SETATTR(K) (void)hipFuncSetAttribute((const void*)fwd_megakernel<(1 << K)>, hipFuncAttributeMaxDynamicSharedMemorySize, LDS_BYTES)
        SETATTR(0); SETATTR(1); SETATTR(2); SETATTR(3); SETATTR(4); SETATTR(5); SETATTR(6); SETATTR(7); SETATTR(8); SETATTR(9); SETATTR(10); SETATTR(11);
        per_cu = 1;
#endif
        if (per_cu < 1) { fprintf(stderr, "kernel_launch: occupancy query says %d blocks per CU\n", per_cu); grid = -1; return; }
        grid = cus;
        (void)hipGetLastError();
    }
    if (grid < 0) return;
    (void)hipMemsetAsync((char*)d_ws + WS_MOD, 0, 4 * 12288 * 4, stream);
    (void)hipMemsetAsync((char*)d_ws + WS_BAR, 0, 16384 + 1024, stream);
    Params p{};
    for (int i = 0; i < 28; ++i) p.in[i] = (const float*)d_in[i];
    p.out = (float*)d_out; p.ws = (unsigned char*)d_ws;
#if ONE_LAUNCH
    p.ph_lo = 0; p.ph_hi = N_PHASES;
    void* args[] = {&p};
    hipError_t e = hipLaunchCooperativeKernel((const void*)fwd_megakernel<0xFFFF>, dim3(grid), dim3(NTHR), args, LDS_BYTES, stream);
    if (e != hipSuccess) fprintf(stderr, "cooperative launch failed: %s (grid %d)\n", hipGetErrorString(e), grid);
#else
#define LAUNCH1(K) hipLaunchKernelGGL(fwd_megakernel<(1 << K)>, dim3(grid), dim3(NTHR), LDS_BYTES, stream, p)
    for (int ph = 0; ph < N_PHASES; ++ph) { p.ph_lo = ph; p.ph_hi = ph + 1;
        if (ph == 0) { LAUNCH1(9); continue; }
        if (ph == 19) { LAUNCH1(10); continue; }
        switch ((ph - 1) % 9) {
        case 0: LAUNCH1(0); break; case 1: LAUNCH1(1); break; case 2: LAUNCH1(2); LAUNCH1(11); break; case 3: LAUNCH1(3); break; case 4: LAUNCH1(4); break;
        case 5: LAUNCH1(5); break; case 6: LAUNCH1(6); break; case 7: LAUNCH1(7); break; case 8: LAUNCH1(8); break; }
    }
#endif
}
```

```cpp
#include <hip/hip_runtime.h>
#include <hip/hip_cooperative_groups.h>
#include <cstdio>
#include <cstdint>
namespace cg = cooperative_groups;
__device__ __forceinline__ int otid() { int t = threadIdx.x; asm volatile("" : "+v"(t)); return t; }
namespace pg8 {
#define PG8_LAS __attribute__((address_space(3)))
typedef unsigned short bf16_t;
typedef short bf16x8 __attribute__((ext_vector_type(8)));
typedef float f32x4 __attribute__((ext_vector_type(4)));
typedef unsigned u32x4 __attribute__((ext_vector_type(4)));
constexpr int BM = 256, BK = 64, HALF = 128, HTB = HALF * BK * 2  , STAGE_BYTES = 8 * HTB, NXCD = 8, WGM = 8;

__host__ __device__ __forceinline__ int lds_byte(int r, int c) { const int st = (r >> 4) * 2 + (c >> 5), rr = r & 15, cc = c & 31, ob = rr * 64 + cc * 2; return st * 1024 + (ob ^ (((ob >> 9) & 1) << 5)); }
__host__ __device__ __forceinline__ void stage_rc(int b, int& R, int& C) { const int st = b / 1024, sb = b % 1024, swz = sb ^ (((sb >> 9) & 1) << 5); R = (st >> 1) * 16 + swz / 64; C = (st & 1) * 32 + (swz % 64) / 2; }
__host__ __device__ __forceinline__ int perm32(int rho) { const int n = rho >> 4, i = rho & 15; return 8 * (i >> 2) + 4 * n + (i & 3); }

struct Unit { int pm, pn, ko; };
struct Gemm { const bf16_t* A; const bf16_t* Bt; int M, N, K, ldk; };

struct StaticOrder {
    int nM, nN, nwg, G, c;
    __host__ __device__ void init(int M, int N, int G_, int c_) { nM = M / BM; nN = N / BM; nwg = nM * nN; G = G_; c = c_; }
    __host__ __device__ bool next(int i, Unit& u) const {
        const long L = (long)i * G + c; if (L >= nwg) return false;
        int wgid = (int)L; { const int q = nwg / NXCD, r = nwg % NXCD, xcd = wgid % NXCD, off = wgid / NXCD; wgid = (xcd < r ? xcd * (q + 1) : r * (q + 1) + (xcd - r) * q) + off; }
        const int nig = WGM * nN, gid = wgid / nig, fm = gid * WGM, gsz = (nM - fm) < WGM ? (nM - fm) : WGM;
        u.pm = fm + ((wgid % nig) % gsz); u.pn = (wgid % nig) / gsz; u.ko = 0; return true;
    }
    __device__ __forceinline__ void a_ready(const Unit&) const {}
    __device__ __forceinline__ void done(const Unit&) const {}
};


struct SplitKOrder {
    int nN, S, Kc, G, c, pm;
    __host__ __device__ void init(int N, int S_, int Kc_, int G_, int c_, int pm_) { nN = N / BM; S = S_; Kc = Kc_; G = G_; c = c_; pm = pm_; }
    __host__ __device__ bool next(int i, Unit& u) const { const long L = (long)i * G + c; if (L >= (long)nN * S) return false; u.pm = pm; u.pn = (int)L / S; u.ko = ((int)L % S) * Kc; return true; }
    __device__ __forceinline__ void a_ready(const Unit&) const {}
    __device__ __forceinline__ void done(const Unit&) const {}
};
__device__ __forceinline__ unsigned cvt_pk_bf16(float lo, float hi) { unsigned r; asm volatile("v_cvt_pk_bf16_f32 %0, %1, %2" : "=v"(r) : "v"(lo), "v"(hi)); return r; }
struct EpiF32 {
    static constexpr bool PERM = false, AFTER_DRAIN = false;
    float* O; int ldc;
    __device__ __forceinline__ void operator()(const f32x4 (&acc)[2][2][4][2], const Unit& u, int wr, int wc, int fr, int fq) const {
        const int row0 = u.pm * BM + wr * 64 + fr, col0 = u.pn * BM + wc * 32 + 4 * fq;
#pragma unroll
        for (int ai = 0; ai < 2; ++ai)
#pragma unroll
            for (int m = 0; m < 4; ++m) { float* rowp = O + (size_t)(row0 + ai * HALF + m * 16) * ldc + col0;
#pragma unroll
                for (int bj = 0; bj < 2; ++bj)
#pragma unroll
                    for (int n = 0; n < 2; ++n) *(f32x4*)(rowp + bj * HALF + n * 16) = acc[ai][bj][m][n]; }
    }
    __device__ __forceinline__ void fused(f32x4 (&)[2][2][4][2], const Unit&, int, int, int, int, PG8_LAS unsigned char*, int, int) const {}
};
struct EpiRes {
    static constexpr bool PERM = false, AFTER_DRAIN = false;
    const float* res_l; const float* res_c; float* out_l; float* out_c; const float* gate_l; const float* gate_c;
    __device__ __forceinline__ void operator()(const f32x4 (&acc)[2][2][4][2], const Unit& u, int wr, int wc, int fr, int fq) const {
        const bool isc = u.pm >= 32;
        const float* res = isc ? res_c : res_l; float* out = isc ? out_c : out_l; const float* gate = isc ? gate_c : gate_l;
        const int row0 = (isc ? u.pm - 32 : u.pm) * BM + wr * 64 + fr, col0 = u.pn * BM + wc * 32 + 4 * fq;
        f32x4 gv[2][2];
#pragma unroll
        for (int bj = 0; bj < 2; ++bj)
#pragma unroll
            for (int n = 0; n < 2; ++n) gv[bj][n] = *(const f32x4*)(gate + col0 + bj * HALF + n * 16);
#pragma unroll
        for (int ai = 0; ai < 2; ++ai)
#pragma unroll
            for (int m = 0; m < 4; ++m) { const size_t off = (size_t)(row0 + ai * HALF + m * 16) * 2048 + col0;
#pragma unroll
                for (int bj = 0; bj < 2; ++bj)
#pragma unroll
                    for (int n = 0; n < 2; ++n) { const f32x4 r = *(const f32x4*)(res + off + bj * HALF + n * 16);
                        *(f32x4*)(out + off + bj * HALF + n * 16) = r + gv[bj][n] * acc[ai][bj][m][n]; } }
    }
    __device__ __forceinline__ void fused(f32x4 (&)[2][2][4][2], const Unit&, int, int, int, int, PG8_LAS unsigned char*, int, int) const {}
};
struct EpiRelu2 {
    static constexpr bool PERM = true, AFTER_DRAIN = false;
    bf16_t* O; int ldc;
    __device__ __forceinline__ void operator()(const f32x4 (&acc)[2][2][4][2], const Unit& u, int wr, int wc, int fr, int fq) const {
        const int row0 = u.pm * BM + wr * 64 + fr, col0 = u.pn * BM + wc * 32 + 8 * fq;
#pragma unroll
        for (int ai = 0; ai < 2; ++ai)
#pragma unroll
            for (int m = 0; m < 4; ++m) { bf16_t* rowp = O + (size_t)(row0 + ai * HALF + m * 16) * ldc + col0;
#pragma unroll
                for (int bj = 0; bj < 2; ++bj) { f32x4 v0 = acc[ai][bj][m][0], v1 = acc[ai][bj][m][1];
#pragma unroll
                    for (int e = 0; e < 4; ++e) { const float a = fmaxf(v0[e], 0.f), b = fmaxf(v1[e], 0.f); v0[e] = a * a; v1[e] = b * b; }
                    u32x4 w; w.x = cvt_pk_bf16(v0[0], v0[1]); w.y = cvt_pk_bf16(v0[2], v0[3]); w.z = cvt_pk_bf16(v1[0], v1[1]); w.w = cvt_pk_bf16(v1[2], v1[3]);
                    *(u32x4*)(rowp + bj * HALF) = w; } }
    }
    __device__ __forceinline__ void fused(f32x4 (&)[2][2][4][2], const Unit&, int, int, int, int, PG8_LAS unsigned char*, int, int) const {}
};
struct EpiAtomic {
    static constexpr bool PERM = false, AFTER_DRAIN = false;
    float* out; const float* gate;
    __device__ __forceinline__ void operator()(const f32x4 (&acc)[2][2][4][2], const Unit& u, int wr, int wc, int fr, int fq) const {
        const int row0 = wr * 64 + fr, col0 = u.pn * BM + wc * 32 + 4 * fq;
        f32x4 gv[2][2];
#pragma unroll
        for (int bj = 0; bj < 2; ++bj)
#pragma unroll
            for (int n = 0; n < 2; ++n) gv[bj][n] = *(const f32x4*)(gate + col0 + bj * HALF + n * 16);
        float* o = out + (size_t)row0 * 2048 + col0;
#pragma unroll
        for (int ai = 0; ai < 2; ++ai)
#pragma unroll
            for (int m = 0; m < 4; ++m) { float* orow = o + (size_t)(ai * HALF + m * 16) * 2048; asm volatile("" : "+v"(orow));
#pragma unroll
                for (int bj = 0; bj < 2; ++bj)
#pragma unroll
                    for (int n = 0; n < 2; ++n) { const f32x4 v = gv[bj][n] * acc[ai][bj][m][n]; float* q = orow + bj * HALF + n * 16;
                        unsafeAtomicAdd(q, v.x); unsafeAtomicAdd(q + 1, v.y); unsafeAtomicAdd(q + 2, v.z); unsafeAtomicAdd(q + 3, v.w); }
                asm volatile("" ::: "memory"); }
    }
    __device__ __forceinline__ void fused(f32x4 (&)[2][2][4][2], const Unit&, int, int, int, int, PG8_LAS unsigned char*, int, int) const {}
};
template <class Epi, class Sched, bool ALIGN_EPI = false, bool SP2 = false>
__device__ __forceinline__ void gemm_phase(PG8_LAS unsigned char* lds, const Gemm g, const Sched& S, const Epi& E) {
    const int tid = otid(), wid = __builtin_amdgcn_readfirstlane(tid >> 6), lane = tid & 63, wr = wid >> 2, wc = wid & 3, fr = lane & 15, fq = lane >> 4;
    const int K = g.ldk, nt = g.K / BK;
    unsigned voffA[2], voffB[2];
#pragma unroll
    for (int i = 0; i < 2; ++i) { int R, C; stage_rc(tid * 16 + i * 8192, R, C); const int Rb = Epi::PERM ? ((R & ~31) + perm32(R & 31)) : R;
        voffA[i] = (unsigned)(R * K + C) * 2u; voffB[i] = (unsigned)(Rb * K + C) * 2u; }
    const size_t kstep = (size_t)(BK * 2);
    const size_t hstep = (size_t)HALF * K * 2;
    const size_t tstep = 2 * hstep;
    const unsigned ldsw = (unsigned)wid * 1024u;
    const int aoff = lds_byte(wr * 64 + fr, fq * 8), boff = lds_byte(wc * 32 + fr, fq * 8);
#define PG8_SA(b, h) (((b) * 2 + (h)) * HTB)
#define PG8_SB(b, h) ((4 + (b) * 2 + (h)) * HTB)
#define PG8_STAGE(bufoff, gbase, voff) do { _Pragma("unroll") for (int _i = 0; _i < 2; ++_i) \
        __builtin_amdgcn_global_load_lds((const unsigned*)((const char*)(gbase) + (voff)[_i]), (PG8_LAS unsigned*)(lds + (bufoff) + ldsw + _i * 8192), 16, 0, 0); } while (0)
#define PG8_LDA(dst, b, h) do { _Pragma("unroll") for (int m = 0; m < 4; ++m) _Pragma("unroll") for (int k = 0; k < 2; ++k) dst[m][k] = *(const PG8_LAS bf16x8*)(lds + PG8_SA(b, h) + aoff + m * 2048 + k * 1024); } while (0)
#define PG8_LDB(dst, b, h) do { _Pragma("unroll") for (int n = 0; n < 2; ++n) _Pragma("unroll") for (int k = 0; k < 2; ++k) dst[n][k] = *(const PG8_LAS bf16x8*)(lds + PG8_SB(b, h) + boff + n * 2048 + k * 1024); } while (0)
#define PG8_MMA(ai, bj, At, Bt) do { __builtin_amdgcn_s_setprio(1); _Pragma("unroll") for (int m = 0; m < 4; ++m) _Pragma("unroll") for (int n = 0; n < 2; ++n) _Pragma("unroll") for (int k = 0; k < 2; ++k) \
        acc[ai][bj][m][n] = __builtin_amdgcn_mfma_f32_16x16x32_bf16(Bt[n][k], At[m][k], acc[ai][bj][m][n], 0, 0, 0); __builtin_amdgcn_s_setprio(0); } while (0)
#define PG8_WAIT_V(n) asm volatile("s_waitcnt vmcnt(" #n ")" ::: "memory")
#define PG8_WAIT_L(n) asm volatile("s_waitcnt lgkmcnt(" #n ")" ::: "memory")
#define PG8_BAR __builtin_amdgcn_s_barrier()
#define PG8_SCHED __builtin_amdgcn_sched_barrier(0)
    Unit cur, nxt; int ui = 0;
    if (!S.next(0, cur)) return;
    f32x4 acc[2][2][4][2];
#pragma unroll
    for (int a = 0; a < 2; ++a)
#pragma unroll
        for (int b = 0; b < 2; ++b)
#pragma unroll
            for (int m = 0; m < 4; ++m)
#pragma unroll
                for (int n = 0; n < 2; ++n) acc[a][b][m][n] = (f32x4){0.f, 0.f, 0.f, 0.f};
    bf16x8 At[4][2], B0[2][2], B1[2][2];
    const char* cA = (const char*)g.A + (size_t)cur.pm * tstep + (size_t)cur.ko * 2; const char* cB = (const char*)g.Bt + (size_t)cur.pn * tstep + (size_t)cur.ko * 2;
    S.a_ready(cur);
    if constexpr (SP2) {
        PG8_STAGE(PG8_SB(0, 0), cB, voffB); PG8_STAGE(PG8_SB(0, 1), cB + hstep, voffB); PG8_STAGE(PG8_SA(0, 0), cA, voffA); PG8_STAGE(PG8_SA(0, 1), cA + hstep, voffA);
        if (wr == 1) PG8_BAR;
        PG8_WAIT_V(2); PG8_BAR;
        PG8_STAGE(PG8_SB(1, 0), cB + kstep, voffB); PG8_STAGE(PG8_SA(1, 0), cA + kstep, voffA); PG8_STAGE(PG8_SB(1, 1), cB + hstep + kstep, voffB);
        PG8_WAIT_V(6); PG8_BAR;
    } else {
        PG8_STAGE(PG8_SB(0, 0), cB, voffB); PG8_STAGE(PG8_SA(0, 0), cA, voffA); PG8_STAGE(PG8_SB(0, 1), cB + hstep, voffB); PG8_STAGE(PG8_SA(0, 1), cA + hstep, voffA);
        if (wr == 1) PG8_BAR;
        PG8_WAIT_V(4); PG8_BAR;
        PG8_STAGE(PG8_SB(1, 0), cB + kstep, voffB); PG8_STAGE(PG8_SA(1, 0), cA + kstep, voffA); PG8_STAGE(PG8_SB(1, 1), cB + hstep + kstep, voffB);
        PG8_WAIT_V(6); PG8_BAR;
    }
    for (;;) {
        const bool has_next = S.next(ui + 1, nxt);
        const char* nA = has_next ? (const char*)g.A + (size_t)nxt.pm * tstep + (size_t)nxt.ko * 2 : cA; const char* nB = has_next ? (const char*)g.Bt + (size_t)nxt.pn * tstep + (size_t)nxt.ko * 2 : cB;
        for (int t = 0; t < nt; t += 2) {
            const bool last = (t == nt - 2);
            const char* a1 = cA + (size_t)(t + 1) * kstep;
            const char* a2 = last ? nA : cA + (size_t)(t + 2) * kstep; const char* b2 = last ? nB : cB + (size_t)(t + 2) * kstep;
            const char* a3 = a2 + kstep; const char* b3 = b2 + kstep;
            if (last && has_next) S.a_ready(nxt);
            if constexpr (SP2) {
            PG8_LDB(B0, 0, 0); PG8_LDB(B1, 0, 1); PG8_SCHED; PG8_LDA(At, 0, 0); PG8_STAGE(PG8_SA(1, 1), a1 + hstep, voffA);
            PG8_WAIT_V(8); PG8_WAIT_L(0); PG8_BAR; PG8_MMA(0, 0, At, B0); PG8_MMA(0, 1, At, B1); PG8_BAR; PG8_SCHED;
            PG8_LDA(At, 0, 1); PG8_STAGE(PG8_SB(0, 0), b2, voffB); PG8_STAGE(PG8_SB(0, 1), b2 + hstep, voffB); PG8_STAGE(PG8_SA(0, 0), a2, voffA);
            PG8_WAIT_V(8); PG8_WAIT_L(0); PG8_BAR; PG8_MMA(1, 0, At, B0); PG8_MMA(1, 1, At, B1); PG8_BAR; PG8_SCHED;
            PG8_LDB(B0, 1, 0); PG8_LDB(B1, 1, 1); PG8_SCHED; PG8_LDA(At, 1, 0); PG8_STAGE(PG8_SA(0, 1), a2 + hstep, voffA);
            PG8_WAIT_V(8); PG8_WAIT_L(0); PG8_BAR; PG8_MMA(0, 0, At, B0); PG8_MMA(0, 1, At, B1); PG8_BAR; PG8_SCHED;
            PG8_LDA(At, 1, 1); PG8_STAGE(PG8_SB(1, 0), b3, voffB); PG8_STAGE(PG8_SB(1, 1), b3 + hstep, voffB); PG8_STAGE(PG8_SA(1, 0), a3, voffA);
            PG8_WAIT_V(8); PG8_WAIT_L(0); PG8_BAR; PG8_MMA(1, 0, At, B0); PG8_MMA(1, 1, At, B1); PG8_BAR; PG8_SCHED;
            } else {
            PG8_LDB(B0, 0, 0); PG8_SCHED; PG8_LDA(At, 0, 0); PG8_STAGE(PG8_SA(1, 1), a1 + hstep, voffA);
            PG8_WAIT_L(8); PG8_BAR; PG8_WAIT_L(0); PG8_MMA(0, 0, At, B0); PG8_BAR; PG8_SCHED;
            PG8_LDB(B1, 0, 1); PG8_STAGE(PG8_SB(0, 0), b2, voffB);
            PG8_BAR; PG8_WAIT_L(0); PG8_MMA(0, 1, At, B1); PG8_BAR;
            PG8_LDA(At, 0, 1); PG8_STAGE(PG8_SA(0, 0), a2, voffA);
            PG8_BAR; PG8_WAIT_L(0); PG8_MMA(1, 0, At, B0); PG8_BAR; PG8_SCHED;
            PG8_STAGE(PG8_SB(0, 1), b2 + hstep, voffB);
            PG8_WAIT_V(6); PG8_BAR; PG8_MMA(1, 1, At, B1); PG8_BAR;
            PG8_LDB(B0, 1, 0); PG8_SCHED; PG8_LDA(At, 1, 0); PG8_STAGE(PG8_SA(0, 1), a2 + hstep, voffA);
            PG8_WAIT_L(8); PG8_BAR; PG8_WAIT_L(0); PG8_MMA(0, 0, At, B0); PG8_BAR; PG8_SCHED;
            PG8_LDB(B1, 1, 1); PG8_STAGE(PG8_SB(1, 0), b3, voffB);
            PG8_BAR; PG8_WAIT_L(0); PG8_MMA(0, 1, At, B1); PG8_BAR;
            PG8_LDA(At, 1, 1); PG8_STAGE(PG8_SA(1, 0), a3, voffA);
            PG8_BAR; PG8_WAIT_L(0); PG8_MMA(1, 0, At, B0); PG8_BAR; PG8_SCHED;
            PG8_STAGE(PG8_SB(1, 1), b3 + hstep, voffB);
            PG8_WAIT_V(6); PG8_BAR; PG8_MMA(1, 1, At, B1); PG8_BAR;
            }
        }
        if constexpr (ALIGN_EPI) { if (wr == 0) PG8_BAR; }
        if constexpr (!Epi::AFTER_DRAIN) { E(acc, cur, wr, wc, fr, fq); S.done(cur); }
        if (!has_next) break;
#pragma unroll
        for (int a = 0; a < 2; ++a)
#pragma unroll
            for (int b = 0; b < 2; ++b)
#pragma unroll
                for (int m = 0; m < 4; ++m)
#pragma unroll
                    for (int n = 0; n < 2; ++n) acc[a][b][m][n] = (f32x4){0.f, 0.f, 0.f, 0.f};
        cur = nxt; cA = nA; cB = nB; ++ui;
        if constexpr (ALIGN_EPI) { if (wr == 1) PG8_BAR; }
    }
    PG8_WAIT_V(0);
    if constexpr (!ALIGN_EPI) { if (wr == 0) PG8_BAR; }
    PG8_BAR;
    if constexpr (Epi::AFTER_DRAIN) { E.fused(acc, cur, wr, wc, fr, fq, lds, wid, lane); S.done(cur); }
#undef PG8_SA
#undef PG8_SB
#undef PG8_STAGE
#undef PG8_LDA
#undef PG8_LDB
#undef PG8_MMA
#undef PG8_WAIT_V
#undef PG8_WAIT_L
#undef PG8_BAR
#undef PG8_SCHED
}
}
#define LAS __attribute__((address_space(3)))
typedef unsigned short bf16;
typedef float f32x4 __attribute__((ext_vector_type(4)));
typedef float f32x2 __attribute__((ext_vector_type(2)));
typedef short bf16x8 __attribute__((ext_vector_type(8)));
typedef unsigned v4u __attribute__((ext_vector_type(4)));
typedef unsigned v2u __attribute__((ext_vector_type(2)));

constexpr int NTHR = 512;
constexpr int LDS_BYTES = 157696;
constexpr int DM = 2048, TLAT = 8192, TCTX = 256, TTOK = 8448, PINP = 7680, DFF = 8192;
constexpr size_t MiB = 1u << 20;
constexpr size_t WS_MOD = 0;
constexpr size_t WS_DL = 256 * 1024;
constexpr size_t WS_BONUS = 512 * 1024;
constexpr size_t WS_BAR = 1536 * 1024;
constexpr size_t WS_LATC = 2 * MiB;
constexpr size_t WS_WT_IN = 4 * MiB, WS_WT_OUT = 34 * MiB, WS_WT_1 = 42 * MiB, WS_WT_2 = 74 * MiB;
constexpr size_t WS_H = 106 * MiB;
constexpr size_t WS_SZ = 139 * MiB;
constexpr size_t WS_GATE = WS_SZ + (size_t)TTOK * 1024 * 2;
constexpr size_t WS_P = 172 * MiB;
constexpr size_t WS_GDN = 420 * MiB;
constexpr size_t WS_RWD = 569 * MiB;
constexpr size_t WS_RWS = WS_RWD + (size_t)2 * 16 * TTOK * 512;
constexpr size_t WS_WSM = 752 * MiB;
constexpr size_t WS_END = WS_WSM + (size_t)2 * 1024 * 416 * 2;
static_assert(WS_RWS + (size_t)16 * TTOK * 384 <= WS_WSM, "ws map");
static_assert(WS_GATE + (size_t)TTOK * 1024 * 2 <= WS_P && WS_P + (size_t)TTOK * PINP * 4 <= WS_GDN && WS_GDN + (size_t)2 * 8 * 132 * 36864 * 2 <= WS_RWD, "ws map");
static_assert(WS_END <= 768 * MiB, "ws size");

struct Params { const float* in[28]; float* out; unsigned char* ws; int ph_lo, ph_hi; };

__device__ __forceinline__ unsigned f2bf(float f) { unsigned u = __builtin_bit_cast(unsigned, f); return (u + 0x7fffu + ((u >> 16) & 1u)) >> 16; }
__device__ __forceinline__ unsigned pk2(float lo, float hi) { return f2bf(lo) | (f2bf(hi) << 16); }
__device__ __forceinline__ float bf2f(unsigned b) { return __builtin_bit_cast(float, b << 16); }
__device__ __forceinline__ float bflo(unsigned w) { return __builtin_bit_cast(float, w << 16); }
__device__ __forceinline__ float bfhi(unsigned w) { return __builtin_bit_cast(float, w & 0xffff0000u); }
__device__ __forceinline__ float wave_sum(float v) {
#pragma unroll
    for (int o = 1; o < 64; o <<= 1) v += __shfl_xor(v, o);
    return v;
}
__device__ __forceinline__ float sigmoidf_(float x) { return 1.f / (1.f + expf(-x)); }
__device__ __forceinline__ float siluf_(float x) { return x / (1.f + expf(-x)); }
__device__ __forceinline__ float softplusf_(float x) { return x > 20.f ? x : log1pf(expf(x)); }
#define LDS_WAIT() asm volatile("s_waitcnt lgkmcnt(0)" ::: "memory")

__device__ __forceinline__ void transpose_item(const float* W, int K, int N, bf16* WT, float* scr, int item, int lane) {
    const int nblk = N / 32, kb = item / nblk, nb = item % nblk, k0 = 64 * kb, n0 = 32 * nb;
#pragma unroll 8
    for (int i = 0; i < 32; ++i) { const int kk = 2 * i + (lane >> 5); scr[kk * 33 + (lane & 31)] = W[(size_t)(k0 + kk) * N + n0 + (lane & 31)]; }
    LDS_WAIT();
    const int c = lane & 7;
#pragma unroll
    for (int j = 0; j < 4; ++j) { const int n = (lane >> 3) + 8 * j; const float* s = scr + (8 * c) * 33 + n;
        v4u o; o.x = pk2(s[0 * 33], s[1 * 33]); o.y = pk2(s[2 * 33], s[3 * 33]); o.z = pk2(s[4 * 33], s[5 * 33]); o.w = pk2(s[6 * 33], s[7 * 33]);
        *(v4u*)(WT + (size_t)(n0 + n) * K + k0 + 8 * c) = o; }
    LDS_WAIT();
}
__device__ __forceinline__ void convert_weights(const Params& p, int l, int mask, int gw, int ngw, float* scr, int lane) {
    const float* w_in = p.in[8] + (size_t)l * 2048 * 7616; const float* w_out = p.in[24] + (size_t)l * 2048 * 2048;
    const float* w1 = p.in[25] + (size_t)l * 2048 * 8192; const float* w2 = p.in[26] + (size_t)l * 8192 * 2048;
    bf16* t_in = (bf16*)(p.ws + WS_WT_IN); bf16* t_out = (bf16*)(p.ws + WS_WT_OUT); bf16* t_1 = (bf16*)(p.ws + WS_WT_1); bf16* t_2 = (bf16*)(p.ws + WS_WT_2);
    const int n0 = (mask & 1) ? 7616 : 0, n1 = (mask & 2) ? 2048 : 0, n2 = (mask & 4) ? 8192 : 0, n3 = (mask & 8) ? 8192 : 0;
    for (int it = gw; it < n0 + n1 + n2 + n3; it += ngw) {
        int r = it;
        if (r < n0) { transpose_item(w_in, 2048, 7616, t_in, scr, r, lane); continue; } r -= n0;
        if (r < n1) { transpose_item(w_out, 2048, 2048, t_out, scr, r, lane); continue; } r -= n1;
        if (r < n2) { transpose_item(w1, 2048, 8192, t_1, scr, r, lane); continue; } r -= n2;
        transpose_item(w2, 8192, 2048, t_2, scr, r, lane);
    }
}
__device__ __forceinline__ void phase0(const Params& p, float* L) {
    const int tid = otid(), lane = tid & 63, wave = tid >> 6, G = gridDim.x, b = blockIdx.x;
    for (int i = b * NTHR + tid; i < TCTX * DM / 4; i += G * NTHR) ((f32x4*)(p.ws + WS_LATC))[i] = ((const f32x4*)p.in[2])[i];
    { v4u z = {0u, 0u, 0u, 0u}; v4u* dst = (v4u*)((bf16*)(p.ws + WS_WT_IN) + (size_t)7616 * 2048);
      for (int i = b * NTHR + tid; i < 64 * 2048 / 8; i += G * NTHR) dst[i] = z; }
    convert_weights(p, 0, 1, b * 8 + wave, G * 8, L + wave * 2112, lane);
    for (int t = b * NTHR + tid; t < 2 * 52 * 1024; t += G * NTHR) {
        const int n = t & 1023, kg = (t >> 10) % 52, l = t / (52 * 1024), k0 = kg * 8;
        const float* src; int kk0;
        if (k0 < 128) { src = p.in[15] + ((size_t)(l * 2 + (k0 >> 6)) * 64) * 1024; kk0 = k0 & 63; }
        else if (k0 < 256) { src = p.in[17] + ((size_t)(l * 2 + ((k0 - 128) >> 6)) * 64) * 1024; kk0 = k0 & 63; }
        else { src = p.in[18] + (size_t)l * 160 * 1024; kk0 = k0 - 256; }
        float v[8];
#pragma unroll
        for (int e = 0; e < 8; ++e) v[e] = src[(size_t)(kk0 + e) * 1024 + n];
        *(v4u*)((bf16*)(p.ws + WS_WSM) + ((size_t)l * 1024 + n) * 416 + k0) = (v4u){pk2(v[0], v[1]), pk2(v[2], v[3]), pk2(v[4], v[5]), pk2(v[6], v[7])};
    }
    __syncthreads();
    float* sl = L; float* sc = L + 2048;
    for (int k = tid; k < 2048; k += NTHR) { sl[k] = siluf_(p.in[1][k]); sc[k] = siluf_(p.in[3][k]); }
    __syncthreads();
    for (int it = b; it < 512; it += G) {
        const int l = it >> 8, cb = (it >> 5) & 7, kr = it & 31;
        if (tid < 384) {
            const float* W = p.in[4] + ((size_t)l * 2048 + kr * 64) * 12288 + cb * 1536 + tid * 4;
            f32x4 a0 = {0.f, 0.f, 0.f, 0.f}, a1 = {0.f, 0.f, 0.f, 0.f};
#pragma unroll 16
            for (int k = 0; k < 64; ++k) { const f32x4 w = *(const f32x4*)(W + (size_t)k * 12288); a0 += sl[kr * 64 + k] * w; a1 += sc[kr * 64 + k] * w; }
            if (kr == 0) { const f32x4 bv = *(const f32x4*)(p.in[5] + l * 12288 + cb * 1536 + tid * 4); a0 += bv; a1 += bv; }
            float* m0 = (float*)(p.ws + WS_MOD) + (l * 2) * 12288 + cb * 1536 + tid * 4; float* m1 = m0 + 12288;
            unsafeAtomicAdd(m0, a0.x); unsafeAtomicAdd(m0 + 1, a0.y); unsafeAtomicAdd(m0 + 2, a0.z); unsafeAtomicAdd(m0 + 3, a0.w);
            unsafeAtomicAdd(m1, a1.x); unsafeAtomicAdd(m1 + 1, a1.y); unsafeAtomicAdd(m1 + 2, a1.z); unsafeAtomicAdd(m1 + 3, a1.w);
        }
    }
}

__device__ __forceinline__ void norm_phase(const Params& p, int l, const float* xl, const float* xc, const float* g, int sh_idx, int sc_idx, int nrows) {
    const int tid = otid(), lane = tid & 63, gw = blockIdx.x * 8 + (tid >> 6), ngw = gridDim.x * 8;
    bf16* H = (bf16*)(p.ws + WS_H);
    const float* mod = (const float*)(p.ws + WS_MOD) + (size_t)l * 2 * 12288;
    for (int row = gw; row < nrows; row += ngw) {
        const bool isc = row >= TLAT;
        const float* xr = isc ? xc + (size_t)(row - TLAT) * DM : xl + (size_t)row * DM;
        const float* md = mod + (isc ? 12288 : 0);
        f32x4 v[8]; float ss = 0.f;
#pragma unroll
        for (int j = 0; j < 8; ++j) { v[j] = ((const f32x4*)xr)[lane + 64 * j]; ss += v[j].x * v[j].x + v[j].y * v[j].y + v[j].z * v[j].z + v[j].w * v[j].w; }
        const float rstd = rsqrtf(wave_sum(ss) * (1.f / DM) + 1e-6f);
#pragma unroll
        for (int j = 0; j < 8; ++j) { const int col = 4 * (lane + 64 * j);
            const f32x4 gg = *(const f32x4*)(g + col), s1 = *(const f32x4*)(md + sc_idx * DM + col), s0 = *(const f32x4*)(md + sh_idx * DM + col);
            const f32x4 y = v[j] * rstd * gg * (1.f + s1) + s0;
            v2u o; o.x = pk2(y.x, y.y); o.y = pk2(y.z, y.w);
            *(v2u*)(H + (size_t)row * DM + col) = o; }
    }
}
__device__ __forceinline__ void final_norm(const Params& p) {
    const int tid = otid(), lane = tid & 63, gw = blockIdx.x * 8 + (tid >> 6), ngw = gridDim.x * 8;
    const float* g = p.in[27];
    for (int row = gw; row < TLAT; row += ngw) {
        float* xr = p.out + (size_t)row * DM;
        f32x4 v[8]; float ss = 0.f;
#pragma unroll
        for (int j = 0; j < 8; ++j) { v[j] = ((const f32x4*)xr)[lane + 64 * j]; ss += v[j].x * v[j].x + v[j].y * v[j].y + v[j].z * v[j].z + v[j].w * v[j].w; }
        const float rstd = rsqrtf(wave_sum(ss) * (1.f / DM) + 1e-6f);
#pragma unroll
        for (int j = 0; j < 8; ++j) { const f32x4 gg = ((const f32x4*)g)[lane + 64 * j]; ((f32x4*)xr)[lane + 64 * j] = v[j] * rstd * gg; }
    }
}
typedef __attribute__((address_space(1))) unsigned gu32;
#define XB_TMO      128
#define XB_XCNT(j)  (256  + 64 * (j))
#define XB_XSUB(j)  (1280 + 64 * (j))
#define XB_XGEN(j)  (2304 + 64 * (j))
#define XB_TOP      3328
#define XB_TOPGEN   3392
#define XCD_BAR_WORDS 3456
#define XB_SPIN_CAP (1u << 18)

__device__ __forceinline__ unsigned xb_ld(unsigned* p)              { return __hip_atomic_load(p, __ATOMIC_RELAXED, __HIP_MEMORY_SCOPE_AGENT); }
__device__ __forceinline__ unsigned xb_add(unsigned* p, unsigned v) { return __hip_atomic_fetch_add(p, v, __ATOMIC_RELAXED, __HIP_MEMORY_SCOPE_AGENT); }
__device__ __forceinline__ unsigned xb_xcc_id() { return (unsigned)__builtin_amdgcn_s_getreg((3 << 11) | 20) & 0xFu; }
#define XB_SPIN(cond, bar) do { unsigned _sp = 0; while (cond) { __builtin_amdgcn_s_sleep(1); \
    if ((++_sp & 255u) == 0u) { if (xb_ld(&(bar)[XB_TMO])) break; if (_sp > XB_SPIN_CAP) { atomicAdd(&(bar)[XB_TMO], 1u); break; } } } } while (0)

struct XcdBarrier {
    unsigned* bar; unsigned x;
    volatile LAS unsigned* st;
};

__device__ __forceinline__ XcdBarrier xcd_barrier_post(unsigned* bar, volatile LAS unsigned* st) {
    XcdBarrier b; b.bar = bar; b.x = xb_xcc_id(); b.st = st;
    if (threadIdx.x == 0) (void)xb_add(&bar[XB_XCNT(b.x)], 1u);
    return b;
}
__device__ __forceinline__ void xcd_barrier_complete(unsigned* bar, unsigned x, unsigned& nloc, unsigned& nx) {
    const unsigned G = gridDim.x * gridDim.y * gridDim.z;
    unsigned sum, cnt, mine, sp = 0u;
    for (;;) {
        sum = 0u; cnt = 0u; mine = 0u;
#pragma unroll
        for (unsigned j = 0; j < 16; ++j) { const unsigned c = xb_ld(&bar[XB_XCNT(j)]); sum += c; cnt += (c > 0u) ? 1u : 0u; mine = (j == x) ? c : mine; }
        if (sum == G) break;
        __builtin_amdgcn_s_sleep(1);
        if ((++sp & 255u) == 0u) { if (xb_ld(&bar[XB_TMO])) break; if (sp > XB_SPIN_CAP) { atomicAdd(&bar[XB_TMO], 1u); break; } }
    }
    nloc = mine > 0u ? mine : 1u; nx = cnt > 0u ? cnt : 1u;
}

__device__ __forceinline__ void xcd_barrier(const XcdBarrier& b) {
    asm volatile("s_waitcnt vmcnt(0)" ::: "memory");
    __syncthreads();
    if (threadIdx.x == 0) {
        unsigned* bar = b.bar;
        __builtin_amdgcn_s_waitcnt(0);
        unsigned nloc = b.st[0], nx = b.st[1];
        if (nloc == 0u) { xcd_barrier_complete(bar, b.x, nloc, nx); b.st[0] = nloc; b.st[1] = nx; }
        const unsigned old = xb_add(&bar[XB_XSUB(b.x)], 1u);
        const unsigned gen = old / nloc;
        if (old + 1u == (gen + 1u) * nloc) {
            __builtin_amdgcn_fence(__ATOMIC_RELEASE, "agent");
            asm volatile("s_waitcnt vmcnt(0)" ::: "memory");
            const unsigned og = xb_add(&bar[XB_TOP], 1u);
            const unsigned tg = og / nx;
            if (og + 1u == (tg + 1u) * nx) xb_add(&bar[XB_TOPGEN], 1u);
            else XB_SPIN(xb_ld(&bar[XB_TOPGEN]) == tg, bar);
            __builtin_amdgcn_fence(__ATOMIC_ACQUIRE, "agent");
            xb_add(&bar[XB_XGEN(b.x)], 1u);
            asm volatile("s_waitcnt vmcnt(0)" ::: "memory");
        } else {
            XB_SPIN(xb_ld(&bar[XB_XGEN(b.x)]) == gen, bar);
            __builtin_amdgcn_fence(__ATOMIC_ACQUIRE, "agent");
            asm volatile("s_waitcnt vmcnt(0)" ::: "memory");
        }
    }
    __syncthreads();
}

__device__ __forceinline__ void gdn_prep_item(const Params& p, int l, int item, float* L) {
    const int tid = otid(), lane = tid & 63, wave = tid >> 6;
    const int h = item & 7, ch = item >> 3;
    const bool isctx = ch >= 128;
    const int seg0 = isctx ? TLAT : 0, seglen = isctx ? TCTX : TLAT, t0 = isctx ? (ch - 128) * 64 : ch * 64;
    const float* P = (const float*)(p.ws + WS_P);
    const float* cw = p.in[9] + (size_t)l * 3 * 3072;
    float* qs = L; float* ks = L + 8448; float* KKm = L + 16896; float* QKm = L + 21056; float* TI = L + 25216;
    float* Gs = L + 33920; float* BETA = Gs + 128; float* EG = Gs + 256; float* GL = Gs + 384;
    bf16* const gd0 = (bf16*)(p.ws + WS_GDN) + ((size_t)h * 132 + (isctx ? (ch - 128) : 4 + ch)) * 36864;
    bf16* const gd1 = (bf16*)(p.ws + WS_GDN) + ((size_t)(8 + h) * 132 + (isctx ? 3 - (ch - 128) : 4 + 127 - ch)) * 36864;
#define GDP(d) ((d) ? gd1 : gd0)
    {
        const int i = tid >> 3, c0 = (tid & 7) * 16, tk = t0 + i;
        const size_t prow = (size_t)(seg0 + tk) * PINP;
#pragma unroll
        for (int which = 0; which < 2; ++which) {
            const int col = which * 1024 + h * 128 + c0;
            f32x4 y[4]; float ss = 0.f;
#pragma unroll
            for (int jj = 0; jj < 4; ++jj) {
                const f32x4 x0 = *(const f32x4*)(P + prow + col + 4 * jj);
                f32x4 xm = {0.f, 0.f, 0.f, 0.f}, xp = {0.f, 0.f, 0.f, 0.f};
                if (tk > 0) xm = *(const f32x4*)(P + prow - PINP + col + 4 * jj);
                if (tk < seglen - 1) xp = *(const f32x4*)(P + prow + PINP + col + 4 * jj);
                const f32x4 w0 = *(const f32x4*)(cw + col + 4 * jj), w1 = *(const f32x4*)(cw + 3072 + col + 4 * jj), w2 = *(const f32x4*)(cw + 6144 + col + 4 * jj);
                f32x4 t = xm * w0 + x0 * w1 + xp * w2;
                t.x = siluf_(t.x); t.y = siluf_(t.y); t.z = siluf_(t.z); t.w = siluf_(t.w);
                y[jj] = t; ss += t.x * t.x + t.y * t.y + t.z * t.z + t.w * t.w;
            }
            ss += __shfl_xor(ss, 1); ss += __shfl_xor(ss, 2); ss += __shfl_xor(ss, 4);
            const float sc = rsqrtf(ss + 1e-6f) * (which == 0 ? 0.08838834764831845f : 1.f);
            float* dst = (which ? ks : qs) + i * 132 + c0;
#pragma unroll
            for (int jj = 0; jj < 4; ++jj) *(f32x4*)(dst + 4 * jj) = y[jj] * sc;
        }
        {
            const int col = 3072 + h * 128 + c0; unsigned o[8];
#pragma unroll
            for (int jj = 0; jj < 4; ++jj) { const f32x4 z = *(const f32x4*)(P + prow + col + 4 * jj);
                o[2 * jj] = pk2(siluf_(z.x), siluf_(z.y)); o[2 * jj + 1] = pk2(siluf_(z.z), siluf_(z.w)); }
            bf16* sz = (bf16*)(p.ws + WS_SZ) + (size_t)(seg0 + tk) * 1024 + h * 128 + c0;
            *(v4u*)sz = (v4u){o[0], o[1], o[2], o[3]}; *(v4u*)(sz + 8) = (v4u){o[4], o[5], o[6], o[7]};
        }
    }
    if (tid < 128) {
        const int d = tid >> 6, ip = tid & 63, i = d ? 63 - ip : ip;
        const size_t prow = (size_t)(seg0 + t0 + i) * PINP;
        const float bb = P[prow + 4096 + d * 8 + h], al = P[prow + 4112 + d * 8 + h];
        const float A = expf(p.in[10][l * 16 + d * 8 + h]);
        float g = -A * softplusf_(al + p.in[11][l * 16 + d * 8 + h]);
#pragma unroll
        for (int o = 1; o < 64; o <<= 1) { const float t = __shfl_up(g, o); if (ip >= o) g += t; }
        Gs[d * 64 + ip] = g; BETA[d * 64 + ip] = sigmoidf_(bb); EG[d * 64 + ip] = expf(g);
        if (ip == 63) { GL[d] = g;
            const int np = isctx ? (d ? 3 - (ch - 128) : (ch - 128)) : (d ? 4 + 127 - ch : 4 + ch);
            ((float*)(p.ws + WS_DL))[(d * 8 + h) * 132 + np] = expf(g); }
    }
    __syncthreads();
    {
        const int ia = tid >> 4, jb = tid & 15;
        float akk[2][4], aqk[2][4];
#pragma unroll
        for (int a = 0; a < 2; ++a)
#pragma unroll
            for (int bq = 0; bq < 4; ++bq) { akk[a][bq] = 0.f; aqk[a][bq] = 0.f; }
        for (int c = 0; c < 128; c += 4) {
            f32x4 ki[2], qi[2], kj[4];
#pragma unroll
            for (int a = 0; a < 2; ++a) { ki[a] = *(const f32x4*)(ks + (ia + 32 * a) * 132 + c); qi[a] = *(const f32x4*)(qs + (ia + 32 * a) * 132 + c); }
#pragma unroll
            for (int bq = 0; bq < 4; ++bq) kj[bq] = *(const f32x4*)(ks + (jb + 16 * bq) * 132 + c);
#pragma unroll
            for (int a = 0; a < 2; ++a)
#pragma unroll
                for (int bq = 0; bq < 4; ++bq) {
                    akk[a][bq] += ki[a].x * kj[bq].x + ki[a].y * kj[bq].y + ki[a].z * kj[bq].z + ki[a].w * kj[bq].w;
                    aqk[a][bq] += qi[a].x * kj[bq].x + qi[a].y * kj[bq].y + qi[a].z * kj[bq].z + qi[a].w * kj[bq].w; }
        }
#pragma unroll
        for (int a = 0; a < 2; ++a)
#pragma unroll
            for (int bq = 0; bq < 4; ++bq) { KKm[(ia + 32 * a) * 65 + jb + 16 * bq] = akk[a][bq]; QKm[(ia + 32 * a) * 65 + jb + 16 * bq] = aqk[a][bq]; }
    }
    __syncthreads();
#pragma unroll 4
    for (int e = 0; e < 16; ++e) { const int idx = tid + 512 * e, d = idx >> 12, ip = (idx >> 6) & 63, jp = idx & 63;
        const int ri = d ? 63 - ip : ip, rj = d ? 63 - jp : jp;
        float v = 0.f;
        if (jp < ip) v = BETA[d * 64 + ip] * KKm[ri * 65 + rj] * expf(Gs[d * 64 + ip] - Gs[d * 64 + jp]);
        TI[d * 4352 + ip * 68 + jp] = v; }
    __syncthreads();
    if (wave < 2) {
        const int d = wave; float X[64];
        const float* Lb = TI + d * 4352;
#pragma unroll
        for (int i = 0; i < 64; ++i) {
            float acc = (i == lane) ? 1.f : 0.f;
#pragma unroll
            for (int j4 = 0; j4 < i; j4 += 4) {
                const f32x4 lv = *(const f32x4*)(Lb + i * 68 + j4);
                acc -= lv.x * X[j4];
                if (j4 + 1 < i) acc -= lv.y * X[j4 + 1];
                if (j4 + 2 < i) acc -= lv.z * X[j4 + 2];
                if (j4 + 3 < i) acc -= lv.w * X[j4 + 3];
            }
            X[i] = acc;
        }
        LDS_WAIT();
#pragma unroll
        for (int i = 0; i < 64; ++i) TI[d * 4352 + i * 68 + lane] = X[i];
    } else {
        const int t2 = tid - 128;
        for (int idx = t2; idx < 2048; idx += 384) {
            const int d = idx >> 10, ip = (idx >> 4) & 63, c8 = idx & 15, ri = d ? 63 - ip : ip; const float e = EG[d * 64 + ip];
            const f32x4 a = *(const f32x4*)(qs + ri * 132 + c8 * 8), bq = *(const f32x4*)(qs + ri * 132 + c8 * 8 + 4);
            *(v4u*)(GDP(d) + 8192 + ip * 128 + c8 * 8) = (v4u){pk2(a.x * e, a.y * e), pk2(a.z * e, a.w * e), pk2(bq.x * e, bq.y * e), pk2(bq.z * e, bq.w * e)};
        }
        for (int idx = t2; idx < 2048; idx += 384) {
            const int d = idx >> 10, c = (idx >> 3) & 127, i8 = idx & 7; const float gl = GL[d]; float v[8];
#pragma unroll
            for (int e = 0; e < 8; ++e) { const int ip = i8 * 8 + e, ri = d ? 63 - ip : ip; v[e] = ks[ri * 132 + c] * expf(gl - Gs[d * 64 + ip]); }
            *(v4u*)(GDP(d) + 16384 + c * 64 + i8 * 8) = (v4u){pk2(v[0], v[1]), pk2(v[2], v[3]), pk2(v[4], v[5]), pk2(v[6], v[7])};
        }
        for (int idx = t2; idx < 1024; idx += 384) {
            const int d = idx >> 9, ip = (idx >> 3) & 63, j8 = idx & 7, ri = d ? 63 - ip : ip; const float gi = Gs[d * 64 + ip]; float v[8];
#pragma unroll
            for (int e = 0; e < 8; ++e) { const int jp = j8 * 8 + e, rj = d ? 63 - jp : jp; v[e] = (jp <= ip) ? QKm[ri * 65 + rj] * expf(gi - Gs[d * 64 + jp]) : 0.f; }
            *(v4u*)(GDP(d) + 24576 + ip * 64 + j8 * 8) = (v4u){pk2(v[0], v[1]), pk2(v[2], v[3]), pk2(v[4], v[5]), pk2(v[6], v[7])};
        }
    }
    __syncthreads();
    {
        const int i = tid >> 3, c0 = (tid & 7) * 16, tk = t0 + i; const size_t prow = (size_t)(seg0 + tk) * PINP; const int col = 2048 + h * 128 + c0;
#pragma unroll
        for (int jj = 0; jj < 4; ++jj) {
            const f32x4 x0 = *(const f32x4*)(P + prow + col + 4 * jj);
            f32x4 xm = {0.f, 0.f, 0.f, 0.f}, xp = {0.f, 0.f, 0.f, 0.f};
            if (tk > 0) xm = *(const f32x4*)(P + prow - PINP + col + 4 * jj);
            if (tk < seglen - 1) xp = *(const f32x4*)(P + prow + PINP + col + 4 * jj);
            const f32x4 w0 = *(const f32x4*)(cw + col + 4 * jj), w1 = *(const f32x4*)(cw + 3072 + col + 4 * jj), w2 = *(const f32x4*)(cw + 6144 + col + 4 * jj);
            f32x4 t = xm * w0 + x0 * w1 + xp * w2;
            t.x = siluf_(t.x); t.y = siluf_(t.y); t.z = siluf_(t.z); t.w = siluf_(t.w);
            *(f32x4*)(qs + i * 132 + c0 + 4 * jj) = t;
        }
    }
    const int d5 = tid >> 8, tt = tid & 255, ig = d5 ? 15 - (tt >> 4) : (tt >> 4), cg = tt & 15, jmax = ig * 4 + 3;
#pragma unroll
    for (int pass = 0; pass < 2; ++pass) {
        if (pass == 1) __syncthreads();
        const float* src = pass ? qs : ks;
        f32x4 acc[4][2];
#pragma unroll
        for (int ii = 0; ii < 4; ++ii) { acc[ii][0] = (f32x4){0.f, 0.f, 0.f, 0.f}; acc[ii][1] = (f32x4){0.f, 0.f, 0.f, 0.f}; }
        for (int j = 0; j <= jmax; ++j) {
            const int rj = d5 ? 63 - j : j;
            const float cf = pass ? BETA[d5 * 64 + j] : BETA[d5 * 64 + j] * EG[d5 * 64 + j];
            const f32x4 k0 = *(const f32x4*)(src + rj * 132 + cg * 4), k1 = *(const f32x4*)(src + rj * 132 + 64 + cg * 4);
#pragma unroll
            for (int ii = 0; ii < 4; ++ii) { const float t = TI[d5 * 4352 + (ig * 4 + ii) * 68 + j] * cf; acc[ii][0] += t * k0; acc[ii][1] += t * k1; }
        }
        bf16* dst = GDP(d5) + (pass ? 28672 : 0);
#pragma unroll
        for (int ii = 0; ii < 4; ++ii) {
            *(v2u*)(dst + (ig * 4 + ii) * 128 + cg * 4) = (v2u){pk2(acc[ii][0].x, acc[ii][0].y), pk2(acc[ii][0].z, acc[ii][0].w)};
            *(v2u*)(dst + (ig * 4 + ii) * 128 + 64 + cg * 4) = (v2u){pk2(acc[ii][1].x, acc[ii][1].y), pk2(acc[ii][1].z, acc[ii][1].w)};
        }
    }
    __syncthreads();
}

__device__ __forceinline__ void rw_tok(int sf, int& prow, int& up, int& dn) {
    if (sf < TCTX) { prow = TLAT + sf; up = sf > 0 ? prow - 1 : -1; dn = sf < TCTX - 1 ? prow + 1 : -1; }
    else { const int j = sf - TCTX, r = j & 127, cc = j >> 7; prow = r * 64 + cc; up = r > 0 ? prow - 64 : -1; dn = r < 127 ? prow + 64 : -1; }
}
__device__ __forceinline__ float rw_shift(const float* P, const float* mu, int prow, int up, int dn, int col) {
    const float x = P[(size_t)prow * PINP + 4128 + col];
    const float u = up >= 0 ? P[(size_t)up * PINP + 4128 + col] : 0.f;
    const float dv = dn >= 0 ? P[(size_t)dn * PINP + 4128 + col] : 0.f;
    return x + mu[col] * (0.5f * (u + dv) - x);
}
__device__ __forceinline__ float fexp(float x) { return __expf(x); }
__device__ __forceinline__ float fsig(float x) { return __frcp_rn(1.f + __expf(-x)); }
#ifndef TSEL
#define TSEL -1
#endif
#define PSTAMP(i) do { if (TSEL >= 50 && probe && tid == 0) ((unsigned long long*)(p.ws + WS_BAR + 32768))[50 + (i)] = __builtin_amdgcn_s_memrealtime(); } while (0)
__device__ __forceinline__ void rwkv_prep_item(const Params& p, int l, int item, float* L, bool probe = false) {
    const int tid = otid(), lane = tid & 63, wave = tid >> 6, r = lane & 15, q = lane >> 4;
    const float* P = (const float*)(p.ws + WS_P);
    const float* mu = p.in[13] + (size_t)l * 3488;
    bf16* actb = (bf16*)L;
    int* tinfo = (int*)(L + 3392);
    const int sf0 = item * 16;
    PSTAMP(0);
    if (tid < 16) { int prow, up, dn; rw_tok(sf0 + tid, prow, up, dn); tinfo[tid * 4] = prow; tinfo[tid * 4 + 1] = up; tinfo[tid * 4 + 2] = dn; }
    __syncthreads();
#pragma unroll
    for (int i = 0; i < 13; ++i) { const int e = tid + 512 * i, t = e / 416, cc = e - t * 416;
        const int prow = tinfo[t * 4], up = tinfo[t * 4 + 1], dn = tinfo[t * 4 + 2];
        float v = rw_shift(P, mu, prow, up, dn, 3072 + cc);
        if (cc < 128) v = 1.f - 2.f * __frcp_rn(__expf(2.f * v) + 1.f); else if (cc >= 256) v = fsig(v);
        actb[t * 424 + cc] = (bf16)f2bf(v); }
    __syncthreads();
    PSTAMP(1);
    const int prow = tinfo[r * 4], up = tinfo[r * 4 + 1], dn = tinfo[r * 4 + 2], sf = sf0 + r;
    const int s1 = sf < TCTX ? TCTX - 1 - sf : 8703 - sf;
    const float mup = up >= 0 ? 0.5f : 0.f, mdn = dn >= 0 ? 0.5f : 0.f;
    const float* Pr = P + (size_t)prow * PINP + 4128; const float* Pu = P + (size_t)(up >= 0 ? up : prow) * PINP + 4128; const float* Pd = P + (size_t)(dn >= 0 ? dn : prow) * PINP + 4128;
    const bf16* Wsm = (const bf16*)(p.ws + WS_WSM) + (size_t)l * 1024 * 416;
    const float* w0p = p.in[14] + (size_t)l * 2048; const float* a0p = p.in[16] + (size_t)l * 2048;
    const float* k_k = p.in[19] + (size_t)l * 1024; const float* k_a = p.in[20] + (size_t)l * 1024; const float* r_k = p.in[21] + (size_t)l * 1024;
#pragma unroll 1
    for (int hi = 0; hi < 2; ++hi) {
        const int hh = wave * 2 + hi;
        f32x4 acc[4][5];
#pragma unroll
        for (int ct = 0; ct < 4; ++ct)
#pragma unroll
            for (int m = 0; m < 5; ++m) acc[ct][m] = (f32x4){0.f, 0.f, 0.f, 0.f};
#pragma unroll
        for (int kk = 0; kk < 13; ++kk) {
            const bf16x8 bfr = *(const bf16x8*)(actb + r * 424 + kk * 32 + 8 * q);
            constexpr int MAT[13] = {0, 0, 1, 1, 2, 2, 3, 3, 4, 4, 4, 4, 4};
#pragma unroll
            for (int ct = 0; ct < 4; ++ct) {
                const bf16x8 afr = *(const bf16x8*)(Wsm + (size_t)(hh * 64 + ct * 16 + r) * 416 + kk * 32 + 8 * q);
                acc[ct][MAT[kk]] = __builtin_amdgcn_mfma_f32_16x16x32_bf16(afr, bfr, acc[ct][MAT[kk]], 0, 0, 0);
            }
            if ((kk & 3) == 3) asm volatile("" ::: "memory");
        }
        if (hi == 0) PSTAMP(2);
        f32x4 kv[4], rv[4], vv[4]; float ss = 0.f;
#pragma unroll
        for (int ct = 0; ct < 4; ++ct) { const int c = hh * 64 + ct * 16 + 4 * q;
#pragma unroll
            for (int ten = 0; ten < 3; ++ten) { const int cc = ten * 1024 + c;
                const f32x4 x = *(const f32x4*)(Pr + cc), u = *(const f32x4*)(Pu + cc), dv = *(const f32x4*)(Pd + cc), m = *(const f32x4*)(mu + cc);
                const f32x4 y = x + m * (u * mup + dv * mdn - x);
                if (ten == 0) rv[ct] = y; else if (ten == 1) kv[ct] = y; else vv[ct] = y; }
            const f32x4 kkr = kv[ct] * *(const f32x4*)(k_k + c);
            ss += kkr.x * kkr.x + kkr.y * kkr.y + kkr.z * kkr.z + kkr.w * kkr.w;
            if (ct & 1) asm volatile("" ::: "memory"); }
        ss += __shfl_xor(ss, 16); ss += __shfl_xor(ss, 32);
        if (hi == 0) PSTAMP(3);
        const float rn = rsqrtf(ss + 1e-6f);
        unsigned char* rd0 = p.ws + WS_RWD + ((size_t)hh * TTOK + sf) * 512; unsigned char* rd1 = p.ws + WS_RWD + ((size_t)(16 + hh) * TTOK + s1) * 512;
        unsigned char* rs = p.ws + WS_RWS + ((size_t)hh * TTOK + sf) * 384;
        bf16* gt = (bf16*)(p.ws + WS_GATE) + (size_t)prow * 1024;
        float bon = 0.f;
#pragma unroll
        for (int ct = 0; ct < 4; ++ct) { const int c = hh * 64 + ct * 16 + 4 * q, co = ct * 16 + 4 * q;
            const f32x4 kkv = kv[ct] * *(const f32x4*)(k_k + c) * rn, ka = *(const f32x4*)(k_a + c), rk = *(const f32x4*)(r_k + c);
            f32x4 ksum = {0.f, 0.f, 0.f, 0.f};
#pragma unroll
            for (int d = 0; d < 2; ++d) {
                const f32x4 xw = *(const f32x4*)(w0p + d * 1024 + c) + acc[ct][d], xa = *(const f32x4*)(a0p + d * 1024 + c) + acc[ct][2 + d];
                f32x4 dec, kd, nk;
#pragma unroll
                for (int j = 0; j < 4; ++j) { const float y = -xw[j]; const float sp = y > 20.f ? y : __logf(1.f + __expf(y));
                    dec[j] = __expf(-__expf(-sp - 0.5f));
                    const float a = fsig(xa[j]); kd[j] = kv[ct][j] * (1.f + (a - 1.f) * ka[j]); nk[j] = -(kkv[j] * a); }
                ksum += kd;
                unsigned char* rd = d ? rd1 : rd0;
                *(f32x4*)(rd + co * 4) = dec;
                *(v2u*)(rd + 256 + co * 2) = (v2u){pk2(kd.x, kd.y), pk2(kd.z, kd.w)};
                *(v2u*)(rd + 384 + co * 2) = (v2u){pk2(nk.x, nk.y), pk2(nk.z, nk.w)};
            }
            const f32x4 bt = rv[ct] * ksum * rk; bon += (bt.x + bt.y) + (bt.z + bt.w);
            *(v2u*)(rs + co * 2) = (v2u){pk2(rv[ct].x, rv[ct].y), pk2(rv[ct].z, rv[ct].w)};
            *(v2u*)(rs + 128 + co * 2) = (v2u){pk2(kkv.x, kkv.y), pk2(kkv.z, kkv.w)};
            *(v2u*)(rs + 256 + co * 2) = (v2u){pk2(vv[ct].x, vv[ct].y), pk2(vv[ct].z, vv[ct].w)};
            *(v2u*)(gt + c) = (v2u){pk2(acc[ct][4].x, acc[ct][4].y), pk2(acc[ct][4].z, acc[ct][4].w)};
            asm volatile("" ::: "memory");
        }
        bon += __shfl_xor(bon, 16); bon += __shfl_xor(bon, 32);
        if (q == 0) ((float*)(p.ws + WS_BONUS))[prow * 16 + hh] = bon;
        if (hi == 0) PSTAMP(4);
    }
    PSTAMP(5);
    __syncthreads();
    PSTAMP(6);
}
#define LDS_BARRIER() do { asm volatile("s_waitcnt lgkmcnt(0)" ::: "memory"); __builtin_amdgcn_s_barrier(); asm volatile("" ::: "memory"); } while (0)
__device__ __forceinline__ f32x4 mfma16(bf16x8 a, bf16x8 b, f32x4 c) { return __builtin_amdgcn_mfma_f32_16x16x32_bf16(a, b, c, 0, 0, 0); }
__device__ __forceinline__ void gdn_scan(const Params& p, int b, unsigned char* lds) {
    const int tid = otid(), lane = tid & 63, wave = tid >> 6, r = lane & 15, q = lane >> 4;
    const int s = b & 3, h = (b >> 2) & 7, d = b >> 5;
    bf16* Wb = (bf16*)lds; bf16* Qb = Wb + 2 * 8704; bf16* KTb = Qb + 2 * 8704; bf16* Ab = KTb + 2 * 9216; bf16* Ub = Ab + 2 * 4608; bf16* ST = Ub + 2 * 2560; bf16* VT = ST + 4352;
    const bf16* G = (const bf16*)(p.ws + WS_GDN) + (size_t)((d * 8 + h) * 132) * 36864;
    const float* DLp = (const float*)(p.ws + WS_DL) + (d * 8 + h) * 132;
    float* O = (float*)(p.ws + WS_P) + (size_t)d * TTOK * 1024 + h * 128 + s * 32;
    for (int e = tid; e < 4352; e += NTHR) ST[e] = 0;
    f32x4 S0 = {0.f, 0.f, 0.f, 0.f}, S1 = {0.f, 0.f, 0.f, 0.f};
    v4u pw0, pw1, pq0, pq1, pk0, pk1, pa, pu;
    pu = (v4u){0u, 0u, 0u, 0u};
#define GDN_LOAD(n) do { const bf16* g_ = G + (size_t)(n) * 36864; \
        pw0 = *(const v4u*)(g_ + tid * 8); pw1 = *(const v4u*)(g_ + (tid + 512) * 8); \
        pq0 = *(const v4u*)(g_ + 8192 + tid * 8); pq1 = *(const v4u*)(g_ + 8192 + (tid + 512) * 8); \
        pk0 = *(const v4u*)(g_ + 16384 + tid * 8); pk1 = *(const v4u*)(g_ + 16384 + (tid + 512) * 8); \
        pa = *(const v4u*)(g_ + 24576 + tid * 8); \
        if (tid < 256) pu = *(const v4u*)(g_ + 28672 + (tid >> 2) * 128 + s * 32 + (tid & 3) * 8); } while (0)
#define GDN_STORE(bf) do { \
        *(v4u*)(Wb + (bf) * 8704 + (tid >> 4) * 136 + (tid & 15) * 8) = pw0; *(v4u*)(Wb + (bf) * 8704 + ((tid + 512) >> 4) * 136 + (tid & 15) * 8) = pw1; \
        *(v4u*)(Qb + (bf) * 8704 + (tid >> 4) * 136 + (tid & 15) * 8) = pq0; *(v4u*)(Qb + (bf) * 8704 + ((tid + 512) >> 4) * 136 + (tid & 15) * 8) = pq1; \
        *(v4u*)(KTb + (bf) * 9216 + (tid >> 3) * 72 + (tid & 7) * 8) = pk0; *(v4u*)(KTb + (bf) * 9216 + ((tid + 512) >> 3) * 72 + (tid & 7) * 8) = pk1; \
        *(v4u*)(Ab + (bf) * 4608 + (tid >> 3) * 72 + (tid & 7) * 8) = pa; \
        if (tid < 256) *(v4u*)(Ub + (bf) * 2560 + (tid >> 2) * 40 + (tid & 3) * 8) = pu; } while (0)
    GDN_LOAD(0); GDN_STORE(0);
    __syncthreads();
    const int mi = wave >> 1, nv = wave & 1;
    for (int n = 0; n < 132; ++n) {
        const int bf = n & 1;
        if (n + 1 < 132) GDN_LOAD(n + 1);
        const float dl = DLp[n];
        f32x4 co = {0.f, 0.f, 0.f, 0.f}, cv = {0.f, 0.f, 0.f, 0.f};
#pragma unroll
        for (int kk = 0; kk < 4; ++kk) {
            const bf16x8 sa = *(const bf16x8*)(ST + (16 * nv + r) * 136 + kk * 32 + 8 * q);
            const bf16x8 qa = *(const bf16x8*)(Qb + bf * 8704 + (16 * mi + r) * 136 + kk * 32 + 8 * q);
            const bf16x8 wb = *(const bf16x8*)(Wb + bf * 8704 + (16 * mi + r) * 136 + kk * 32 + 8 * q);
            co = mfma16(qa, sa, co);
            cv = mfma16(sa, wb, cv);
        }
        {
            const v2u uu = *(const v2u*)(Ub + bf * 2560 + (16 * mi + r) * 40 + 16 * nv + 4 * q);
            const float v0 = bflo(uu.x) - cv.x, v1 = bfhi(uu.x) - cv.y, v2 = bflo(uu.y) - cv.z, v3 = bfhi(uu.y) - cv.w;
            bf16* vt = VT + (16 * nv + 4 * q) * 72 + 16 * mi + r;
            vt[0] = (bf16)f2bf(v0); vt[72] = (bf16)f2bf(v1); vt[144] = (bf16)f2bf(v2); vt[216] = (bf16)f2bf(v3);
        }
        LDS_BARRIER();
#pragma unroll
        for (int kk = 0; kk < 2; ++kk) {
            const bf16x8 aa = *(const bf16x8*)(Ab + bf * 4608 + (16 * mi + r) * 72 + kk * 32 + 8 * q);
            const bf16x8 vb = *(const bf16x8*)(VT + (16 * nv + r) * 72 + kk * 32 + 8 * q);
            co = mfma16(aa, vb, co);
        }
        {
            const bool cx = n < 4;
#pragma unroll
            for (int j = 0; j < 4; ++j) { const int ip = 16 * mi + 4 * q + j;
                const int tok = d == 0 ? (cx ? TLAT + n * 64 + ip : (n - 4) * 64 + ip) : (cx ? TLAT + (3 - n) * 64 + 63 - ip : (131 - n) * 64 + 63 - ip);
                O[(size_t)tok * 1024 + 16 * nv + r] = co[j]; }
        }
#pragma unroll
        for (int e = 0; e < 2; ++e) {
            f32x4 Sv = (e ? S1 : S0) * dl; const int nk = 2 * mi + e;
#pragma unroll
            for (int kk = 0; kk < 2; ++kk) {
                const bf16x8 va = *(const bf16x8*)(VT + (16 * nv + r) * 72 + kk * 32 + 8 * q);
                const bf16x8 kb = *(const bf16x8*)(KTb + bf * 9216 + (16 * nk + r) * 72 + kk * 32 + 8 * q);
                Sv = mfma16(va, kb, Sv);
            }
            if (e) S1 = Sv; else S0 = Sv;
            bf16* st = ST + (16 * nv + 4 * q) * 136 + 16 * nk + r;
            st[0] = (bf16)f2bf(Sv.x); st[136] = (bf16)f2bf(Sv.y); st[272] = (bf16)f2bf(Sv.z); st[408] = (bf16)f2bf(Sv.w);
        }
        if (n + 1 < 132) GDN_STORE(bf ^ 1);
        LDS_BARRIER();
    }
}
__device__ __forceinline__ float red16(float x) {
    x += __builtin_bit_cast(float, __builtin_amdgcn_update_dpp(0, __builtin_bit_cast(int, x), 0x128, 0xf, 0xf, false));
    x += __builtin_bit_cast(float, __builtin_amdgcn_update_dpp(0, __builtin_bit_cast(int, x), 0x124, 0xf, 0xf, false));
    x += __builtin_bit_cast(float, __builtin_amdgcn_update_dpp(0, __builtin_bit_cast(int, x), 0x122, 0xf, 0xf, false));
    x += __builtin_bit_cast(float, __builtin_amdgcn_update_dpp(0, __builtin_bit_cast(int, x), 0x121, 0xf, 0xf, false));
    return x;
}
__device__ __forceinline__ void rwkv_compute_chunk(const float* buf, float* opb, int rl, int kg, f32x4& S) {
    constexpr int TB = 32, SF = 336;
    const float* sp = buf + 4 * kg; const float* vp = buf + 320 + rl; float* op = opb + rl * 17 + kg;
    f32x4 w = *(const f32x4*)sp, kd = *(const f32x4*)(sp + 64), nk = *(const f32x4*)(sp + 128), rr = *(const f32x4*)(sp + 192), kk = *(const f32x4*)(sp + 256);
    float v = vp[0];
#pragma unroll
    for (int st = 0; st < TB; ++st) {
        const int sn = st < TB - 1 ? st + 1 : st;
        const f32x4 w_n = *(const f32x4*)(sp + sn * SF), kd_n = *(const f32x4*)(sp + sn * SF + 64), nk_n = *(const f32x4*)(sp + sn * SF + 128),
                    rr_n = *(const f32x4*)(sp + sn * SF + 192), kk_n = *(const f32x4*)(sp + sn * SF + 256);
        const float v_n = vp[sn * SF];
        f32x2 d2 = (f32x2){S.x, S.y} * (f32x2){kk.x, kk.y};
        d2 = (f32x2){S.z, S.w} * (f32x2){kk.z, kk.w} + d2;
        const float dot = red16(d2.x + d2.y);
        S = S * w + v * kd + dot * nk;
        f32x2 o2 = (f32x2){S.x, S.y} * (f32x2){rr.x, rr.y};
        o2 = (f32x2){S.z, S.w} * (f32x2){rr.z, rr.w} + o2;
        op[st * 272] = o2.x + o2.y;
        w = w_n; kd = kd_n; nk = nk_n; rr = rr_n; kk = kk_n; v = v_n;
    }
}
__device__ __forceinline__ void rwkv_scan(const Params& p, int b, float* L) {
    const int tid = otid(), lane = tid & 63, wave = tid >> 6;
    const int pair = b >> 2, qt = b & 3, d = pair >> 4, h = pair & 15;
    const unsigned char* RD = p.ws + WS_RWD + (size_t)(d * 16 + h) * TTOK * 512;
    const unsigned char* RS = p.ws + WS_RWS + (size_t)h * TTOK * 384;
    float* O = (float*)(p.ws + WS_P) + (size_t)(2 + d) * TTOK * 1024 + h * 64 + qt * 16;
    constexpr int TB = 32, SF = 336, NCH = TTOK / TB;
    float* OP = L + 2 * TB * SF;
    const int rl = (wave & 3) * 4 + (lane >> 4), kg = lane & 15;
    const int lt = tid - 256;
    float* const dummy = L + 2 * TB * SF + 2 * TB * 272;
    int so[7], dofA[7], dofB[7]; bool isd[7];
#pragma unroll
    for (int i = 0; i < 7; ++i) { const int u = lt + 256 * i, st = u / 50, x = u % 50, sg = d ? -st : st; const bool valid = u < TB * 50;
        so[i] = !valid ? 0 : (x < 32 ? st * 512 + x * 16 : (x < 48 ? sg * 384 + (x - 32) * 16 : sg * 384 + 256 + qt * 32 + (x - 48) * 16));
        isd[i] = !valid || x < 32;
        const int base = st * SF + (x < 16 ? x * 4 : (x < 32 ? 64 + (x - 16) * 8 : (x < 48 ? 192 + (x - 32) * 8 : 320 + (x - 48) * 8)));
        dofA[i] = valid ? base : -1;
        dofB[i] = (valid && x >= 16) ? base + 4 : -1; }
    v4u ldA[7], ldB[7];
#define RW_LOADSET(ld, cc_) do { const int c_ = (cc_) < NCH ? (cc_) : NCH - 1; const unsigned char* rdb = RD + (size_t)c_ * (TB * 512); \
        const int sfb = d == 0 ? c_ * TB : (c_ < 8 ? TCTX - 1 - c_ * TB : 8703 - c_ * TB); const unsigned char* rsb = RS + (size_t)sfb * 384; \
        _Pragma("unroll") for (int i = 0; i < 7; ++i) ld[i] = *(const v4u*)((isd[i] ? rdb : rsb) + so[i]); } while (0)
#define RW_STORESET(ld, cc_) do { const bool live = (cc_) < NCH; float* buf = L + ((cc_) & 1) * (TB * SF); \
        _Pragma("unroll") for (int i = 0; i < 7; ++i) { const v4u v = ld[i]; const bool f32u = dofB[i] < 0; \
            float* d0 = (live && dofA[i] >= 0) ? buf + dofA[i] : dummy; float* d1 = (live && dofB[i] >= 0) ? buf + dofB[i] : dummy; \
            const f32x4 lo = {bflo(v.x), bfhi(v.x), bflo(v.y), bfhi(v.y)}, hi = {bflo(v.z), bfhi(v.z), bflo(v.w), bfhi(v.w)}; \
            *(f32x4*)d0 = f32u ? __builtin_bit_cast(f32x4, v) : lo; *(f32x4*)d1 = hi; } } while (0)
#define RW_ITER(c, LSET, SSET) do { \
        if (wave >= 4) { \
            RW_LOADSET(LSET, (c) + 2); \
            {     \
                const int cm = (c) >= 1 ? (c) - 1 : 0; const float* op = OP + (cm & 1) * (TB * 272); \
                const int st = lt >> 3, r2 = (lt & 7) * 2, s = cm * TB + st; float o[2]; \
                _Pragma("unroll") for (int e = 0; e < 2; ++e) { const float* q = op + st * 272 + (r2 + e) * 17; float a_ = 0.f, b_ = 0.f; \
                    _Pragma("unroll") for (int k_ = 0; k_ < 16; k_ += 2) { a_ += q[k_]; b_ += q[k_ + 1]; } o[e] = a_ + b_; } \
                const int j = s < TCTX ? 0 : (d ? 8447 - s : s - TCTX); \
                const int tok = s < TCTX ? TLAT + (d ? TCTX - 1 - s : s) : (j & 127) * 64 + (j >> 7); \
                *(f32x2*)(O + (size_t)tok * 1024 + r2) = (f32x2){o[0], o[1]}; } \
            RW_STORESET(SSET, (c) + 1); \
        } else if ((c) >= 0 && (c) < NCH) { rwkv_compute_chunk(L + ((c) & 1) * (TB * SF), OP + ((c) & 1) * (TB * 272), rl, kg, S); } \
        LDS_BARRIER(); } while (0)
    f32x4 S = {0.f, 0.f, 0.f, 0.f};
    if (wave >= 4) RW_LOADSET(ldA, 0);
    for (int c = -1; c <= NCH; c += 2) { RW_ITER(c, ldB, ldA); RW_ITER(c + 1, ldA, ldB); }
    __syncthreads();
}

#define DPP_ADD(x, CTRL) ((x) + __builtin_bit_cast(float, __builtin_amdgcn_update_dpp(0, __builtin_bit_cast(int, (x)), (CTRL), 0xf, 0xf, false)))
__device__ __forceinline__ void combine_phase(const Params& p, int l, int ntok) {
    const int tid = otid(), lane = tid & 63, gw = blockIdx.x * 8 + (tid >> 6), ngw = gridDim.x * 8;
    const float* OG = (const float*)(p.ws + WS_P); const float* OR = OG + (size_t)2 * TTOK * 1024;
    const bf16* SZ = (const bf16*)(p.ws + WS_SZ); const bf16* GT = (const bf16*)(p.ws + WS_GATE);
    const float* BON = (const float*)(p.ws + WS_BONUS);
    bf16* Y = (bf16*)(p.ws + WS_H);
    const int c0 = lane * 16, hr = lane >> 2;
    f32x4 ng[4], lg[4], lb[4];
#pragma unroll
    for (int e = 0; e < 4; ++e) { ng[e] = *(const f32x4*)(p.in[12] + (size_t)l * 128 + (lane & 7) * 16 + 4 * e);
        lg[e] = *(const f32x4*)(p.in[22] + (size_t)l * 1024 + c0 + 4 * e); lb[e] = *(const f32x4*)(p.in[23] + (size_t)l * 1024 + c0 + 4 * e); }
    for (int tok = gw; tok < ntok; tok += ngw) {
        const int sf = tok >= TLAT ? tok - TLAT : TCTX + (tok & 63) * 128 + (tok >> 6);
        const float* of = OG + (size_t)tok * 1024 + c0; const float* ob = of + (size_t)TTOK * 1024;
        const float* rf = OR + (size_t)tok * 1024 + c0; const float* rb = rf + (size_t)TTOK * 1024;
        f32x4 a[4], o[4];
#pragma unroll
        for (int e = 0; e < 4; ++e) { a[e] = *(const f32x4*)(of + 4 * e) + *(const f32x4*)(ob + 4 * e); o[e] = *(const f32x4*)(rf + 4 * e) + *(const f32x4*)(rb + 4 * e); }
        const v4u sz0 = *(const v4u*)(SZ + (size_t)tok * 1024 + c0), sz1 = *(const v4u*)(SZ + (size_t)tok * 1024 + c0 + 8);
        const v4u gt0 = *(const v4u*)(GT + (size_t)tok * 1024 + c0), gt1 = *(const v4u*)(GT + (size_t)tok * 1024 + c0 + 8);
        const unsigned char* vrec = p.ws + WS_RWS + ((size_t)hr * TTOK + sf) * 384 + 256 + (lane & 3) * 32;
        const v4u vv0 = *(const v4u*)vrec, vv1 = *(const v4u*)(vrec + 16);
        const float bonus = BON[tok * 16 + hr];
        float ss = 0.f;
#pragma unroll
        for (int e = 0; e < 4; ++e) ss += a[e].x * a[e].x + a[e].y * a[e].y + a[e].z * a[e].z + a[e].w * a[e].w;
        ss = DPP_ADD(ss, 0xB1); ss = DPP_ADD(ss, 0x4E); ss = DPP_ADD(ss, 0x141);
        const float rstd = rsqrtf(ss * (1.f / 128.f) + 1e-6f);
        const unsigned szw[8] = {sz0.x, sz0.y, sz0.z, sz0.w, sz1.x, sz1.y, sz1.z, sz1.w};
        unsigned yo[8];
#pragma unroll
        for (int e = 0; e < 4; ++e) { const f32x4 y = a[e] * rstd * ng[e];
            yo[2 * e] = pk2(y.x * bflo(szw[2 * e]), y.y * bfhi(szw[2 * e])); yo[2 * e + 1] = pk2(y.z * bflo(szw[2 * e + 1]), y.w * bfhi(szw[2 * e + 1])); }
        *(v4u*)(Y + (size_t)tok * 2048 + c0) = (v4u){yo[0], yo[1], yo[2], yo[3]}; *(v4u*)(Y + (size_t)tok * 2048 + c0 + 8) = (v4u){yo[4], yo[5], yo[6], yo[7]};
        float sm = 0.f;
#pragma unroll
        for (int e = 0; e < 4; ++e) sm += (o[e].x + o[e].y) + (o[e].z + o[e].w);
        sm = DPP_ADD(sm, 0xB1); sm = DPP_ADD(sm, 0x4E);
        const float mean = sm * (1.f / 64.f); float sv = 0.f;
#pragma unroll
        for (int e = 0; e < 4; ++e) { o[e] = o[e] - mean; sv += o[e].x * o[e].x + o[e].y * o[e].y + o[e].z * o[e].z + o[e].w * o[e].w; }
        sv = DPP_ADD(sv, 0xB1); sv = DPP_ADD(sv, 0x4E);
        const float rs2 = rsqrtf(sv * (1.f / 64.f) + 64e-5f);
        const unsigned vw[8] = {vv0.x, vv0.y, vv0.z, vv0.w, vv1.x, vv1.y, vv1.z, vv1.w}, gw8[8] = {gt0.x, gt0.y, gt0.z, gt0.w, gt1.x, gt1.y, gt1.z, gt1.w};
#pragma unroll
        for (int e = 0; e < 4; ++e) { const f32x4 y = o[e] * rs2 * lg[e] + lb[e];
            yo[2 * e] = pk2((y.x + bonus * bflo(vw[2 * e])) * bflo(gw8[2 * e]), (y.y + bonus * bfhi(vw[2 * e])) * bfhi(gw8[2 * e]));
            yo[2 * e + 1] = pk2((y.z + bonus * bflo(vw[2 * e + 1])) * bflo(gw8[2 * e + 1]), (y.w + bonus * bfhi(vw[2 * e + 1])) * bfhi(gw8[2 * e + 1])); }
        *(v4u*)(Y + (size_t)tok * 2048 + 1024 + c0) = (v4u){yo[0], yo[1], yo[2], yo[3]}; *(v4u*)(Y + (size_t)tok * 2048 + 1024 + c0 + 8) = (v4u){yo[4], yo[5], yo[6], yo[7]};
    }
}
#ifndef ONE_LAUNCH
#define ONE_LAUNCH 1
#endif
constexpr int N_PHASES = 20;
#if ONE_LAUNCH
#define PH(k) (true)
#ifndef TSEL
#define TSEL -1
#endif
#ifndef TSCALE
#define TSCALE 0.0003f
#endif
#define STAMP(k) do { if (TSEL >= 0 && blockIdx.x == 0 && threadIdx.x == 0) ((unsigned long long*)(p.ws + WS_BAR + 32768))[(k)] = __builtin_amdgcn_s_memrealtime(); } while (0)
#define SEAM(k) do { xcd_barrier(gbar); STAMP((k) + 1); } while (0)
#else
#define PH(k) (p.ph_lo == (k))
#define SEAM(k) do {} while (0)
#endif
#define PHON(k) ((PHMASK >> (k)) & 1)
#ifndef DUPMASK
#define DUPMASK 0
#endif
#define REP(k) for (int rep_ = 0; rep_ <= ((DUPMASK >> (k)) & 1); ++rep_) if (rep_ == 0 || (cg::this_grid().sync(), true))
template <int PHMASK, int l> __device__ __forceinline__ void layer_phases(const Params& p, unsigned char* lds, const XcdBarrier& gbar) {
    float* L = (float*)lds;
    const int b = blockIdx.x, G = gridDim.x;
    float* lat_c = (float*)(p.ws + WS_LATC);
    const float* mod = (const float*)(p.ws + WS_MOD);
    constexpr int M = l == 0 ? TTOK : TLAT;
    constexpr int B0 = 1 + 9 * l;
    const float* res_l = l == 0 ? p.in[0] : p.out; const float* res_c = l == 0 ? p.in[2] : lat_c;
    const float* mod_l = mod + (size_t)(l * 2) * 12288; const float* mod_c = mod_l + 12288;
    REP(0) if (PH(B0 + 0) && PHON(0)) {
        norm_phase(p, l, res_l, res_c, p.in[6] + (size_t)l * DM, 0, 1, TTOK);
    }
    SEAM(B0 + 0);
    REP(1) if (PH(B0 + 1) && PHON(1)) {
        pg8::Gemm g{(const pg8::bf16_t*)(p.ws + WS_H), (const pg8::bf16_t*)(p.ws + WS_WT_IN), TTOK, PINP, DM, DM}; pg8::StaticOrder S; S.init(TTOK, PINP, G, b);
        pg8::EpiF32 E{(float*)(p.ws + WS_P), PINP};
        pg8::gemm_phase<pg8::EpiF32, pg8::StaticOrder, true, true>((PG8_LAS unsigned char*)lds, g, S, E);
    }
    SEAM(B0 + 1);
    REP(2) if (PH(B0 + 2)) {
#if ONE_LAUNCH
        {
            unsigned* qctr = (unsigned*)(p.ws + WS_BAR + 16384) + l * 64;
            volatile LAS unsigned* qslot = (volatile LAS unsigned*)((LAS unsigned char*)lds + LDS_BYTES - 8);
            bool rwfirst_ = true;
            for (;;) {
                if (threadIdx.x == 0) *qslot = atomicAdd(qctr, 1u);
                __syncthreads();
                const unsigned it = *qslot;
                __syncthreads();
                if (it >= 1584u) break;
                unsigned long long t0_ = 0; if (TSEL >= 44) t0_ = __builtin_amdgcn_s_memrealtime();
                if (it < 528u) rwkv_prep_item(p, l, (int)it, L, TSEL >= 50 && l == 0 && blockIdx.x == 0 && rwfirst_); else gdn_prep_item(p, l, (int)it - 528, L);
                if (it < 528u) rwfirst_ = false;
                if (TSEL >= 44 && l == 0 && blockIdx.x == 0 && threadIdx.x == 0) { unsigned long long* ts = (unsigned long long*)(p.ws + WS_BAR + 32768); const int sl_ = it < 528u ? 44 : 45;
                    if (ts[sl_ + 4] != 0x5151ull) { ts[sl_ + 4] = 0x5151ull; ts[sl_] = __builtin_amdgcn_s_memrealtime() - t0_; } }
            }
        }
#else
        if (PHON(2)) for (int it = b; it < 528; it += G) rwkv_prep_item(p, l, it, L);
        if (PHON(11)) for (int it = b; it < 1056; it += G) gdn_prep_item(p, l, it, L);
#endif
    }
    SEAM(B0 + 2);
    REP(3) if (PH(B0 + 3) && PHON(3)) {
        if (b < 64) for (int r2_ = 0; r2_ <= ((DUPMASK >> 12) & 1); ++r2_) { if (r2_) __syncthreads(); gdn_scan(p, b, lds); }
        if (b >= 64 && b < 192) for (int r2_ = 0; r2_ <= ((DUPMASK >> 13) & 1); ++r2_) rwkv_scan(p, b - 64, L);
        if (b >= 192) { const int tid = otid(), gw = (b - 192) * 8 + (tid >> 6), ngw = (G - 192) * 8;
            if (l == 0) { convert_weights(p, 0, 14, gw, ngw, L + (tid >> 6) * 2112, tid & 63); convert_weights(p, 1, 1, gw, ngw, L + (tid >> 6) * 2112, tid & 63); }
            else convert_weights(p, 1, 14, gw, ngw, L + (tid >> 6) * 2112, tid & 63); }
    }
    if (l == 0 && (b == 0 || b == 64 || b == 192)) { __syncthreads(); if (TSEL >= 0 && threadIdx.x == 0) ((unsigned long long*)(p.ws + WS_BAR + 32768))[40 + (b >> 6)] = __builtin_amdgcn_s_memrealtime(); }
    SEAM(B0 + 3);
    REP(4) if (PH(B0 + 4) && PHON(4)) combine_phase(p, l, M);
    SEAM(B0 + 4);
    REP(5) if (PH(B0 + 5) && PHON(5)) {
        pg8::Gemm g{(const pg8::bf16_t*)(p.ws + WS_H), (const pg8::bf16_t*)(p.ws + WS_WT_OUT), TLAT, DM, DM, DM}; pg8::StaticOrder S; S.init(TLAT, DM, G, b);
        pg8::EpiRes E{res_l, res_c, p.out, lat_c, mod_l + 2 * DM, mod_c + 2 * DM};
        pg8::gemm_phase<pg8::EpiRes, pg8::StaticOrder, true, true>((PG8_LAS unsigned char*)lds, g, S, E);
        if (l == 0) {
            pg8::Gemm gc{(const pg8::bf16_t*)(p.ws + WS_H) + (size_t)TLAT * DM, (const pg8::bf16_t*)(p.ws + WS_WT_OUT), TCTX, DM, 1024, DM}; pg8::SplitKOrder Sc; Sc.init(DM, 2, 1024, G, b, 0);
            pg8::EpiAtomic Ec{lat_c, mod_c + 2 * DM};
            pg8::gemm_phase<pg8::EpiAtomic, pg8::SplitKOrder, true, true>((PG8_LAS unsigned char*)lds, gc, Sc, Ec); }
    }
    SEAM(B0 + 5);
    REP(6) if (PH(B0 + 6) && PHON(6)) norm_phase(p, l, p.out, lat_c, p.in[7] + (size_t)l * DM, 3, 4, M);
    SEAM(B0 + 6);
    REP(7) if (PH(B0 + 7) && PHON(7)) {
        pg8::Gemm g{(const pg8::bf16_t*)(p.ws + WS_H), (const pg8::bf16_t*)(p.ws + WS_WT_1), M, DFF, DM, DM}; pg8::StaticOrder S; S.init(M, DFF, G, b);
        pg8::EpiRelu2 E{(pg8::bf16_t*)(p.ws + WS_P), DFF};
        pg8::gemm_phase<pg8::EpiRelu2, pg8::StaticOrder, true, true>((PG8_LAS unsigned char*)lds, g, S, E);
    }
    SEAM(B0 + 7);
    REP(8) if (PH(B0 + 8) && PHON(8)) {
        pg8::Gemm g{(const pg8::bf16_t*)(p.ws + WS_P), (const pg8::bf16_t*)(p.ws + WS_WT_2), TLAT, DM, DFF, DFF}; pg8::StaticOrder S; S.init(TLAT, DM, G, b);
        pg8::EpiRes E{p.out, lat_c, p.out, lat_c, mod_l + 5 * DM, mod_c + 5 * DM};
        pg8::gemm_phase<pg8::EpiRes, pg8::StaticOrder, true, true>((PG8_LAS unsigned char*)lds, g, S, E);
        if (l == 0) {
            pg8::Gemm gc{(const pg8::bf16_t*)(p.ws + WS_P) + (size_t)TLAT * DFF, (const pg8::bf16_t*)(p.ws + WS_WT_2), TCTX, DM, 2048, DFF}; pg8::SplitKOrder Sc; Sc.init(DM, 4, 2048, G, b, 0);
            pg8::EpiAtomic Ec{lat_c, mod_c + 5 * DM};
            pg8::gemm_phase<pg8::EpiAtomic, pg8::SplitKOrder, true, true>((PG8_LAS unsigned char*)lds, gc, Sc, Ec); }
    }
    SEAM(B0 + 8);
}
template <int PHMASK> __global__ void __launch_bounds__(NTHR) fwd_megakernel(Params p) {
    extern __shared__ __attribute__((aligned(16))) unsigned char lds[];
    volatile LAS unsigned* bst = (volatile LAS unsigned*)((LAS unsigned char*)lds + LDS_BYTES - 16);
    if (threadIdx.x < 4) bst[threadIdx.x] = 0u;
    __syncthreads();
    XcdBarrier gbar; gbar.bar = (unsigned*)(p.ws + WS_BAR); gbar.x = 0; gbar.st = bst;
#if ONE_LAUNCH
    gbar = xcd_barrier_post((unsigned*)(p.ws + WS_BAR), bst);
#endif
    STAMP(0);
    REP(9) if (PH(0) && PHON(9)) phase0(p, (float*)lds);
#if ONE_LAUNCH
    cg::this_grid().sync(); STAMP(1);
#endif
    layer_phases<PHMASK, 0>(p, lds, gbar);
    layer_phases<PHMASK, 1>(p, lds, gbar);
    if (PH(19) && PHON(10)) final_norm(p);
    if (TSEL >= 0) { STAMP(20); if (blockIdx.x == 0 && threadIdx.x == 0) { const unsigned long long* ts = (const unsigned long long*)(p.ws + WS_BAR + 32768); __threadfence(); p.out[0] = (float)(TSEL >= 50 ? ts[TSEL] - ts[50] : TSEL >= 44 ? ts[TSEL] : (TSEL >= 40 ? ts[TSEL] - ts[4] : ts[TSEL + 1] - ts[TSEL])) * TSCALE; } }
}

extern "C" void kernel_launch(void* const* d_in, const int* in_sizes, int n_in, void* d_out, int out_size, void* d_ws, size_t ws_size, hipStream_t stream) {
    static int grid = 0;
    if (grid == 0) {
        if (n_in != 28 || ws_size < WS_END) { fprintf(stderr, "kernel_launch: need 28 inputs and %zu bytes of workspace (got %d, %zu)\n", (size_t)WS_END, n_in, ws_size); grid = -1; return; }
        int dev = 0, cus = 0, per_cu = 0;
        (void)hipGetDevice(&dev); (void)hipDeviceGetAttribute(&cus, hipDeviceAttributeMultiprocessorCount, dev);
#if ONE_LAUNCH
        (void)hipFuncSetAttribute((const void*)fwd_megakernel<0xFFFF>, hipFuncAttributeMaxDynamicSharedMemorySize, LDS_BYTES);
        (void)hipOccupancyMaxActiveBlocksPerMultiprocessor(&per_cu, (const void*)fwd_megakernel<0xFFFF>, NTHR, LDS_BYTES);
#else
#define SETATTR(K) (void)hipFuncSetAttribute((const void*)fwd_megakernel<(1 << K)>, hipFuncAttributeMaxDynamicSharedMemorySize, LDS_BYTES)
        SETATTR(0); SETATTR(1); SETATTR(2); SETATTR(3); SETATTR(4); SETATTR(5); SETATTR(6); SETATTR(7); SETATTR(8); SETATTR(9); SETATTR(10); SETATTR(11);
        per_cu = 1;
#endif
        if (per_cu < 1) { fprintf(stderr, "kernel_launch: occupancy query says %d blocks per CU\n", per_cu); grid = -1; return; }
        grid = cus;
        (void)hipGetLastError();
    }
    if (grid < 0) return;
    (void)hipMemsetAsync((char*)d_ws + WS_MOD, 0, 4 * 12288 * 4, stream);
    (void)hipMemsetAsync((char*)d_ws + WS_BAR, 0, 16384 + 1024, stream);
    Params p{};
    for (int i = 0; i < 28; ++i) p.in[i] = (const float*)d_in[i];
    p.out = (float*)d_out; p.ws = (unsigned char*)d_ws;
#if ONE_LAUNCH
    p.ph_lo = 0; p.ph_hi = N_PHASES;
    void* args[] = {&p};
    hipError_t e = hipLaunchCooperativeKernel((const void*)fwd_megakernel<0xFFFF>, dim3(grid), dim3(NTHR), args, LDS_BYTES, stream);
    if (e != hipSuccess) fprintf(stderr, "cooperative launch failed: %s (grid %d)\n", hipGetErrorString(e), grid);
#else
#define LAUNCH1(K) hipLaunchKernelGGL(fwd_megakernel<(1 << K)>, dim3(grid), dim3(NTHR), LDS_BYTES, stream, p)
    for (int ph = 0; ph < N_PHASES; ++ph) { p.ph_lo = ph; p.ph_hi = ph + 1;
        if (ph == 0) { LAUNCH1(9); continue; }
        if (ph == 19) { LAUNCH1(10); continue; }
        switch ((ph - 1) % 9) {
        case 0: LAUNCH1(0); break; case 1: LAUNCH1(1); break; case 2: LAUNCH1(2); LAUNCH1(11); break; case 3: LAUNCH1(3); break; case 4: LAUNCH1(4); break;
        case 5: LAUNCH1(5); break; case 6: LAUNCH1(6); break; case 7: LAUNCH1(7); break; case 8: LAUNCH1(8); break; }
    }
#endif
}
```
